# Optimizing an MI355X kernel written in HIP

```python
import jax
import jax.numpy as jnp
from jax import lax
import numpy as np

D_MODEL = 1024
BATCH = 16
SEQ = 2048
DEPTH = 1

GRID_W = 64
CTX_LEN = 256
MLSTM_HEADS = 8
MLSTM_DH = 128
MLSTM_W = MLSTM_HEADS * MLSTM_DH
MLSTM_CHUNK = 64
GLA_HEADS = 4
GLA_DK_HEAD = 128
GLA_DV_HEAD = 256
GLA_DK = GLA_HEADS * GLA_DK_HEAD
GLA_DV = GLA_HEADS * GLA_DV_HEAD
GLA_RANK = 16
GLA_TAU = 16.0
GLA_CHUNK = 16
D_FF = 2816
ALPHA = (2.0 * DEPTH) ** 0.25
BETA = (8.0 * DEPTH) ** -0.25
EPS = 1e-5
SPLITS = (MLSTM_W, MLSTM_W, MLSTM_W, MLSTM_W, 4 * MLSTM_HEADS, GLA_DK, GLA_DK, GLA_DV, GLA_DV, 2 * GLA_RANK, D_MODEL, D_MODEL)
N_IN = sum(SPLITS)

kernel_name = 'hybrid_mlstm_gla_convglu_prefix'


def layer_norm(h, g, b):
    hf = h.astype(jnp.float32)
    mu = hf.mean(-1, keepdims=True)
    var = jnp.square(hf - mu).mean(-1, keepdims=True)
    return ((hf - mu) * lax.rsqrt(var + EPS)).astype(h.dtype) * g + b


def head_norm(h, g, center):
    if center:
        h = h - h.mean(-1, keepdims=True)
    h = h * lax.rsqrt(jnp.square(h).mean(-1, keepdims=True) + EPS)
    bsz, nh, t, d = h.shape
    return jnp.transpose(h, (0, 2, 1, 3)).reshape(bsz, t, nh * d) * g


def split_heads(a, nh):
    bsz, t, ch = a.shape
    return jnp.transpose(a.reshape(bsz, t, nh, ch // nh), (0, 2, 1, 3))


def to_chunks(a, size):
    bsz, nh, t = a.shape[:3]
    return jnp.moveaxis(a.reshape((bsz, nh, t // size, size) + a.shape[3:]), 2, 0)


def from_chunks(a):
    nc, bsz, nh, size = a.shape[:4]
    return jnp.moveaxis(a, 0, 2).reshape((bsz, nh, nc * size) + a.shape[4:])


def short_conv(a, w):
    ap = jnp.pad(a, ((0, 0), (1, 1), (0, 0)))
    return ap[:, :-2] * w[0] + ap[:, 1:-1] * w[1] + ap[:, 2:] * w[2]


def mlstm_scan(q, k, v, li, lf, state):
    size = MLSTM_CHUNK
    tril = jnp.tril(jnp.ones((size, size), bool))

    def step(carry, inp):
        c_mat, n_vec, m = carry
        qc, kc, vc, lic, lfc = inp
        b = jnp.cumsum(lfc, axis=-1)
        dlog = jnp.where(tril, b[..., :, None] - b[..., None, :] + lic[..., None, :], -jnp.inf)
        m_inter = b + m[..., None]
        m_row = jnp.maximum(m_inter, dlog.max(-1))
        s = jnp.einsum('bhld,bhsd->bhls', qc, kc) * jnp.exp(dlog - m_row[..., None])
        w_inter = jnp.exp(m_inter - m_row)
        num = w_inter[..., None] * jnp.einsum('bhld,bhde->bhle', qc, c_mat) + jnp.einsum('bhls,bhse->bhle', s, vc)
        den = w_inter * jnp.einsum('bhld,bhd->bhl', qc, n_vec) + s.sum(-1)
        h = num / jnp.maximum(jnp.abs(den), jnp.exp(-m_row))[..., None]
        b_end = b[..., -1]
        wlog = b_end[..., None] - b + lic
        m_new = jnp.maximum(b_end + m, wlog.max(-1))
        wk = kc * jnp.exp(wlog - m_new[..., None])[..., None]
        decay = jnp.exp(b_end + m - m_new)
        c_new = decay[..., None, None] * c_mat + jnp.einsum('bhld,bhle->bhde', wk, vc)
        n_new = decay[..., None] * n_vec + wk.sum(2)
        return (c_new, n_new, m_new), h

    state, h = lax.scan(step, state, tuple(to_chunks(a, size) for a in (q, k, v, li, lf)))
    return from_chunks(h), state


def gla_scan(q, k, v, la, s_mat):
    size = GLA_CHUNK
    tril = jnp.tril(jnp.ones((size, size), bool))[:, :, None]

    def step(s_mat, inp):
        qc, kc, vc, lac = inp
        bcum = jnp.cumsum(lac, axis=2)
        o_inter = jnp.einsum('bhld,bhde->bhle', qc * jnp.exp(bcum), s_mat)
        dec = jnp.exp(jnp.where(tril, bcum[:, :, :, None, :] - bcum[:, :, None, :, :], -jnp.inf))
        a = jnp.einsum('bhlsd,bhsd->bhls', qc[:, :, :, None, :] * dec, kc)
        o = o_inter + jnp.einsum('bhls,bhse->bhle', a, vc)
        b_end = bcum[:, :, -1]
        s_new = jnp.exp(b_end)[..., None] * s_mat + jnp.einsum('bhld,bhle->bhde', kc * jnp.exp(b_end[:, :, None] - bcum), vc)
        return s_new, o

    s_mat, o = lax.scan(step, s_mat, tuple(to_chunks(a, size) for a in (q, k, v, la)))
    return from_chunks(o), s_mat


def bidirectional(scan, ctx_shared, ctx_gates, lat_shared, lat_gates, init_state):
    out_ctx, out_lat = 0.0, 0.0
    for d in range(2):
        cs, cg, ls, lg = ctx_shared, ctx_gates[d], lat_shared, lat_gates[d]
        if d == 1:
            cs, cg, ls, lg = [tuple(jnp.flip(a, axis=2) for a in t) for t in (cs, cg, ls, lg)]
        h_c, st = scan(*cs, *cg, init_state)
        h_l, _ = scan(*ls, *lg, st)
        if d == 1:
            h_c, h_l = jnp.flip(h_c, axis=2), jnp.flip(h_l, axis=2)
        out_ctx = out_ctx + h_c
        out_lat = out_lat + h_l
    return out_ctx, out_lat


def mixer_inputs(u, w_in, b_in, conv_qk, gw_f, gb_f, gw_b, gb_b):
    f32 = lambda a: a.astype(jnp.float32)
    p = u @ w_in + b_in
    cuts = [int(i) for i in np.cumsum(SPLITS)[:-1]]
    q_m, k_m, v_m, o_m, g_m, q_g, k_g, v_g, z_g, r_g, gate_a, gate_b = jnp.split(p, cuts, axis=-1)
    qk = jax.nn.silu(short_conv(jnp.concatenate([q_m, k_m], axis=-1), conv_qk))
    q_m, k_m = jnp.split(qk, 2, axis=-1)
    mlstm_shared = (split_heads(f32(q_m), MLSTM_HEADS) * MLSTM_DH ** -0.5,
                    split_heads(f32(k_m), MLSTM_HEADS), split_heads(f32(v_m), MLSTM_HEADS))
    bsz, t, _ = u.shape
    i_f, i_b, f_f, f_b = jnp.transpose(f32(g_m).reshape(bsz, t, 4, MLSTM_HEADS), (2, 0, 3, 1))
    mlstm_gates = ((i_f, jax.nn.log_sigmoid(f_f)), (i_b, jax.nn.log_sigmoid(f_b)))
    gla_shared = (split_heads(f32(q_g), GLA_HEADS) * GLA_DK_HEAD ** -0.5,
                  split_heads(f32(k_g), GLA_HEADS), split_heads(f32(v_g), GLA_HEADS))
    r_f, r_b = jnp.split(f32(r_g), 2, axis=-1)
    la_f = split_heads(jax.nn.log_sigmoid(r_f @ gw_f + gb_f) / GLA_TAU, GLA_HEADS)
    la_b = split_heads(jax.nn.log_sigmoid(r_b @ gw_b + gb_b) / GLA_TAU, GLA_HEADS)
    gla_gates = ((la_f,), (la_b,))
    return mlstm_shared, mlstm_gates, gla_shared, gla_gates, (o_m, z_g, gate_a, gate_b)


def merge_branches(h_m, h_g, side, mlstm_norm_g, gla_norm_g, w_branch_mlstm, w_branch_gla, w_out, dtype):
    o_m, z_g, gate_a, gate_b = side
    y_m = (head_norm(h_m, mlstm_norm_g, True) * jax.nn.sigmoid(o_m.astype(jnp.float32))).astype(dtype) @ w_branch_mlstm
    y_g = (head_norm(h_g, gla_norm_g, False) * jax.nn.silu(z_g.astype(jnp.float32))).astype(dtype) @ w_branch_gla
    return (jax.nn.sigmoid(gate_a) * y_m + jax.nn.sigmoid(gate_b) * y_g) @ w_out


def conv_glu(u, rows, w_up, b_up, conv_w, conv_b, w_down, b_down):
    gate, val = jnp.split(u @ w_up + b_up, 2, axis=-1)
    bsz, t, ch = gate.shape
    img = gate.reshape(bsz, rows, t // rows, ch)
    img = lax.conv_general_dilated(img, conv_w[:, :, None, :], (1, 1), 'SAME',
                                   dimension_numbers=('NHWC', 'HWIO', 'NHWC'), feature_group_count=ch) + conv_b
    return (jax.nn.gelu(img.reshape(bsz, t, ch)) * val) @ w_down + b_down


def setup_inputs(seed: int = 0) -> dict:
    key = jax.random.key(seed)
    ks = jax.random.split(key, 28)

    def nrm(k, shape, scale):
        return jax.random.normal(k, shape, jnp.float32) * scale

    nl = DEPTH
    f_lo = 4 * MLSTM_W + 2 * MLSTM_HEADS
    b_in = nrm(ks[7], (nl, N_IN), 0.02).at[:, f_lo:f_lo + 2 * MLSTM_HEADS].add(3.0)
    return {
        'x': nrm(ks[0], (BATCH, SEQ, D_MODEL), 1.0),
        'c': nrm(ks[1], (BATCH, D_MODEL), 1.0),
        'ctx': nrm(ks[2], (BATCH, CTX_LEN, D_MODEL), 1.0),
        'c_ctx': nrm(ks[3], (D_MODEL,), 1.0),
        'w_mod': nrm(ks[4], (nl, D_MODEL, 6 * D_MODEL), 0.5 * D_MODEL ** -0.5),
        'b_mod': nrm(ks[5], (nl, 6 * D_MODEL), 0.02),
        'w_in': nrm(ks[6], (nl, D_MODEL, N_IN), D_MODEL ** -0.5),
        'b_in': b_in,
        'conv_qk': nrm(ks[8], (nl, 3, 2 * MLSTM_W), 3 ** -0.5),
        'gla_gate_w_fwd': nrm(ks[9], (nl, GLA_RANK, GLA_DK), GLA_RANK ** -0.5),
        'gla_gate_b_fwd': nrm(ks[10], (nl, GLA_DK), 0.02),
        'gla_gate_w_bwd': nrm(ks[11], (nl, GLA_RANK, GLA_DK), GLA_RANK ** -0.5),
        'gla_gate_b_bwd': nrm(ks[12], (nl, GLA_DK), 0.02),
        'mlstm_norm_g': 1.0 + nrm(ks[13], (nl, MLSTM_W), 0.02),
        'gla_norm_g': 1.0 + nrm(ks[14], (nl, GLA_DV), 0.02),
        'w_branch_mlstm': nrm(ks[15], (nl, MLSTM_W, D_MODEL), BETA * MLSTM_W ** -0.5),
        'w_branch_gla': nrm(ks[16], (nl, GLA_DV, D_MODEL), BETA * GLA_DV ** -0.5),
        'w_out': nrm(ks[17], (nl, D_MODEL, D_MODEL), BETA * D_MODEL ** -0.5),
        'ln1_g': 1.0 + nrm(ks[18], (nl, D_MODEL), 0.02),
        'ln1_b': nrm(ks[19], (nl, D_MODEL), 0.02),
        'w_up': nrm(ks[20], (nl, D_MODEL, 2 * D_FF), D_MODEL ** -0.5),
        'b_up': nrm(ks[21], (nl, 2 * D_FF), 0.02),
        'ffn_conv_w': nrm(ks[22], (nl, 3, 3, D_FF), 1.0 / 3.0),
        'ffn_conv_b': nrm(ks[23], (nl, D_FF), 0.02),
        'w_down': nrm(ks[24], (nl, D_FF, D_MODEL), BETA * D_FF ** -0.5),
        'b_down': nrm(ks[25], (nl, D_MODEL), 0.02),
        'ln2_g': 1.0 + nrm(ks[26], (nl, D_MODEL), 0.02),
        'ln2_b': nrm(ks[27], (nl, D_MODEL), 0.02),
    }


def reference(x, c, ctx, c_ctx, w_mod, b_mod, w_in, b_in, conv_qk, gla_gate_w_fwd, gla_gate_b_fwd,
              gla_gate_w_bwd, gla_gate_b_bwd, mlstm_norm_g, gla_norm_g, w_branch_mlstm, w_branch_gla, w_out,
              ln1_g, ln1_b, w_up, b_up, ffn_conv_w, ffn_conv_b, w_down, b_down, ln2_g, ln2_b):
    bsz, seq, _ = x.shape
    rows = seq // GRID_W
    h, hc = x, ctx
    for l in range(DEPTH):
        mod = jax.nn.silu(c) @ w_mod[l] + b_mod[l]
        sh1, sc1, g1, sh2, sc2, g2 = jnp.split(mod[:, None, :], 6, axis=-1)
        mod_c = jax.nn.silu(c_ctx) @ w_mod[l] + b_mod[l]
        csh1, csc1, cg1, csh2, csc2, cg2 = jnp.split(mod_c, 6, axis=-1)
        proj = (w_in[l], b_in[l], conv_qk[l], gla_gate_w_fwd[l], gla_gate_b_fwd[l], gla_gate_w_bwd[l], gla_gate_b_bwd[l])
        m_sh_c, m_g_c, g_sh_c, g_g_c, side_c = mixer_inputs(hc * (1 + csc1) + csh1, *proj)
        m_sh_l, m_g_l, g_sh_l, g_g_l, side_l = mixer_inputs(h * (1 + sc1) + sh1, *proj)
        m_init = (jnp.zeros((bsz, MLSTM_HEADS, MLSTM_DH, MLSTM_DH), jnp.float32),
                  jnp.zeros((bsz, MLSTM_HEADS, MLSTM_DH), jnp.float32),
                  jnp.zeros((bsz, MLSTM_HEADS), jnp.float32))
        g_init = jnp.zeros((bsz, GLA_HEADS, GLA_DK_HEAD, GLA_DV_HEAD), jnp.float32)
        hm_c, hm_l = bidirectional(mlstm_scan, m_sh_c, m_g_c, m_sh_l, m_g_l, m_init)
        hg_c, hg_l = bidirectional(gla_scan, g_sh_c, g_g_c, g_sh_l, g_g_l, g_init)
        outp = (mlstm_norm_g[l], gla_norm_g[l], w_branch_mlstm[l], w_branch_gla[l], w_out[l])
        ffn = (w_up[l], b_up[l], ffn_conv_w[l], ffn_conv_b[l], w_down[l], b_down[l])
        mix = merge_branches(hm_l, hg_l, side_l, *outp, x.dtype)
        h = layer_norm(ALPHA * h + g1 * mix, ln1_g[l], ln1_b[l])
        f = conv_glu(h * (1 + sc2) + sh2, rows, *ffn)
        h = layer_norm(ALPHA * h + g2 * f, ln2_g[l], ln2_b[l])
        if l < DEPTH - 1:
            mix_c = merge_branches(hm_c, hg_c, side_c, *outp, x.dtype)
            hc = layer_norm(ALPHA * hc + cg1 * mix_c, ln1_g[l], ln1_b[l])
            f_c = conv_glu(hc * (1 + csc2) + csh2, 1, *ffn)
            hc = layer_norm(ALPHA * hc + cg2 * f_c, ln2_g[l], ln2_b[l])
    return h
```

```cpp
#include <hip/hip_runtime.h>
#include <cstdio>
#include <cstdint>

typedef unsigned short bf16_t;

constexpr int DM = 1024, NB = 16, SEQ = 2048, CTX = 256, GW = 64;
constexpr int ML = NB * SEQ;
constexpr int MC = NB * CTX;
constexpr int MT = ML + MC;
constexpr int NIN = 9280, NINP = 9472;
constexpr int DFF = 2816;
constexpr float ALPHA = 1.189207115002721f;
constexpr float EPS = 1e-5f;
constexpr int PC_QM = 0, PC_KM = 1024, PC_VM = 2048, PC_SMALL = 3072, PC_QG = 3328, PC_KG = 3840, PC_VG = 4352, PC_SIDE = 5376;
constexpr int N_AB = 5376;
constexpr int N_SIDE = 4096;

constexpr size_t MiB = 1u << 20;
constexpr size_t WS_CTL = 0;
constexpr size_t WS_MOD = 1 * MiB;
constexpr size_t WS_BIN = WS_MOD + 512 * 1024;
constexpr size_t WS_WIN = 4 * MiB;
constexpr size_t WS_WBM = WS_WIN + (size_t)NINP * DM * 2;
constexpr size_t WS_WBG = WS_WBM + 2 * MiB;
constexpr size_t WS_WOUT = WS_WBG + 2 * MiB;
constexpr size_t WS_WUP = WS_WOUT + 2 * MiB;
constexpr size_t WS_WDN = WS_WUP + 11 * MiB;
constexpr size_t WS_U = 46 * MiB;
constexpr size_t WS_BIG = 118 * MiB;
constexpr size_t WS_END = 502 * MiB;
static_assert(WS_WDN + (size_t)DM * DFF * 2 <= WS_U, "weights fit");
constexpr size_t BIG_PM = 0;
constexpr size_t BIG_PG = 216 * MiB;
constexpr size_t BIG_SMALL = 360 * MiB;
constexpr size_t BIG_HG = 0;
constexpr size_t BIG_SIDE = 128 * MiB;
constexpr size_t BIG_GATE = 0;
constexpr size_t BIG_VAL = 176 * MiB;

__device__ __forceinline__ float bf2f(bf16_t v) { return __uint_as_float(((unsigned)v) << 16); }
__device__ __forceinline__ bf16_t f2bf(float f) { unsigned u = __float_as_uint(f); return (bf16_t)((u + 0x7fffu + ((u >> 16) & 1u)) >> 16); }
__device__ __forceinline__ float sigmoidf_(float x) { return 1.f / (1.f + __expf(-x)); }
__device__ __forceinline__ float siluf_(float x) { return x * sigmoidf_(x); }
__device__ __forceinline__ float logsigmoidf_(float x) { return fminf(x, 0.f) - log1pf(__expf(-fabsf(x))); }
__device__ __forceinline__ float gelu_tanh(float x) { const float u = 0.7978845608028654f * (x + 0.044715f * x * x * x); return 0.5f * x * (1.f + tanhf(u)); }
__device__ __forceinline__ float wave_sum(float v) {
#pragma unroll
    for (int o = 1; o < 64; o <<= 1) v += __shfl_xor(v, o);
    return v;
}

__global__ void __launch_bounds__(256) k_transpose_w(const float* __restrict__ W, int ldw, int K, int src_col0, int ncols, bf16_t* __restrict__ Wt, int dst_row0) {
    __shared__ float t[32][33];
    const int n0 = blockIdx.x * 32, k0 = blockIdx.y * 32, tx = threadIdx.x & 31, ty = threadIdx.x >> 5;
#pragma unroll
    for (int i = 0; i < 4; ++i) { const int k = k0 + ty + 8 * i; t[ty + 8 * i][tx] = W[(size_t)k * ldw + src_col0 + n0 + tx]; }
    __syncthreads();
#pragma unroll
    for (int i = 0; i < 4; ++i) { const int n = n0 + ty + 8 * i; Wt[(size_t)(dst_row0 + n) * K + k0 + tx] = f2bf(t[tx][ty + 8 * i]); }
}
__global__ void k_zero16(bf16_t* p, size_t n) { size_t i = (size_t)blockIdx.x * blockDim.x + threadIdx.x; if (i < n) p[i] = 0; }
__global__ void k_bias_perm(const float* __restrict__ b_in, float* __restrict__ bp) {
    const int j = blockIdx.x * blockDim.x + threadIdx.x; if (j >= NINP) return;
    int s = -1;
    if (j < 3072) s = j;
    else if (j < 3104) s = 4096 + (j - 3072);
    else if (j < 3136) s = 7200 + (j - 3104);
    else if (j < 3328) s = -1;
    else if (j < 3840) s = 4128 + (j - 3328);
    else if (j < 4352) s = 4640 + (j - 3840);
    else if (j < 5376) s = 5152 + (j - 4352);
    else if (j < 6400) s = 3072 + (j - 5376);
    else if (j < 7424) s = 6176 + (j - 6400);
    else if (j < 8448) s = 7232 + (j - 7424);
    else s = 8256 + (j - 8448);
    bp[j] = s >= 0 ? b_in[s] : 0.f;
}
__global__ void __launch_bounds__(256) k_mod(const float* __restrict__ c, const float* __restrict__ c_ctx, const float* __restrict__ w_mod, const float* __restrict__ b_mod, float* __restrict__ modv) {
    const int j = blockIdx.x * 256 + threadIdx.x, r = blockIdx.y;
    const float* cv = r < 16 ? c + r * DM : c_ctx;
    float acc = b_mod[j];
    for (int k = 0; k < DM; ++k) acc += siluf_(cv[k]) * w_mod[(size_t)k * 6144 + j];
    modv[r * 6144 + j] = acc;
}
__global__ void __launch_bounds__(256) k_modulate(const float* __restrict__ x, const float* __restrict__ ctx, const float* __restrict__ modv, bf16_t* __restrict__ U) {
    const size_t i = ((size_t)blockIdx.x * 256 + threadIdx.x) * 4;
    const int row = (int)(i / DM), d = (int)(i % DM);
    const float* src; int r;
    if (row < ML) { src = x + (size_t)row * DM + d; r = row / SEQ; } else { src = ctx + (size_t)(row - ML) * DM + d; r = 16; }
    const float4 v = *(const float4*)src; const float* mv = modv + r * 6144;
    const float4 sh = *(const float4*)(mv + d), sc = *(const float4*)(mv + 1024 + d);
    ushort4 o; o.x = f2bf(v.x * (1.f + sc.x) + sh.x); o.y = f2bf(v.y * (1.f + sc.y) + sh.y); o.z = f2bf(v.z * (1.f + sc.z) + sh.z); o.w = f2bf(v.w * (1.f + sc.w) + sh.w);
    *(ushort4*)(U + i) = o;
}

struct EpiAB {
    bf16_t* Pm; bf16_t* Pg; float* small; const float* bias;
    __device__ __forceinline__ void operator()(int row, int col, float v, float) const {
        v += bias[col];
        if (col < 3072) Pm[(size_t)row * 3072 + col] = f2bf(v);
        else if (col < 3328) { if (col < 3136) small[(size_t)row * 64 + (col - 3072)] = v; }
        else Pg[(size_t)row * 2048 + (col - 3328)] = f2bf(v);
    }
};
struct EpiSide { bf16_t* S; const float* bias;
    __device__ __forceinline__ void operator()(int row, int col, float v, float) const { S[(size_t)row * 4096 + col] = f2bf(v + bias[PC_SIDE + col]); } };
struct EpiMerge { bf16_t* Z; const bf16_t* side;
    __device__ __forceinline__ void operator()(int row, int col, float v1, float v2) const {
        const float ga = bf2f(side[(size_t)row * 4096 + 2048 + col]), gb = bf2f(side[(size_t)row * 4096 + 3072 + col]);
        Z[(size_t)row * DM + col] = f2bf(sigmoidf_(ga) * v1 + sigmoidf_(gb) * v2); } };
struct EpiOut { const float* x; const float* modv; float* r1;
    __device__ __forceinline__ void operator()(int row, int col, float v, float) const {
        const float g1 = modv[(row / SEQ) * 6144 + 2048 + col]; r1[(size_t)row * DM + col] = ALPHA * x[(size_t)row * DM + col] + g1 * v; } };
struct EpiUp { bf16_t* gate; bf16_t* val; const float* b_up;
    __device__ __forceinline__ void operator()(int row, int col, float v, float) const {
        v += b_up[col]; if (col < DFF) gate[(size_t)row * DFF + col] = f2bf(v); else val[(size_t)row * DFF + (col - DFF)] = f2bf(v); } };
struct EpiDown { float* h; const float* modv; const float* b_down;
    __device__ __forceinline__ void operator()(int row, int col, float v, float) const {
        const float g2 = modv[(row / SEQ) * 6144 + 5120 + col]; float* p = h + (size_t)row * DM + col; *p = ALPHA * (*p) + g2 * (v + b_down[col]); } };

template <class Epi, bool DUAL>
__global__ void __launch_bounds__(256) k_gemm_naive(const bf16_t* __restrict__ A, int lda, const bf16_t* __restrict__ Bt, const bf16_t* __restrict__ A2, int lda2, const bf16_t* __restrict__ Bt2, int K, Epi epi) {
    __shared__ float As[16][68], Bs[16][68];
    const int tx = threadIdx.x & 15, ty = threadIdx.x >> 4;
    const int m0 = blockIdx.y * 64, n0 = blockIdx.x * 64;
    const int lr = threadIdx.x >> 2, lk = (threadIdx.x & 3) * 4;
    float acc[4][4], acc2[4][4];
#pragma unroll
    for (int i = 0; i < 4; ++i)
#pragma unroll
        for (int j = 0; j < 4; ++j) { acc[i][j] = 0.f; acc2[i][j] = 0.f; }
    for (int pass = 0; pass < (DUAL ? 2 : 1); ++pass) {
        const bf16_t* Ap = pass ? A2 : A; const bf16_t* Bp = pass ? Bt2 : Bt; const int la = pass ? lda2 : lda;
        for (int k0 = 0; k0 < K; k0 += 16) {
            const ushort4 av = *(const ushort4*)(Ap + (size_t)(m0 + lr) * la + k0 + lk);
            const ushort4 bv = *(const ushort4*)(Bp + (size_t)(n0 + lr) * K + k0 + lk);
            As[lk + 0][lr] = bf2f(av.x); As[lk + 1][lr] = bf2f(av.y); As[lk + 2][lr] = bf2f(av.z); As[lk + 3][lr] = bf2f(av.w);
            Bs[lk + 0][lr] = bf2f(bv.x); Bs[lk + 1][lr] = bf2f(bv.y); Bs[lk + 2][lr] = bf2f(bv.z); Bs[lk + 3][lr] = bf2f(bv.w);
            __syncthreads();
#pragma unroll
            for (int k = 0; k < 16; ++k) {
                const float4 a = *(const float4*)&As[k][ty * 4], b = *(const float4*)&Bs[k][tx * 4];
                const float aa[4] = {a.x, a.y, a.z, a.w}, bb[4] = {b.x, b.y, b.z, b.w};
#pragma unroll
                for (int i = 0; i < 4; ++i)
#pragma unroll
                    for (int j = 0; j < 4; ++j) { if (pass == 0) acc[i][j] += aa[i] * bb[j]; else acc2[i][j] += aa[i] * bb[j]; }
            }
            __syncthreads();
        }
    }
#pragma unroll
    for (int i = 0; i < 4; ++i)
#pragma unroll
        for (int j = 0; j < 4; ++j) epi(m0 + ty * 4 + i, n0 + tx * 4 + j, acc[i][j], acc2[i][j]);
}

__global__ void __launch_bounds__(192) k_mlstm_naive(const bf16_t* __restrict__ Pm, const float* __restrict__ small, const float* __restrict__ conv_qk, bf16_t* __restrict__ hm  ) {
    __shared__ float qs[128], ks[128], sden[2];
    const int bid = blockIdx.x, dir = bid & 1, h = (bid >> 1) & 7, b = bid >> 4, e = threadIdx.x;
    float C[128];
#pragma unroll
    for (int d = 0; d < 128; ++d) C[d] = 0.f;
    float m = 0.f;
    if (e < 128) qs[e] = 0.f;
    float wq0 = 0, wq1 = 0, wq2 = 0, wk0 = 0, wk1 = 0, wk2 = 0;
    if (e < 128) { const int cq = h * 128 + e, ck = 1024 + h * 128 + e;
        wq0 = conv_qk[cq]; wq1 = conv_qk[2048 + cq]; wq2 = conv_qk[4096 + cq]; wk0 = conv_qk[ck]; wk1 = conv_qk[2048 + ck]; wk2 = conv_qk[4096 + ck]; }
    bf16_t* hout = hm + (size_t)dir * ML * DM;
    for (int seg = 0; seg < 2; ++seg) {
        const int T = seg ? SEQ : CTX; const int row0 = seg ? b * SEQ : ML + b * CTX;
        for (int s = 0; s < T; ++s) {
            const int t = dir ? (T - 1 - s) : s; const int row = row0 + t;
            if (e < 128) {
                const bf16_t* p = Pm + (size_t)row * 3072 + h * 128 + e;
                const float k1 = bf2f(p[1024]), k0 = t > 0 ? bf2f(p[1024 - 3072]) : 0.f, k2 = t < T - 1 ? bf2f(p[1024 + 3072]) : 0.f;
                ks[e] = siluf_(wk0 * k0 + wk1 * k1 + wk2 * k2);
                if (seg) { const float q1 = bf2f(p[0]), q0 = t > 0 ? bf2f(p[-3072]) : 0.f, q2 = t < T - 1 ? bf2f(p[3072]) : 0.f;
                    qs[e] = siluf_(wq0 * q0 + wq1 * q1 + wq2 * q2) * 0.08838834764831845f; }
            }
            const float li = small[(size_t)row * 64 + dir * 8 + h], lf = logsigmoidf_(small[(size_t)row * 64 + 16 + dir * 8 + h]);
            const float mn = fmaxf(lf + m, li), fd = __expf(lf + m - mn), iw = __expf(li - mn);
            const float ve = e < 128 ? bf2f(Pm[(size_t)row * 3072 + 2048 + h * 128 + e]) : 1.f;
            __syncthreads();
            float acc = 0.f;
            if (e <= 128) {
                const float a = iw * ve;
#pragma unroll
                for (int d = 0; d < 128; ++d) { C[d] = fd * C[d] + ks[d] * a; acc += qs[d] * C[d]; }
            }
            if (seg) {
                if (e == 128) sden[0] = acc;
                __syncthreads();
                if (e < 128) { const float den = fmaxf(fabsf(sden[0]), __expf(-mn)); hout[(size_t)row * DM + h * 128 + e] = f2bf(acc / den); }
            }
            m = mn;
            __syncthreads();
        }
    }
}

__global__ void __launch_bounds__(256) k_gla_naive(const bf16_t* __restrict__ Pg, const float* __restrict__ small, const float* __restrict__ gw_f, const float* __restrict__ gb_f,
                                                   const float* __restrict__ gw_b, const float* __restrict__ gb_b, bf16_t* __restrict__ hg  ) {
    __shared__ float qs[128], ks[128], al[128];
    const int bid = blockIdx.x, dir = bid & 1, h = (bid >> 1) & 3, b = bid >> 3, e = threadIdx.x;
    float S[128];
#pragma unroll
    for (int d = 0; d < 128; ++d) S[d] = 0.f;
    const float* gw = dir ? gw_b : gw_f; const float* gb = dir ? gb_b : gb_f;
    float w[16]; float gbv = 0.f;
    if (e < 128) { gbv = gb[h * 128 + e];
#pragma unroll
        for (int i = 0; i < 16; ++i) w[i] = gw[i * 512 + h * 128 + e]; }
    bf16_t* hout = hg + (size_t)dir * ML * DM;
    for (int seg = 0; seg < 2; ++seg) {
        const int T = seg ? SEQ : CTX; const int row0 = seg ? b * SEQ : ML + b * CTX;
        for (int s = 0; s < T; ++s) {
            const int t = dir ? (T - 1 - s) : s; const int row = row0 + t;
            if (e < 128) {
                const float* r = small + (size_t)row * 64 + 32 + dir * 16; float a = gbv;
#pragma unroll
                for (int i = 0; i < 16; ++i) a += r[i] * w[i];
                al[e] = __expf(logsigmoidf_(a) * (1.f / 16.f));
                qs[e] = bf2f(Pg[(size_t)row * 2048 + h * 128 + e]) * 0.08838834764831845f;
                ks[e] = bf2f(Pg[(size_t)row * 2048 + 512 + h * 128 + e]);
            }
            const float ve = bf2f(Pg[(size_t)row * 2048 + 1024 + h * 256 + e]);
            __syncthreads();
            float acc = 0.f;
#pragma unroll
            for (int d = 0; d < 128; ++d) { S[d] = al[d] * S[d] + ks[d] * ve; acc += qs[d] * S[d]; }
            if (seg) hout[(size_t)row * DM + h * 256 + e] = f2bf(acc);
            __syncthreads();
        }
    }
}

__global__ void __launch_bounds__(256) k_aprep(bf16_t* __restrict__ hm, bf16_t* __restrict__ hg, const bf16_t* __restrict__ side, const float* __restrict__ gm, const float* __restrict__ gg) {
    const int gwv = blockIdx.x * 4 + (threadIdx.x >> 6), lane = threadIdx.x & 63;
    const int row = gwv / 12, u = gwv % 12;
    if (u < 8) {
        const int c0 = u * 128 + lane * 2; const size_t o = (size_t)row * DM + c0;
        float v0 = bf2f(hm[o]) + bf2f(hm[o + (size_t)ML * DM]), v1 = bf2f(hm[o + 1]) + bf2f(hm[o + 1 + (size_t)ML * DM]);
        const float mean = wave_sum(v0 + v1) * (1.f / 128.f); v0 -= mean; v1 -= mean;
        const float rstd = rsqrtf(wave_sum(v0 * v0 + v1 * v1) * (1.f / 128.f) + EPS);
        const float o0 = bf2f(side[(size_t)row * 4096 + c0]), o1 = bf2f(side[(size_t)row * 4096 + c0 + 1]);
        hm[o] = f2bf(v0 * rstd * gm[c0] * sigmoidf_(o0)); hm[o + 1] = f2bf(v1 * rstd * gm[c0 + 1] * sigmoidf_(o1));
    } else {
        const int hh = u - 8; const int c0 = hh * 256 + lane * 4; const size_t o = (size_t)row * DM + c0;
        float v[4]; float ss = 0.f;
#pragma unroll
        for (int i = 0; i < 4; ++i) { v[i] = bf2f(hg[o + i]) + bf2f(hg[o + i + (size_t)ML * DM]); ss += v[i] * v[i]; }
        const float rstd = rsqrtf(wave_sum(ss) * (1.f / 256.f) + EPS);
#pragma unroll
        for (int i = 0; i < 4; ++i) { const float z = bf2f(side[(size_t)row * 4096 + 1024 + c0 + i]); hg[o + i] = f2bf(v[i] * rstd * gg[c0 + i] * siluf_(z)); }
    }
}

__global__ void __launch_bounds__(256) k_ln1(float* __restrict__ r1, const float* __restrict__ g, const float* __restrict__ bta, const float* __restrict__ modv, bf16_t* __restrict__ u2) {
    const int row = blockIdx.x * 4 + (threadIdx.x >> 6), lane = threadIdx.x & 63; float* p = r1 + (size_t)row * DM; const float* mv = modv + (row / SEQ) * 6144;
    float4 v[4]; float s = 0.f;
#pragma unroll
    for (int j = 0; j < 4; ++j) { v[j] = *(const float4*)(p + j * 256 + lane * 4); s += v[j].x + v[j].y + v[j].z + v[j].w; }
    const float mean = wave_sum(s) * (1.f / DM); float q = 0.f;
#pragma unroll
    for (int j = 0; j < 4; ++j) { v[j].x -= mean; v[j].y -= mean; v[j].z -= mean; v[j].w -= mean; q += v[j].x * v[j].x + v[j].y * v[j].y + v[j].z * v[j].z + v[j].w * v[j].w; }
    const float rstd = rsqrtf(wave_sum(q) * (1.f / DM) + EPS);
#pragma unroll
    for (int j = 0; j < 4; ++j) { const int c = j * 256 + lane * 4; const float4 gg = *(const float4*)(g + c), bb = *(const float4*)(bta + c), sh = *(const float4*)(mv + 3072 + c), sc = *(const float4*)(mv + 4096 + c);
        float4 o; o.x = v[j].x * rstd * gg.x + bb.x; o.y = v[j].y * rstd * gg.y + bb.y; o.z = v[j].z * rstd * gg.z + bb.z; o.w = v[j].w * rstd * gg.w + bb.w;
        *(float4*)(p + c) = o;
        ushort4 w; w.x = f2bf(o.x * (1.f + sc.x) + sh.x); w.y = f2bf(o.y * (1.f + sc.y) + sh.y); w.z = f2bf(o.z * (1.f + sc.z) + sh.z); w.w = f2bf(o.w * (1.f + sc.w) + sh.w);
        *(ushort4*)(u2 + (size_t)row * DM + c) = w; }
}
__global__ void __launch_bounds__(256) k_ln2(float* __restrict__ r2, const float* __restrict__ g, const float* __restrict__ bta) {
    const int row = blockIdx.x * 4 + (threadIdx.x >> 6), lane = threadIdx.x & 63; float* p = r2 + (size_t)row * DM;
    float4 v[4]; float s = 0.f;
#pragma unroll
    for (int j = 0; j < 4; ++j) { v[j] = *(const float4*)(p + j * 256 + lane * 4); s += v[j].x + v[j].y + v[j].z + v[j].w; }
    const float mean = wave_sum(s) * (1.f / DM); float q = 0.f;
#pragma unroll
    for (int j = 0; j < 4; ++j) { v[j].x -= mean; v[j].y -= mean; v[j].z -= mean; v[j].w -= mean; q += v[j].x * v[j].x + v[j].y * v[j].y + v[j].z * v[j].z + v[j].w * v[j].w; }
    const float rstd = rsqrtf(wave_sum(q) * (1.f / DM) + EPS);
#pragma unroll
    for (int j = 0; j < 4; ++j) { const int c = j * 256 + lane * 4; const float4 gg = *(const float4*)(g + c), bb = *(const float4*)(bta + c);
        float4 o; o.x = v[j].x * rstd * gg.x + bb.x; o.y = v[j].y * rstd * gg.y + bb.y; o.z = v[j].z * rstd * gg.z + bb.z; o.w = v[j].w * rstd * gg.w + bb.w;
        *(float4*)(p + c) = o; }
}

__global__ void __launch_bounds__(256) k_convglu(const bf16_t* __restrict__ gate, bf16_t* __restrict__ val, const float* __restrict__ cw  , const float* __restrict__ cb) {
    const size_t i = (size_t)blockIdx.x * 256 + threadIdx.x;
    const int row = (int)(i / DFF), ch = (int)(i % DFF);
    const int b = row / SEQ, t = row % SEQ, r = t / GW, c = t % GW;
    float acc = cb[ch];
#pragma unroll
    for (int di = 0; di < 3; ++di)
#pragma unroll
        for (int dj = 0; dj < 3; ++dj) { const int rr = r + di - 1, cc = c + dj - 1;
            if (rr >= 0 && rr < SEQ / GW && cc >= 0 && cc < GW) acc += bf2f(gate[((size_t)b * SEQ + rr * GW + cc) * DFF + ch]) * cw[(di * 3 + dj) * DFF + ch]; }
    val[i] = f2bf(gelu_tanh(acc) * bf2f(val[i]));
}

extern "C" void kernel_launch(void* const* d_in, const int* in_sizes, int n_in, void* d_out, int out_size, void* d_ws, size_t ws_size, hipStream_t stream) {
    if (n_in != 28 || out_size != ML * DM || ws_size < WS_END) { fprintf(stderr, "kernel_launch: unexpected shapes n_in %d out %d ws %zu\n", n_in, out_size, ws_size); return; }
    const float* x = (const float*)d_in[0]; const float* c = (const float*)d_in[1]; const float* ctx = (const float*)d_in[2]; const float* c_ctx = (const float*)d_in[3];
    const float* w_mod = (const float*)d_in[4]; const float* b_mod = (const float*)d_in[5]; const float* w_in = (const float*)d_in[6]; const float* b_in = (const float*)d_in[7];
    const float* conv_qk = (const float*)d_in[8]; const float* gw_f = (const float*)d_in[9]; const float* gb_f = (const float*)d_in[10]; const float* gw_b = (const float*)d_in[11]; const float* gb_b = (const float*)d_in[12];
    const float* mnorm_g = (const float*)d_in[13]; const float* gnorm_g = (const float*)d_in[14]; const float* w_bm = (const float*)d_in[15]; const float* w_bg = (const float*)d_in[16]; const float* w_out = (const float*)d_in[17];
    const float* ln1_g = (const float*)d_in[18]; const float* ln1_b = (const float*)d_in[19]; const float* w_up = (const float*)d_in[20]; const float* b_up = (const float*)d_in[21];
    const float* cw = (const float*)d_in[22]; const float* cb = (const float*)d_in[23]; const float* w_down = (const float*)d_in[24]; const float* b_down = (const float*)d_in[25];
    const float* ln2_g = (const float*)d_in[26]; const float* ln2_b = (const float*)d_in[27];
    unsigned char* ws = (unsigned char*)d_ws; float* out = (float*)d_out;
    float* modv = (float*)(ws + WS_MOD); float* binp = (float*)(ws + WS_BIN);
    bf16_t* Wt_in = (bf16_t*)(ws + WS_WIN); bf16_t* Wt_bm = (bf16_t*)(ws + WS_WBM); bf16_t* Wt_bg = (bf16_t*)(ws + WS_WBG); bf16_t* Wt_out = (bf16_t*)(ws + WS_WOUT);
    bf16_t* Wt_up = (bf16_t*)(ws + WS_WUP); bf16_t* Wt_dn = (bf16_t*)(ws + WS_WDN);
    bf16_t* U = (bf16_t*)(ws + WS_U); unsigned char* big = ws + WS_BIG;
    bf16_t* Pm = (bf16_t*)(big + BIG_PM); bf16_t* Pg = (bf16_t*)(big + BIG_PG); float* small = (float*)(big + BIG_SMALL);
    bf16_t* hm = (bf16_t*)d_out; bf16_t* hg = (bf16_t*)(big + BIG_HG); bf16_t* side = (bf16_t*)(big + BIG_SIDE);
    bf16_t* gate = (bf16_t*)(big + BIG_GATE); bf16_t* val = (bf16_t*)(big + BIG_VAL);
    bf16_t* Z = U; bf16_t* u2 = U;

    struct Seg { int src, n, dst; };
    const Seg segs[11] = {{0, 3072, 0}, {4096, 32, 3072}, {7200, 32, 3104}, {4128, 512, 3328}, {4640, 512, 3840}, {5152, 1024, 4352}, {3072, 1024, 5376}, {6176, 1024, 6400}, {7232, 1024, 7424}, {8256, 1024, 8448}, {0, 0, 0}};
    k_zero16<<<(192 * 1024 + 255) / 256, 256, 0, stream>>>(Wt_in + (size_t)3136 * DM, (size_t)192 * DM);
    for (int i = 0; i < 10; ++i) k_transpose_w<<<dim3(segs[i].n / 32, DM / 32), 256, 0, stream>>>(w_in, NIN, DM, segs[i].src, segs[i].n, Wt_in, segs[i].dst);
    k_transpose_w<<<dim3(DM / 32, DM / 32), 256, 0, stream>>>(w_bm, DM, DM, 0, DM, Wt_bm, 0);
    k_transpose_w<<<dim3(DM / 32, DM / 32), 256, 0, stream>>>(w_bg, DM, DM, 0, DM, Wt_bg, 0);
    k_transpose_w<<<dim3(DM / 32, DM / 32), 256, 0, stream>>>(w_out, DM, DM, 0, DM, Wt_out, 0);
    k_transpose_w<<<dim3(2 * DFF / 32, DM / 32), 256, 0, stream>>>(w_up, 2 * DFF, DM, 0, 2 * DFF, Wt_up, 0);
    k_transpose_w<<<dim3(DM / 32, DFF / 32), 256, 0, stream>>>(w_down, DM, DFF, 0, DM, Wt_dn, 0);
    k_bias_perm<<<(NINP + 255) / 256, 256, 0, stream>>>(b_in, binp);
    k_mod<<<dim3(6144 / 256, 17), 256, 0, stream>>>(c, c_ctx, w_mod, b_mod, modv);
    k_modulate<<<(unsigned)((size_t)MT * DM / 4 / 256), 256, 0, stream>>>(x, ctx, modv, U);
    k_gemm_naive<EpiAB, false><<<dim3(N_AB / 64, MT / 64), 256, 0, stream>>>(U, DM, Wt_in, nullptr, 0, nullptr, DM, EpiAB{Pm, Pg, small, binp});
    k_mlstm_naive<<<256, 192, 0, stream>>>(Pm, small, conv_qk, hm);
    k_gla_naive<<<128, 256, 0, stream>>>(Pg, small, gw_f, gb_f, gw_b, gb_b, hg);
    k_gemm_naive<EpiSide, false><<<dim3(N_SIDE / 64, ML / 64), 256, 0, stream>>>(U, DM, Wt_in + (size_t)PC_SIDE * DM, nullptr, 0, nullptr, DM, EpiSide{side, binp});
    k_aprep<<<ML * 12 / 4, 256, 0, stream>>>(hm, hg, side, mnorm_g, gnorm_g);
    k_gemm_naive<EpiMerge, true><<<dim3(DM / 64, ML / 64), 256, 0, stream>>>(hm, DM, Wt_bm, hg, DM, Wt_bg, DM, EpiMerge{Z, side});
    k_gemm_naive<EpiOut, false><<<dim3(DM / 64, ML / 64), 256, 0, stream>>>(Z, DM, Wt_out, nullptr, 0, nullptr, DM, EpiOut{x, modv, out});
    k_ln1<<<ML / 4, 256, 0, stream>>>(out, ln1_g, ln1_b, modv, u2);
    k_gemm_naive<EpiUp, false><<<dim3(2 * DFF / 64, ML / 64), 256, 0, stream>>>(u2, DM, Wt_up, nullptr, 0, nullptr, DM, EpiUp{gate, val, b_up});
    k_convglu<<<(unsigned)((size_t)ML * DFF / 256), 256, 0, stream>>>(gate, val, cw, cb);
    k_gemm_naive<EpiDown, false><<<dim3(DM / 64, ML / 64), 256, 0, stream>>>(val, DFF, Wt_dn, nullptr, 0, nullptr, DFF, EpiDown{out, modv, b_down});
    k_ln2<<<ML / 4, 256, 0, stream>>>(out, ln2_g, ln2_b);
}
```

```cpp
#include <hip/hip_runtime.h>
#include <cstdio>
#include <cstdint>

typedef unsigned short bf16_t;

constexpr int DM = 1024, NB = 16, SEQ = 2048, CTX = 256, GW = 64;
constexpr int ML = NB * SEQ;
constexpr int MC = NB * CTX;
constexpr int MT = ML + MC;
constexpr int NIN = 9280, NINP = 9472;
constexpr int DFF = 2816;
constexpr float ALPHA = 1.189207115002721f;
constexpr float EPS = 1e-5f;
constexpr int PC_QM = 0, PC_KM = 1024, PC_VM = 2048, PC_SMALL = 3072, PC_QG = 3328, PC_KG = 3840, PC_VG = 4352, PC_SIDE = 5376;
constexpr int N_AB = 5376;
constexpr int N_SIDE = 4096;

constexpr size_t MiB = 1u << 20;
constexpr size_t WS_CTL = 0;
constexpr size_t WS_MOD = 1 * MiB;
constexpr size_t WS_BIN = WS_MOD + 512 * 1024;
constexpr size_t WS_WIN = 4 * MiB;
constexpr size_t WS_WBM = WS_WIN + (size_t)NINP * DM * 2;
constexpr size_t WS_WBG = WS_WBM + 2 * MiB;
constexpr size_t WS_WOUT = WS_WBG + 2 * MiB;
constexpr size_t WS_WUP = WS_WOUT + 2 * MiB;
constexpr size_t WS_WDN = WS_WUP + 11 * MiB;
constexpr size_t WS_U = 46 * MiB;
constexpr size_t WS_BIG = 118 * MiB;
constexpr size_t WS_END = 502 * MiB;
static_assert(WS_WDN + (size_t)DM * DFF * 2 <= WS_U, "weights fit");
constexpr size_t BIG_PM = 0;
constexpr size_t BIG_PG = 216 * MiB;
constexpr size_t BIG_SMALL = 360 * MiB;
constexpr size_t BIG_HG = 0;
constexpr size_t BIG_SIDE = 128 * MiB;
constexpr size_t BIG_GATE = 0;
constexpr size_t BIG_VAL = 176 * MiB;

__device__ __forceinline__ float bf2f(bf16_t v) { return __uint_as_float(((unsigned)v) << 16); }
__device__ __forceinline__ bf16_t f2bf(float f) { unsigned u = __float_as_uint(f); return (bf16_t)((u + 0x7fffu + ((u >> 16) & 1u)) >> 16); }
__device__ __forceinline__ float sigmoidf_(float x) { return 1.f / (1.f + __expf(-x)); }
__device__ __forceinline__ float siluf_(float x) { return x * sigmoidf_(x); }
__device__ __forceinline__ float logsigmoidf_(float x) { return fminf(x, 0.f) - log1pf(__expf(-fabsf(x))); }
__device__ __forceinline__ float gelu_tanh(float x) { const float u = 0.7978845608028654f * (x + 0.044715f * x * x * x); return 0.5f * x * (1.f + tanhf(u)); }
__device__ __forceinline__ float wave_sum(float v) {
#pragma unroll
    for (int o = 1; o < 64; o <<= 1) v += __shfl_xor(v, o);
    return v;
}

__global__ void __launch_bounds__(256) k_transpose_w(const float* __restrict__ W, int ldw, int K, int src_col0, int ncols, bf16_t* __restrict__ Wt, int dst_row0) {
    __shared__ float t[32][33];
    const int n0 = blockIdx.x * 32, k0 = blockIdx.y * 32, tx = threadIdx.x & 31, ty = threadIdx.x >> 5;
#pragma unroll
    for (int i = 0; i < 4; ++i) { const int k = k0 + ty + 8 * i; t[ty + 8 * i][tx] = W[(size_t)k * ldw + src_col0 + n0 + tx]; }
    __syncthreads();
#pragma unroll
    for (int i = 0; i < 4; ++i) { const int n = n0 + ty + 8 * i; Wt[(size_t)(dst_row0 + n) * K + k0 + tx] = f2bf(t[tx][ty + 8 * i]); }
}
__global__ void k_zero16(bf16_t* p, size_t n) { size_t i = (size_t)blockIdx.x * blockDim.x + threadIdx.x; if (i < n) p[i] = 0; }
__global__ void k_bias_perm(const float* __restrict__ b_in, float* __restrict__ bp) {
    const int j = blockIdx.x * blockDim.x + threadIdx.x; if (j >= NINP) return;
    int s = -1;
    if (j < 3072) s = j;
    else if (j < 3104) s = 4096 + (j - 3072);
    else if (j < 3136) s = 7200 + (j - 3104);
    else if (j < 3328) s = -1;
    else if (j < 3840) s = 4128 + (j - 3328);
    else if (j < 4352) s = 4640 + (j - 3840);
    else if (j < 5376) s = 5152 + (j - 4352);
    else if (j < 6400) s = 3072 + (j - 5376);
    else if (j < 7424) s = 6176 + (j - 6400);
    else if (j < 8448) s = 7232 + (j - 7424);
    else s = 8256 + (j - 8448);
    bp[j] = s >= 0 ? b_in[s] : 0.f;
}
__global__ void __launch_bounds__(256) k_mod(const float* __restrict__ c, const float* __restrict__ c_ctx, const float* __restrict__ w_mod, const float* __restrict__ b_mod, float* __restrict__ modv) {
    const int j = blockIdx.x * 256 + threadIdx.x, r = blockIdx.y;
    const float* cv = r < 16 ? c + r * DM : c_ctx;
    float acc = b_mod[j];
    for (int k = 0; k < DM; ++k) acc += siluf_(cv[k]) * w_mod[(size_t)k * 6144 + j];
    modv[r * 6144 + j] = acc;
}
__global__ void __launch_bounds__(256) k_modulate(const float* __restrict__ x, const float* __restrict__ ctx, const float* __restrict__ modv, bf16_t* __restrict__ U) {
    const size_t i = ((size_t)blockIdx.x * 256 + threadIdx.x) * 4;
    const int row = (int)(i / DM), d = (int)(i % DM);
    const float* src; int r;
    if (row < ML) { src = x + (size_t)row * DM + d; r = row / SEQ; } else { src = ctx + (size_t)(row - ML) * DM + d; r = 16; }
    const float4 v = *(const float4*)src; const float* mv = modv + r * 6144;
    const float4 sh = *(const float4*)(mv + d), sc = *(const float4*)(mv + 1024 + d);
    ushort4 o; o.x = f2bf(v.x * (1.f + sc.x) + sh.x); o.y = f2bf(v.y * (1.f + sc.y) + sh.y); o.z = f2bf(v.z * (1.f + sc.z) + sh.z); o.w = f2bf(v.w * (1.f + sc.w) + sh.w);
    *(ushort4*)(U + i) = o;
}

struct EpiAB {
    bf16_t* Pm; bf16_t* Pg; float* small; const float* bias;
    __device__ __forceinline__ void operator()(int row, int col, float v, float) const {
        v += bias[col];
        if (col < 3072) Pm[(size_t)row * 3072 + col] = f2bf(v);
        else if (col < 3328) { if (col < 3136) small[(size_t)row * 64 + (col - 3072)] = v; }
        else Pg[(size_t)row * 2048 + (col - 3328)] = f2bf(v);
    }
};
struct EpiSide { bf16_t* S; const float* bias;
    __device__ __forceinline__ void operator()(int row, int col, float v, float) const { S[(size_t)row * 4096 + col] = f2bf(v + bias[PC_SIDE + col]); } };
struct EpiMerge { bf16_t* Z; const bf16_t* side;
    __device__ __forceinline__ void operator()(int row, int col, float v1, float v2) const {
        const float ga = bf2f(side[(size_t)row * 4096 + 2048 + col]), gb = bf2f(side[(size_t)row * 4096 + 3072 + col]);
        Z[(size_t)row * DM + col] = f2bf(sigmoidf_(ga) * v1 + sigmoidf_(gb) * v2); } };
struct EpiOut { const float* x; const float* modv; float* r1;
    __device__ __forceinline__ void operator()(int row, int col, float v, float) const {
        const float g1 = modv[(row / SEQ) * 6144 + 2048 + col]; r1[(size_t)row * DM + col] = ALPHA * x[(size_t)row * DM + col] + g1 * v; } };
struct EpiUp { bf16_t* gate; bf16_t* val; const float* b_up;
    __device__ __forceinline__ void operator()(int row, int col, float v, float) const {
        v += b_up[col]; if (col < DFF) gate[(size_t)row * DFF + col] = f2bf(v); else val[(size_t)row * DFF + (col - DFF)] = f2bf(v); } };
struct EpiDown { float* h; const float* modv; const float* b_down;
    __device__ __forceinline__ void operator()(int row, int col, float v, float) const {
        const float g2 = modv[(row / SEQ) * 6144 + 5120 + col]; float* p = h + (size_t)row * DM + col; *p = ALPHA * (*p) + g2 * (v + b_down[col]); } };

template <class Epi, bool DUAL>
__global__ void __launch_bounds__(256) k_gemm_naive(const bf16_t* __restrict__ A, int lda, const bf16_t* __restrict__ Bt, const bf16_t* __restrict__ A2, int lda2, const bf16_t* __restrict__ Bt2, int K, Epi epi) {
    __shared__ float As[16][68], Bs[16][68];
    const int tx = threadIdx.x & 15, ty = threadIdx.x >> 4;
    const int m0 = blockIdx.y * 64, n0 = blockIdx.x * 64;
    const int lr = threadIdx.x >> 2, lk = (threadIdx.x & 3) * 4;
    float acc[4][4], acc2[4][4];
#pragma unroll
    for (int i = 0; i < 4; ++i)
#pragma unroll
        for (int j = 0; j < 4; ++j) { acc[i][j] = 0.f; acc2[i][j] = 0.f; }
    for (int pass = 0; pass < (DUAL ? 2 : 1); ++pass) {
        const bf16_t* Ap = pass ? A2 : A; const bf16_t* Bp = pass ? Bt2 : Bt; const int la = pass ? lda2 : lda;
        for (int k0 = 0; k0 < K; k0 += 16) {
            const ushort4 av = *(const ushort4*)(Ap + (size_t)(m0 + lr) * la + k0 + lk);
            const ushort4 bv = *(const ushort4*)(Bp + (size_t)(n0 + lr) * K + k0 + lk);
            As[lk + 0][lr] = bf2f(av.x); As[lk + 1][lr] = bf2f(av.y); As[lk + 2][lr] = bf2f(av.z); As[lk + 3][lr] = bf2f(av.w);
            Bs[lk + 0][lr] = bf2f(bv.x); Bs[lk + 1][lr] = bf2f(bv.y); Bs[lk + 2][lr] = bf2f(bv.z); Bs[lk + 3][lr] = bf2f(bv.w);
            __syncthreads();
#pragma unroll
            for (int k = 0; k < 16; ++k) {
                const float4 a = *(const float4*)&As[k][ty * 4], b = *(const float4*)&Bs[k][tx * 4];
                const float aa[4] = {a.x, a.y, a.z, a.w}, bb[4] = {b.x, b.y, b.z, b.w};
#pragma unroll
                for (int i = 0; i < 4; ++i)
#pragma unroll
                    for (int j = 0; j < 4; ++j) { if (pass == 0) acc[i][j] += aa[i] * bb[j]; else acc2[i][j] += aa[i] * bb[j]; }
            }
            __syncthreads();
        }
    }
#pragma unroll
    for (int i = 0; i < 4; ++i)
#pragma unroll
        for (int j = 0; j < 4; ++j) epi(m0 + ty * 4 + i, n0 + tx * 4 + j, acc[i][j], acc2[i][j]);
}


namespace pg8 {
#define PG8_LAS __attribute__((address_space(3)))
typedef short bf16x8 __attribute__((ext_vector_type(8)));
typedef float f32x4 __attribute__((ext_vector_type(4)));
typedef unsigned u32x4 __attribute__((ext_vector_type(4)));
constexpr int BM = 256, BK = 64, HALF = 128, HTB = HALF * BK * 2, STAGE_BYTES = 8 * HTB, NXCD = 8, WGM = 8;
__host__ __device__ __forceinline__ int lds_byte(int r, int c) { const int st = (r >> 4) * 2 + (c >> 5), rr = r & 15, cc = c & 31, ob = rr * 64 + cc * 2; return st * 1024 + (ob ^ (((ob >> 9) & 1) << 5)); }
__host__ __device__ __forceinline__ void stage_rc(int b, int& R, int& C) { const int st = b / 1024, sb = b % 1024, swz = sb ^ (((sb >> 9) & 1) << 5); R = (st >> 1) * 16 + swz / 64; C = (st & 1) * 32 + (swz % 64) / 2; }
__host__ __device__ __forceinline__ int perm32(int rho) { const int n = rho >> 4, i = rho & 15; return 8 * (i >> 2) + 4 * n + (i & 3); }
struct Unit { int pm, pn, tag; const bf16_t* A; const bf16_t* B; };
__host__ __device__ __forceinline__ bool tile_of(long L, int nM, int nN, int& pm, int& pn) {
    const int nwg = nM * nN; if (L >= nwg) return false;
    int wgid = (int)L; { const int q = nwg / NXCD, r = nwg % NXCD, xcd = wgid % NXCD, off = wgid / NXCD; wgid = (xcd < r ? xcd * (q + 1) : r * (q + 1) + (xcd - r) * q) + off; }
    const int nig = WGM * nN, gid = wgid / nig, fm = gid * WGM, gsz = (nM - fm) < WGM ? (nM - fm) : WGM;
    pm = fm + ((wgid % nig) % gsz); pn = (wgid % nig) / gsz; return true;
}
struct SchedPlain {
    const bf16_t* A; const bf16_t* Bt; int nM, nN, K, G, c, pad;
    __device__ __forceinline__ bool next(int i, Unit& u) const { if (!tile_of((long)i * G + c, nM, nN, u.pm, u.pn)) return false; u.tag = 1; u.A = A + (size_t)u.pm * BM * K; u.B = Bt + (size_t)u.pn * BM * K; return true; }
};
struct SchedDual {
    const bf16_t* A0; const bf16_t* B0; const bf16_t* A1; const bf16_t* B1; int nM, nN, K, G, c, pad;
    __device__ __forceinline__ bool next(int i, Unit& u) const { if (!tile_of((long)(i >> 1) * G + c, nM, nN, u.pm, u.pn)) return false; u.tag = i & 1;
        u.A = ((i & 1) ? A1 : A0) + (size_t)u.pm * BM * K; u.B = ((i & 1) ? B1 : B0) + (size_t)u.pn * BM * K; return true; }
};
__device__ __forceinline__ unsigned cvt_pk_bf16(float lo, float hi) { unsigned r; asm volatile("v_cvt_pk_bf16_f32 %0, %1, %2" : "=v"(r) : "v"(lo), "v"(hi)); return r; }
__device__ __forceinline__ u32x4 pack8(f32x4 v0, f32x4 v1) { u32x4 w; w.x = cvt_pk_bf16(v0[0], v0[1]); w.y = cvt_pk_bf16(v0[2], v0[3]); w.z = cvt_pk_bf16(v1[0], v1[1]); w.w = cvt_pk_bf16(v1[2], v1[3]); return w; }
__device__ __forceinline__ void unpack8(u32x4 w, f32x4& v0, f32x4& v1) {
    v0[0] = __uint_as_float(w.x << 16); v0[1] = __uint_as_float(w.x & 0xffff0000u); v0[2] = __uint_as_float(w.y << 16); v0[3] = __uint_as_float(w.y & 0xffff0000u);
    v1[0] = __uint_as_float(w.z << 16); v1[1] = __uint_as_float(w.z & 0xffff0000u); v1[2] = __uint_as_float(w.w << 16); v1[3] = __uint_as_float(w.w & 0xffff0000u); }

template <class Epi, class Sched>
__device__ __forceinline__ void gemm_phase(PG8_LAS unsigned char* lds, const int K, const Sched& S, const Epi& E) {
    const int tid = threadIdx.x, wid = __builtin_amdgcn_readfirstlane(tid >> 6), lane = tid & 63, wr = wid >> 2, wc = wid & 3, fr = lane & 15, fq = lane >> 4;
    const int nt = K / BK;
    unsigned voffA[2], voffB[2];
#pragma unroll
    for (int i = 0; i < 2; ++i) { int R, C; stage_rc(tid * 16 + i * 8192, R, C); const int Rb = (R & ~31) + perm32(R & 31);
        voffA[i] = (unsigned)(R * K + C) * 2u; voffB[i] = (unsigned)(Rb * K + C) * 2u; }
    const size_t kstep = (size_t)(BK * 2);
    const size_t hstep = (size_t)HALF * K * 2;
    const unsigned ldsw = (unsigned)wid * 1024u;
    const int aoff = lds_byte(wr * 64 + fr, fq * 8), boff = lds_byte(wc * 32 + fr, fq * 8);
#define PG8_SA(b, h) (((b) * 2 + (h)) * HTB)
#define PG8_SB(b, h) ((4 + (b) * 2 + (h)) * HTB)
#define PG8_STAGE(bufoff, gbase, voff) do { _Pragma("unroll") for (int _i = 0; _i < 2; ++_i) \
        __builtin_amdgcn_global_load_lds((const unsigned*)((const char*)(gbase) + (voff)[_i]), (PG8_LAS unsigned*)(lds + (bufoff) + ldsw + _i * 8192), 16, 0, 0); } while (0)
#define PG8_LDA(dst, b, h) do { _Pragma("unroll") for (int m = 0; m < 4; ++m) _Pragma("unroll") for (int k = 0; k < 2; ++k) dst[m][k] = *(const PG8_LAS bf16x8*)(lds + PG8_SA(b, h) + aoff + m * 2048 + k * 1024); } while (0)
#define PG8_LDB(dst, b, h) do { _Pragma("unroll") for (int n = 0; n < 2; ++n) _Pragma("unroll") for (int k = 0; k < 2; ++k) dst[n][k] = *(const PG8_LAS bf16x8*)(lds + PG8_SB(b, h) + boff + n * 2048 + k * 1024); } while (0)
#define PG8_MMA(ai, bj, At, Bt) do { __builtin_amdgcn_s_setprio(1); _Pragma("unroll") for (int m = 0; m < 4; ++m) _Pragma("unroll") for (int n = 0; n < 2; ++n) _Pragma("unroll") for (int k = 0; k < 2; ++k) \
        acc[ai][bj][m][n] = __builtin_amdgcn_mfma_f32_16x16x32_bf16(Bt[n][k], At[m][k], acc[ai][bj][m][n], 0, 0, 0); __builtin_amdgcn_s_setprio(0); } while (0)
#define PG8_WAIT_V(n) asm volatile("s_waitcnt vmcnt(" #n ")" ::: "memory")
#define PG8_WAIT_L(n) asm volatile("s_waitcnt lgkmcnt(" #n ")" ::: "memory")
#define PG8_BAR __builtin_amdgcn_s_barrier()
#define PG8_SCHED __builtin_amdgcn_sched_barrier(0)
    Unit cur, nxt; int ui = 0;
    if (!S.next(0, cur)) return;
    f32x4 acc[2][2][4][2];
#pragma unroll
    for (int a = 0; a < 2; ++a)
#pragma unroll
        for (int b = 0; b < 2; ++b)
#pragma unroll
            for (int m = 0; m < 4; ++m)
#pragma unroll
                for (int n = 0; n < 2; ++n) acc[a][b][m][n] = (f32x4){0.f, 0.f, 0.f, 0.f};
    bf16x8 At[4][2], B0[2][2], B1[2][2];
    const char* cA = (const char*)cur.A; const char* cB = (const char*)cur.B;
    PG8_STAGE(PG8_SB(0, 0), cB, voffB); PG8_STAGE(PG8_SB(0, 1), cB + hstep, voffB); PG8_STAGE(PG8_SA(0, 0), cA, voffA); PG8_STAGE(PG8_SA(0, 1), cA + hstep, voffA);
    if (wr == 1) PG8_BAR;
    PG8_WAIT_V(2); PG8_BAR;
    PG8_STAGE(PG8_SB(1, 0), cB + kstep, voffB); PG8_STAGE(PG8_SA(1, 0), cA + kstep, voffA); PG8_STAGE(PG8_SB(1, 1), cB + hstep + kstep, voffB);
    PG8_WAIT_V(6); PG8_BAR;
    for (;;) {
        const bool has_next = S.next(ui + 1, nxt);
        const char* nA = has_next ? (const char*)nxt.A : cA; const char* nB = has_next ? (const char*)nxt.B : cB;
        for (int t = 0; t < nt; t += 2) {
            const bool last = (t == nt - 2);
            const char* a1 = cA + (size_t)(t + 1) * kstep;
            const char* a2 = last ? nA : cA + (size_t)(t + 2) * kstep; const char* b2 = last ? nB : cB + (size_t)(t + 2) * kstep;
            const char* a3 = a2 + kstep; const char* b3 = b2 + kstep;
            PG8_LDB(B0, 0, 0); PG8_LDB(B1, 0, 1); PG8_SCHED; PG8_LDA(At, 0, 0); PG8_STAGE(PG8_SA(1, 1), a1 + hstep, voffA);
            PG8_WAIT_V(8); PG8_WAIT_L(0); PG8_BAR; PG8_MMA(0, 0, At, B0); PG8_MMA(0, 1, At, B1); PG8_BAR; PG8_SCHED;
            PG8_LDA(At, 0, 1); PG8_STAGE(PG8_SB(0, 0), b2, voffB); PG8_STAGE(PG8_SB(0, 1), b2 + hstep, voffB); PG8_STAGE(PG8_SA(0, 0), a2, voffA);
            PG8_WAIT_V(8); PG8_WAIT_L(0); PG8_BAR; PG8_MMA(1, 0, At, B0); PG8_MMA(1, 1, At, B1); PG8_BAR; PG8_SCHED;
            PG8_LDB(B0, 1, 0); PG8_LDB(B1, 1, 1); PG8_SCHED; PG8_LDA(At, 1, 0); PG8_STAGE(PG8_SA(0, 1), a2 + hstep, voffA);
            PG8_WAIT_V(8); PG8_WAIT_L(0); PG8_BAR; PG8_MMA(0, 0, At, B0); PG8_MMA(0, 1, At, B1); PG8_BAR; PG8_SCHED;
            PG8_LDA(At, 1, 1); PG8_STAGE(PG8_SB(1, 0), b3, voffB); PG8_STAGE(PG8_SB(1, 1), b3 + hstep, voffB); PG8_STAGE(PG8_SA(1, 0), a3, voffA);
            PG8_WAIT_V(8); PG8_WAIT_L(0); PG8_BAR; PG8_MMA(1, 0, At, B0); PG8_MMA(1, 1, At, B1); PG8_BAR; PG8_SCHED;
        }
        if (wr == 0) PG8_BAR;
        const bool keep = E(acc, cur, wr, wc, fr, fq);
        if (!has_next) break;
        if (!keep) {
#pragma unroll
            for (int a = 0; a < 2; ++a)
#pragma unroll
                for (int b = 0; b < 2; ++b)
#pragma unroll
                    for (int m = 0; m < 4; ++m)
#pragma unroll
                        for (int n = 0; n < 2; ++n) acc[a][b][m][n] = (f32x4){0.f, 0.f, 0.f, 0.f};
        }
        cur = nxt; cA = nA; cB = nB; ++ui;
        if (wr == 1) PG8_BAR;
    }
    PG8_WAIT_V(0);
    PG8_BAR;
#undef PG8_SA
#undef PG8_SB
#undef PG8_STAGE
#undef PG8_LDA
#undef PG8_LDB
#undef PG8_MMA
#undef PG8_WAIT_V
#undef PG8_WAIT_L
#undef PG8_BAR
#undef PG8_SCHED
}

#define PG8_FRAG_LOOP for (int ai = 0; ai < 2; ++ai) _Pragma("unroll") for (int m = 0; m < 4; ++m) _Pragma("unroll") for (int bj = 0; bj < 2; ++bj)
struct FEpiAB { bf16_t* Pm; bf16_t* Pg; float* small; const float* bias;
    __device__ __forceinline__ bool operator()(const f32x4 (&acc)[2][2][4][2], const Unit& u, int wr, int wc, int fr, int fq) const {
        const int row0 = u.pm * BM + wr * 64 + fr, ct = u.pn, cin = wc * 32 + 8 * fq;
        f32x4 bv[2][2];
#pragma unroll
        for (int bj = 0; bj < 2; ++bj)
#pragma unroll
            for (int n = 0; n < 2; ++n) bv[bj][n] = *(const f32x4*)(bias + ct * BM + cin + bj * HALF + 4 * n);
        if (ct == 12) {
            if (cin < 64) {
#pragma unroll
                for (int ai = 0; ai < 2; ++ai)
#pragma unroll
                    for (int m = 0; m < 4; ++m) { float* p = small + (size_t)(row0 + ai * HALF + m * 16) * 64 + cin;
                        *(f32x4*)p = acc[ai][0][m][0] + bv[0][0]; *(f32x4*)(p + 4) = acc[ai][0][m][1] + bv[0][1]; }
            }
            return false;
        }
        bf16_t* base; int ld;
        if (ct < 12) { base = Pm + ct * BM; ld = 3072; } else { base = Pg + (ct - 13) * BM; ld = 2048; }
#pragma unroll
        PG8_FRAG_LOOP { *(u32x4*)(base + (size_t)(row0 + ai * HALF + m * 16) * ld + cin + bj * HALF) = pack8(acc[ai][bj][m][0] + bv[bj][0], acc[ai][bj][m][1] + bv[bj][1]); }
        return false;
    }
};
struct FEpiBias { bf16_t* O; const float* bias; int ld, pad;
    __device__ __forceinline__ bool operator()(const f32x4 (&acc)[2][2][4][2], const Unit& u, int wr, int wc, int fr, int fq) const {
        const int row0 = u.pm * BM + wr * 64 + fr, col0 = u.pn * BM + wc * 32 + 8 * fq;
        f32x4 bv[2][2];
#pragma unroll
        for (int bj = 0; bj < 2; ++bj)
#pragma unroll
            for (int n = 0; n < 2; ++n) bv[bj][n] = *(const f32x4*)(bias + col0 + bj * HALF + 4 * n);
#pragma unroll
        PG8_FRAG_LOOP { *(u32x4*)(O + (size_t)(row0 + ai * HALF + m * 16) * ld + col0 + bj * HALF) = pack8(acc[ai][bj][m][0] + bv[bj][0], acc[ai][bj][m][1] + bv[bj][1]); }
        return false;
    }
};
struct FEpiUp { bf16_t* gate; bf16_t* val; const float* bias;
    __device__ __forceinline__ bool operator()(const f32x4 (&acc)[2][2][4][2], const Unit& u, int wr, int wc, int fr, int fq) const {
        const int row0 = u.pm * BM + wr * 64 + fr, cin = wc * 32 + 8 * fq;
        bf16_t* base = u.pn < 11 ? gate + u.pn * BM : val + (u.pn - 11) * BM;
        f32x4 bv[2][2];
#pragma unroll
        for (int bj = 0; bj < 2; ++bj)
#pragma unroll
            for (int n = 0; n < 2; ++n) bv[bj][n] = *(const f32x4*)(bias + u.pn * BM + cin + bj * HALF + 4 * n);
#pragma unroll
        PG8_FRAG_LOOP { *(u32x4*)(base + (size_t)(row0 + ai * HALF + m * 16) * DFF + cin + bj * HALF) = pack8(acc[ai][bj][m][0] + bv[bj][0], acc[ai][bj][m][1] + bv[bj][1]); }
        return false;
    }
};
__device__ __forceinline__ float fsig(float x) { return __builtin_amdgcn_rcpf(1.f + __expf(-x)); }
struct FEpiMerge { bf16_t* Z; const bf16_t* side;
    __device__ __forceinline__ bool operator()(f32x4 (&acc)[2][2][4][2], const Unit& u, int wr, int wc, int fr, int fq) const {
        const int row0 = u.pm * BM + wr * 64 + fr, col0 = u.pn * BM + wc * 32 + 8 * fq;
        if (u.tag == 0) {
#pragma unroll
            PG8_FRAG_LOOP { const bf16_t* sp = side + (size_t)(row0 + ai * HALF + m * 16) * 4096 + col0 + bj * HALF;
                f32x4 a0, a1, b0, b1; unpack8(*(const u32x4*)(sp + 2048), a0, a1); unpack8(*(const u32x4*)(sp + 3072), b0, b1);
#pragma unroll
                for (int j = 0; j < 4; ++j) { acc[ai][bj][m][0][j] *= (1.f + __expf(-b0[j])) * fsig(a0[j]); acc[ai][bj][m][1][j] *= (1.f + __expf(-b1[j])) * fsig(a1[j]); } }
            return true;
        }
#pragma unroll
        PG8_FRAG_LOOP { const bf16_t* sp = side + (size_t)(row0 + ai * HALF + m * 16) * 4096 + col0 + bj * HALF;
            f32x4 b0, b1; unpack8(*(const u32x4*)(sp + 3072), b0, b1); f32x4 v0 = acc[ai][bj][m][0], v1 = acc[ai][bj][m][1];
#pragma unroll
            for (int j = 0; j < 4; ++j) { v0[j] *= fsig(b0[j]); v1[j] *= fsig(b1[j]); }
            *(u32x4*)(Z + (size_t)(row0 + ai * HALF + m * 16) * DM + col0 + bj * HALF) = pack8(v0, v1); }
        return false;
    }
};
struct FEpiOut { const float* x; const float* modv; float* r1;
    __device__ __forceinline__ bool operator()(const f32x4 (&acc)[2][2][4][2], const Unit& u, int wr, int wc, int fr, int fq) const {
        const int row0 = u.pm * BM + wr * 64 + fr, col0 = u.pn * BM + wc * 32 + 8 * fq;
        const float* g = modv + (u.pm * BM / SEQ) * 6144 + 2048 + col0;
        f32x4 gv[2][2];
#pragma unroll
        for (int bj = 0; bj < 2; ++bj)
#pragma unroll
            for (int n = 0; n < 2; ++n) gv[bj][n] = *(const f32x4*)(g + bj * HALF + 4 * n);
#pragma unroll
        PG8_FRAG_LOOP { const size_t o = (size_t)(row0 + ai * HALF + m * 16) * DM + col0 + bj * HALF;
            const f32x4 x0 = *(const f32x4*)(x + o), x1 = *(const f32x4*)(x + o + 4);
            *(f32x4*)(r1 + o) = x0 * ALPHA + gv[bj][0] * acc[ai][bj][m][0]; *(f32x4*)(r1 + o + 4) = x1 * ALPHA + gv[bj][1] * acc[ai][bj][m][1]; }
        return false;
    }
};
struct FEpiDown { float* h; const float* modv; const float* b_down;
    __device__ __forceinline__ bool operator()(const f32x4 (&acc)[2][2][4][2], const Unit& u, int wr, int wc, int fr, int fq) const {
        const int row0 = u.pm * BM + wr * 64 + fr, col0 = u.pn * BM + wc * 32 + 8 * fq;
        const float* g = modv + (u.pm * BM / SEQ) * 6144 + 5120 + col0;
        f32x4 gv[2][2], bv[2][2];
#pragma unroll
        for (int bj = 0; bj < 2; ++bj)
#pragma unroll
            for (int n = 0; n < 2; ++n) { gv[bj][n] = *(const f32x4*)(g + bj * HALF + 4 * n); bv[bj][n] = *(const f32x4*)(b_down + col0 + bj * HALF + 4 * n); }
#pragma unroll
        PG8_FRAG_LOOP { float* p = h + (size_t)(row0 + ai * HALF + m * 16) * DM + col0 + bj * HALF;
            const f32x4 h0 = *(const f32x4*)p, h1 = *(const f32x4*)(p + 4);
            *(f32x4*)p = h0 * ALPHA + gv[bj][0] * (acc[ai][bj][m][0] + bv[bj][0]); *(f32x4*)(p + 4) = h1 * ALPHA + gv[bj][1] * (acc[ai][bj][m][1] + bv[bj][1]); }
        return false;
    }
};
}

constexpr int GEMM_LDS = pg8::STAGE_BYTES;
template <class Sched, class Epi>
__global__ void __launch_bounds__(512, 2) k_gemm_fast(Sched S0, Epi E) {
    extern __shared__ __attribute__((aligned(16))) unsigned char lds_dyn[];
    Sched S = S0; S.G = gridDim.x; S.c = blockIdx.x;
    pg8::gemm_phase<Epi, Sched>((PG8_LAS unsigned char*)lds_dyn, S.K, S, E);
}


namespace scan {
#define LAS __attribute__((address_space(3)))
typedef short bf16x8 __attribute__((ext_vector_type(8)));
typedef short s16x4 __attribute__((ext_vector_type(4)));
typedef float f32x4 __attribute__((ext_vector_type(4)));
typedef unsigned u32x4 __attribute__((ext_vector_type(4)));
typedef unsigned u32x2 __attribute__((ext_vector_type(2)));
constexpr int RS = 288, RSP = 144, RSE = 528;
constexpr int L_RAWQ = 0, L_RAWK = 17408, L_RAWV = 34816;
constexpr int L_Q = 51200, L_K = L_Q + 64 * RS, L_V = L_K + 64 * RS;
constexpr int L_SC = 106496;
constexpr int SC_EQ = 0, SC_EK = 64, SC_FL = 128, SC_QN = 192, SC_RS = 256  , SC_N = 384  , SC_MISC = 640, SC_DEC = 704  , SC_GB = 832  , SC_END = 960;
constexpr int L_RAWR = L_SC + SC_END * 4;
constexpr int L_GW = L_RAWR + 4096;
constexpr int L_E = L_GW + 8192;
constexpr int L_P = L_E;
constexpr int LDS_BYTES = L_E + 64 * RSE;
static_assert(LDS_BYTES <= 160 * 1024, "scan LDS");

typedef float f32x2_t __attribute__((ext_vector_type(2))); typedef __bf16 bf16x2_t __attribute__((ext_vector_type(2)));
__device__ __forceinline__ unsigned cvt_pk(float lo, float hi) { f32x2_t v = {lo, hi}; bf16x2_t b = __builtin_convertvector(v, bf16x2_t); return __builtin_bit_cast(unsigned, b); }
__device__ __forceinline__ s16x4 tr16(const LAS unsigned char* p) { return __builtin_bit_cast(s16x4, __builtin_amdgcn_ds_read_tr16_b64_v4i16((LAS s16x4*)p)); }
__device__ __forceinline__ bf16x8 cat4(s16x4 a, s16x4 b) { return (bf16x8){a[0], a[1], a[2], a[3], b[0], b[1], b[2], b[3]}; }
__device__ __forceinline__ void unpack8f(u32x4 w, float* v) {
    v[0] = __uint_as_float(w.x << 16); v[1] = __uint_as_float(w.x & 0xffff0000u); v[2] = __uint_as_float(w.y << 16); v[3] = __uint_as_float(w.y & 0xffff0000u);
    v[4] = __uint_as_float(w.z << 16); v[5] = __uint_as_float(w.z & 0xffff0000u); v[6] = __uint_as_float(w.w << 16); v[7] = __uint_as_float(w.w & 0xffff0000u); }
__device__ __forceinline__ float fsilu(float x) { return x * __builtin_amdgcn_rcpf(1.f + __expf(-x)); }

struct Args {
    const bf16_t* P; int ld, pad;
    const float* small;
    const float* conv_qk;
    const float* gw_f; const float* gb_f; const float* gw_b; const float* gb_b;
    bf16_t* hout;
};

template <bool GLA>
__device__ __forceinline__ void scan_item(LAS unsigned char* lds, const Args& a, const int item) {
    const int tid = threadIdx.x, lane = tid & 63, wid = __builtin_amdgcn_readfirstlane(tid >> 6), c = lane & 15, g = lane >> 4;
    LAS float* sc = (LAS float*)(lds + L_SC);
    int b, h, dir, half = 0;
    if (GLA) { half = item & 1; dir = (item >> 1) & 1; h = (item >> 2) & 3; b = item >> 4; } else { dir = item & 1; h = (item >> 1) & 7; b = item >> 4; }
    const int colq = GLA ? h * 128 : h * 128, colk = GLA ? 512 + h * 128 : 1024 + h * 128, colv = GLA ? 1024 + h * 256 + half * 128 : 2048 + h * 128;
    const int ocol = GLA ? h * 256 + half * 128 : h * 128;
    bf16_t* hout = a.hout + (size_t)dir * ML * DM;
    const float* gw = dir ? a.gw_b : a.gw_f; const float* gbp = dir ? a.gb_b : a.gb_f;

    for (int i = tid; i < 256; i += 512) sc[SC_N + i] = 0.f;
    if (GLA) {
        for (int i = tid; i < 2048; i += 512) { const int d = i >> 4, k = i & 15; ((LAS float*)(lds + L_GW))[i] = gw[k * 512 + h * 128 + d]; }
        if (tid < 128) sc[SC_GB + tid] = gbp[h * 128 + tid];
    }
    float wq[3][8], wk[3][8];
    if (!GLA) {
        const int cg = tid & 15;
#pragma unroll
        for (int e = 0; e < 8; ++e) { const int cq = h * 128 + cg * 8 + e, ck = 1024 + cq;
            const float q0 = a.conv_qk[cq], q1 = a.conv_qk[2048 + cq], q2 = a.conv_qk[4096 + cq], k0 = a.conv_qk[ck], k1 = a.conv_qk[2048 + ck], k2 = a.conv_qk[4096 + ck];
            wq[0][e] = dir ? q2 : q0; wq[1][e] = q1; wq[2][e] = dir ? q0 : q2; wk[0][e] = dir ? k2 : k0; wk[1][e] = k1; wk[2][e] = dir ? k0 : k2; }
    }
    f32x4 Cst[8]; f32x4 nst = (f32x4){0.f, 0.f, 0.f, 0.f};
#pragma unroll
    for (int j = 0; j < 8; ++j) Cst[j] = (f32x4){0.f, 0.f, 0.f, 0.f};
    float m_run = 0.f;
    float pre_li = 0.f, pre_lf = 0.f;

    auto seg_of = [](int cc) { return cc < 4 ? 0 : 1; };
#define SCAN_ROW(cc_, p_, rowv) do { const int seg_ = (cc_) < 4 ? 0 : 1; const int T_ = seg_ ? SEQ : CTX; const int row0_ = seg_ ? b * SEQ : ML + b * CTX; \
        int pp_ = (p_); pp_ = pp_ < 0 ? 0 : (pp_ > T_ - 1 ? T_ - 1 : pp_); const int t_ = dir ? (T_ - 1 - pp_) : pp_; rowv = row0_ + t_; } while (0)
#define SCAN_ISSUE(cc_) do { const int ci_ = (cc_) < 4 ? (cc_) : (cc_) - 4; \
        for (int n = wid; n < (GLA ? 54 : 50); n += 8) { \
            const int which = n < 17 ? 0 : (n < 34 ? 1 : (n < 50 ? 2 : 3)); const int nn = n - (which == 0 ? 0 : which == 1 ? 17 : which == 2 ? 34 : 50); \
            const int piece = nn * 64 + lane; int row; const char* src; unsigned dst; \
            if (which < 3) { const int j = piece >> 4, cgp = piece & 15; SCAN_ROW(cc_, ci_ * 64 + j - (which < 2 ? 1 : 0), row); \
                src = (const char*)(a.P + (size_t)row * a.ld + (which == 0 ? colq : which == 1 ? colk : colv) + cgp * 8); dst = (which == 0 ? L_RAWQ : which == 1 ? L_RAWK : L_RAWV) + nn * 1024; } \
            else { const int j = piece >> 2, part = piece & 3; SCAN_ROW(cc_, ci_ * 64 + j, row); src = (const char*)(a.small + (size_t)row * 64 + 32 + dir * 16 + part * 4); dst = L_RAWR + nn * 1024; } \
            __builtin_amdgcn_global_load_lds((const unsigned*)src, (LAS unsigned*)(lds + dst), 16, 0, 0); } \
        if (!GLA && wid == 0) { int row; SCAN_ROW(cc_, ci_ * 64 + lane, row); pre_li = a.small[(size_t)row * 64 + dir * 8 + h]; pre_lf = a.small[(size_t)row * 64 + 16 + dir * 8 + h]; } } while (0)

    SCAN_ISSUE(0);
    for (int cc = 0; cc < 36; ++cc) {
        const int seg = cc < 4 ? 0 : 1, ci = seg ? cc - 4 : cc, T = seg ? SEQ : CTX;
        const int par = cc & 1;
        asm volatile("s_waitcnt vmcnt(0)" ::: "memory");
        __syncthreads();
        if (!GLA) {
            if (wid == 0) {
                const float li = pre_li, lf = logsigmoidf_(pre_lf);
                float bs = lf;
#pragma unroll
                for (int o = 1; o < 64; o <<= 1) { const float v = __shfl_up(bs, o); if (lane >= o) bs += v; }
                const float gg = li - bs; float cm = gg;
#pragma unroll
                for (int o = 1; o < 64; o <<= 1) { const float v = __shfl_up(cm, o); if (lane >= o) cm = fmaxf(cm, v); }
                const float M = fmaxf(m_run, cm), M63 = __shfl(M, 63), b63 = __shfl(bs, 63);
                sc[SC_EQ + lane] = __expf(fminf(M63 - M, 80.f)) * 0.08838834764831845f;
                sc[SC_EK + lane] = __expf(gg - M63);
                sc[SC_FL + lane] = __expf(-(bs + M));
                if (lane == 0) sc[SC_MISC] = __expf(m_run - M63);
                m_run = b63 + M63;
            }
        } else {
            int prow; SCAN_ROW(cc, ci * 64 + lane, prow);
            const float* rr = a.small + (size_t)prow * 64 + 32 + dir * 16;
            float r[16];
#pragma unroll
            for (int i = 0; i < 4; ++i) { const f32x4 v = *(const f32x4*)(rr + 4 * i); r[4 * i] = v[0]; r[4 * i + 1] = v[1]; r[4 * i + 2] = v[2]; r[4 * i + 3] = v[3]; }
            for (int e = 0; e < 16; ++e) { const int d = wid * 16 + e; const LAS float* gwd = (const LAS float*)(lds + L_GW) + d * 16;
                float acc = sc[SC_GB + d];
#pragma unroll
                for (int i = 0; i < 4; ++i) { const f32x4 v = *(const LAS f32x4*)(gwd + 4 * i); acc += r[4 * i] * v[0] + r[4 * i + 1] * v[1] + r[4 * i + 2] * v[2] + r[4 * i + 3] * v[3]; }
                float bs = logsigmoidf_(acc) * 0.0625f;
#pragma unroll
                for (int o = 1; o < 64; o <<= 1) { const float v = __shfl_up(bs, o); if (lane >= o) bs += v; }
                const float be = __shfl(bs, 63);
                *(LAS float*)(lds + L_E + lane * RSE + d * 4) = bs - be;
                if (lane == 63) sc[SC_DEC + d] = __expf(be);
            }
        }
        __syncthreads();
#pragma unroll
        for (int it = 0; it < 2; ++it) {
            const int t = (tid >> 4) + 32 * it, cg = tid & 15; const int p = ci * 64 + t;
            const LAS unsigned char* rq = lds + L_RAWQ + (t + 1) * 256 + cg * 16; const LAS unsigned char* rk = lds + L_RAWK + (t + 1) * 256 + cg * 16;
            float xq[8], xk[8];
            if (!GLA) {
                float a0[8], a1[8], a2[8];
                const bool hp = p > 0, hn = p < T - 1;
                if (seg) {
                    unpack8f(*(const LAS u32x4*)(rq - 256), a0); unpack8f(*(const LAS u32x4*)rq, a1); unpack8f(*(const LAS u32x4*)(rq + 256), a2);
                    const float eq = sc[SC_EQ + t];
#pragma unroll
                    for (int e = 0; e < 8; ++e) xq[e] = fsilu(wq[1][e] * a1[e] + (hp ? wq[0][e] * a0[e] : 0.f) + (hn ? wq[2][e] * a2[e] : 0.f)) * eq;
                }
                unpack8f(*(const LAS u32x4*)(rk - 256), a0); unpack8f(*(const LAS u32x4*)rk, a1); unpack8f(*(const LAS u32x4*)(rk + 256), a2);
                const float ek = sc[SC_EK + t];
#pragma unroll
                for (int e = 0; e < 8; ++e) xk[e] = fsilu(wk[1][e] * a1[e] + (hp ? wk[0][e] * a0[e] : 0.f) + (hn ? wk[2][e] * a2[e] : 0.f)) * ek;
            } else {
                float a1[8], ev[8];
                const LAS float* ep = (const LAS float*)(lds + L_E + t * RSE) + cg * 8;
                { const f32x4 e0 = *(const LAS f32x4*)ep, e1 = *(const LAS f32x4*)(ep + 4); ev[0] = e0[0]; ev[1] = e0[1]; ev[2] = e0[2]; ev[3] = e0[3]; ev[4] = e1[0]; ev[5] = e1[1]; ev[6] = e1[2]; ev[7] = e1[3]; }
                if (seg) { unpack8f(*(const LAS u32x4*)rq, a1);
#pragma unroll
                    for (int e = 0; e < 8; ++e) xq[e] = a1[e] * 0.08838834764831845f * __expf(fminf(ev[e], 80.f)); }
                unpack8f(*(const LAS u32x4*)rk, a1);
#pragma unroll
                for (int e = 0; e < 8; ++e) xk[e] = a1[e] * __expf(-ev[e]);
            }
            if (seg) { u32x4 w; w.x = cvt_pk(xq[0], xq[1]); w.y = cvt_pk(xq[2], xq[3]); w.z = cvt_pk(xq[4], xq[5]); w.w = cvt_pk(xq[6], xq[7]); *(LAS u32x4*)(lds + L_Q + t * RS + cg * 16) = w; }
            { u32x4 w; w.x = cvt_pk(xk[0], xk[1]); w.y = cvt_pk(xk[2], xk[3]); w.z = cvt_pk(xk[4], xk[5]); w.w = cvt_pk(xk[6], xk[7]); *(LAS u32x4*)(lds + L_K + t * RS + cg * 16) = w; }
            *(LAS u32x4*)(lds + L_V + t * RS + cg * 16) = *(const LAS u32x4*)(lds + L_RAWV + t * 256 + cg * 16);
        }
        __syncthreads();
        if (cc + 1 < 36) SCAN_ISSUE(cc + 1);
        float dsc = 1.f;
        if (!GLA) { dsc = sc[SC_MISC];
#pragma unroll
            for (int j = 0; j < 8; ++j) Cst[j] *= dsc;
            nst *= dsc;
        } else {
#pragma unroll
            for (int j = 0; j < 8; ++j) { const f32x4 dv = *(const LAS f32x4*)(sc + SC_DEC + 32 * (j >> 1) + 8 * g + 4 * (j & 1)); Cst[j] *= dv; }
        }
        f32x4 O[4];
#pragma unroll
        for (int i = 0; i < 4; ++i) O[i] = (f32x4){0.f, 0.f, 0.f, 0.f};
        if (seg) {
            if (!GLA) {
                const int l = tid >> 3, part = tid & 7; const LAS unsigned char* qp = lds + L_Q + l * RS + part * 32; const LAS float* np = sc + SC_N + par * 128 + part * 16;
                float q[16]; unpack8f(*(const LAS u32x4*)qp, q); unpack8f(*(const LAS u32x4*)(qp + 16), q + 8);
                float s = 0.f;
#pragma unroll
                for (int i = 0; i < 4; ++i) { const f32x4 nv = *(const LAS f32x4*)(np + 4 * i); s += q[4 * i] * nv[0] + q[4 * i + 1] * nv[1] + q[4 * i + 2] * nv[2] + q[4 * i + 3] * nv[3]; }
                s += __shfl_xor(s, 1); s += __shfl_xor(s, 2); s += __shfl_xor(s, 4);
                if (part == 0) sc[SC_QN + l] = s * dsc;
            }
            const int lt = wid >> 1, sth = wid & 1;
            bf16x8 qf[4];
#pragma unroll
            for (int kk = 0; kk < 4; ++kk) qf[kk] = *(const LAS bf16x8*)(lds + L_Q + (16 * lt + c) * RS + (32 * kk + 8 * g) * 2);
            float rs = 0.f;
#pragma unroll
            for (int s2 = 0; s2 < 2; ++s2) { const int st = 2 * sth + s2;
                f32x4 acc = (f32x4){0.f, 0.f, 0.f, 0.f};
                if (st <= lt) {
#pragma unroll
                    for (int kk = 0; kk < 4; ++kk) { const bf16x8 kf = *(const LAS bf16x8*)(lds + L_K + (16 * st + c) * RS + (32 * kk + 8 * g) * 2); acc = __builtin_amdgcn_mfma_f32_16x16x32_bf16(kf, qf[kk], acc, 0, 0, 0); }
                    if (st == lt) {
#pragma unroll
                        for (int i = 0; i < 4; ++i) if (4 * g + i > c) acc[i] = 0.f;
                    }
                }
                rs += (acc[0] + acc[1]) + (acc[2] + acc[3]);
                u32x2 w; w.x = cvt_pk(acc[0], acc[1]); w.y = cvt_pk(acc[2], acc[3]);
                *(LAS u32x2*)(lds + L_P + (16 * lt + c) * RSP + (16 * st + 4 * g) * 2) = w;
            }
            if (!GLA) { rs += __shfl_xor(rs, 16); rs += __shfl_xor(rs, 32); if (g == 0) sc[SC_RS + sth * 64 + 16 * lt + c] = rs; }
#pragma unroll
            for (int kk = 0; kk < 4; ++kk) {
                u32x4 bw; bw.x = cvt_pk(Cst[2 * kk][0], Cst[2 * kk][1]); bw.y = cvt_pk(Cst[2 * kk][2], Cst[2 * kk][3]); bw.z = cvt_pk(Cst[2 * kk + 1][0], Cst[2 * kk + 1][1]); bw.w = cvt_pk(Cst[2 * kk + 1][2], Cst[2 * kk + 1][3]);
                const bf16x8 bfrag = __builtin_bit_cast(bf16x8, bw);
#pragma unroll
                for (int l4 = 0; l4 < 4; ++l4) { const bf16x8 af = *(const LAS bf16x8*)(lds + L_Q + (16 * l4 + c) * RS + (32 * kk + 8 * g) * 2); O[l4] = __builtin_amdgcn_mfma_f32_16x16x32_bf16(af, bfrag, O[l4], 0, 0, 0); }
            }
        }
        bf16x8 vf[2];
        {
            const int q = c >> 2, p = c & 3;
#pragma unroll
            for (int tt = 0; tt < 2; ++tt) { const LAS unsigned char* vp = lds + L_V + (32 * tt + 8 * g + q) * RS + (16 * wid + 4 * p) * 2; vf[tt] = cat4(tr16(vp), tr16(vp + 4 * RS)); }
            const bf16x8 ones = (bf16x8){0x3F80, 0x3F80, 0x3F80, 0x3F80, 0x3F80, 0x3F80, 0x3F80, 0x3F80};
#pragma unroll
            for (int j = 0; j < 8; ++j) {
#pragma unroll
                for (int tt = 0; tt < 2; ++tt) { const LAS unsigned char* kp = lds + L_K + (32 * tt + 8 * g + q) * RS + (32 * (j >> 1) + 8 * p + 4 * (j & 1)) * 2;
                    const bf16x8 kf = cat4(tr16(kp), tr16(kp + 4 * RS));
                    Cst[j] = __builtin_amdgcn_mfma_f32_16x16x32_bf16(kf, vf[tt], Cst[j], 0, 0, 0);
                    if (!GLA) { if (j == wid) nst = __builtin_amdgcn_mfma_f32_16x16x32_bf16(kf, ones, nst, 0, 0, 0); } }
            }
            if (!GLA) { if (c == 0) *(LAS f32x4*)(sc + SC_N + (par ^ 1) * 128 + 32 * (wid >> 1) + 8 * g + 4 * (wid & 1)) = nst; }
        }
        if (seg) {
            __syncthreads();
#pragma unroll
            for (int l4 = 0; l4 < 4; ++l4)
#pragma unroll
                for (int tt = 0; tt < 2; ++tt) { const bf16x8 af = *(const LAS bf16x8*)(lds + L_P + (16 * l4 + c) * RSP + (32 * tt + 8 * g) * 2); O[l4] = __builtin_amdgcn_mfma_f32_16x16x32_bf16(af, vf[tt], O[l4], 0, 0, 0); }
#pragma unroll
            for (int l4 = 0; l4 < 4; ++l4) {
                f32x4 o = O[l4];
                if (!GLA) { const int lb = 16 * l4 + 4 * g;
                    const f32x4 qn = *(const LAS f32x4*)(sc + SC_QN + lb), r0 = *(const LAS f32x4*)(sc + SC_RS + lb), r1 = *(const LAS f32x4*)(sc + SC_RS + 64 + lb), fl = *(const LAS f32x4*)(sc + SC_FL + lb);
#pragma unroll
                    for (int i = 0; i < 4; ++i) { const float den = fmaxf(fabsf(qn[i] + r0[i] + r1[i]), fl[i]); o[i] = o[i] * __builtin_amdgcn_rcpf(den); } }
#pragma unroll
                for (int i = 0; i < 4; ++i) { const int l = 16 * l4 + 4 * g + i; const int pp = ci * 64 + l; const int t = dir ? (T - 1 - pp) : pp;
                    hout[(size_t)(b * SEQ + t) * DM + ocol + 16 * wid + c] = f2bf(o[i]); }
            }
        }
    }
#undef SCAN_ROW
#undef SCAN_ISSUE
}
#undef LAS
}

template <bool GLA>
__global__ void __launch_bounds__(512, 2) k_scan_fast(scan::Args a) {
    extern __shared__ __attribute__((aligned(16))) unsigned char lds_dyn[];
    scan::scan_item<GLA>((__attribute__((address_space(3))) unsigned char*)lds_dyn, a, blockIdx.x);
}

__global__ void __launch_bounds__(192) k_mlstm_naive(const bf16_t* __restrict__ Pm, const float* __restrict__ small, const float* __restrict__ conv_qk, bf16_t* __restrict__ hm  ) {
    __shared__ float qs[128], ks[128], sden[2];
    const int bid = blockIdx.x, dir = bid & 1, h = (bid >> 1) & 7, b = bid >> 4, e = threadIdx.x;
    float C[128];
#pragma unroll
    for (int d = 0; d < 128; ++d) C[d] = 0.f;
    float m = 0.f;
    if (e < 128) qs[e] = 0.f;
    float wq0 = 0, wq1 = 0, wq2 = 0, wk0 = 0, wk1 = 0, wk2 = 0;
    if (e < 128) { const int cq = h * 128 + e, ck = 1024 + h * 128 + e;
        wq0 = conv_qk[cq]; wq1 = conv_qk[2048 + cq]; wq2 = conv_qk[4096 + cq]; wk0 = conv_qk[ck]; wk1 = conv_qk[2048 + ck]; wk2 = conv_qk[4096 + ck]; }
    bf16_t* hout = hm + (size_t)dir * ML * DM;
    for (int seg = 0; seg < 2; ++seg) {
        const int T = seg ? SEQ : CTX; const int row0 = seg ? b * SEQ : ML + b * CTX;
        for (int s = 0; s < T; ++s) {
            const int t = dir ? (T - 1 - s) : s; const int row = row0 + t;
            if (e < 128) {
                const bf16_t* p = Pm + (size_t)row * 3072 + h * 128 + e;
                const float k1 = bf2f(p[1024]), k0 = t > 0 ? bf2f(p[1024 - 3072]) : 0.f, k2 = t < T - 1 ? bf2f(p[1024 + 3072]) : 0.f;
                ks[e] = siluf_(wk0 * k0 + wk1 * k1 + wk2 * k2);
                if (seg) { const float q1 = bf2f(p[0]), q0 = t > 0 ? bf2f(p[-3072]) : 0.f, q2 = t < T - 1 ? bf2f(p[3072]) : 0.f;
                    qs[e] = siluf_(wq0 * q0 + wq1 * q1 + wq2 * q2) * 0.08838834764831845f; }
            }
            const float li = small[(size_t)row * 64 + dir * 8 + h], lf = logsigmoidf_(small[(size_t)row * 64 + 16 + dir * 8 + h]);
            const float mn = fmaxf(lf + m, li), fd = __expf(lf + m - mn), iw = __expf(li - mn);
            const float ve = e < 128 ? bf2f(Pm[(size_t)row * 3072 + 2048 + h * 128 + e]) : 1.f;
            __syncthreads();
            float acc = 0.f;
            if (e <= 128) {
                const float a = iw * ve;
#pragma unroll
                for (int d = 0; d < 128; ++d) { C[d] = fd * C[d] + ks[d] * a; acc += qs[d] * C[d]; }
            }
            if (seg) {
                if (e == 128) sden[0] = acc;
                __syncthreads();
                if (e < 128) { const float den = fmaxf(fabsf(sden[0]), __expf(-mn)); hout[(size_t)row * DM + h * 128 + e] = f2bf(acc / den); }
            }
            m = mn;
            __syncthreads();
        }
    }
}

__global__ void __launch_bounds__(256) k_gla_naive(const bf16_t* __restrict__ Pg, const float* __restrict__ small, const float* __restrict__ gw_f, const float* __restrict__ gb_f,
                                                   const float* __restrict__ gw_b, const float* __restrict__ gb_b, bf16_t* __restrict__ hg  ) {
    __shared__ float qs[128], ks[128], al[128];
    const int bid = blockIdx.x, dir = bid & 1, h = (bid >> 1) & 3, b = bid >> 3, e = threadIdx.x;
    float S[128];
#pragma unroll
    for (int d = 0; d < 128; ++d) S[d] = 0.f;
    const float* gw = dir ? gw_b : gw_f; const float* gb = dir ? gb_b : gb_f;
    float w[16]; float gbv = 0.f;
    if (e < 128) { gbv = gb[h * 128 + e];
#pragma unroll
        for (int i = 0; i < 16; ++i) w[i] = gw[i * 512 + h * 128 + e]; }
    bf16_t* hout = hg + (size_t)dir * ML * DM;
    for (int seg = 0; seg < 2; ++seg) {
        const int T = seg ? SEQ : CTX; const int row0 = seg ? b * SEQ : ML + b * CTX;
        for (int s = 0; s < T; ++s) {
            const int t = dir ? (T - 1 - s) : s; const int row = row0 + t;
            if (e < 128) {
                const float* r = small + (size_t)row * 64 + 32 + dir * 16; float a = gbv;
#pragma unroll
                for (int i = 0; i < 16; ++i) a += r[i] * w[i];
                al[e] = __expf(logsigmoidf_(a) * (1.f / 16.f));
                qs[e] = bf2f(Pg[(size_t)row * 2048 + h * 128 + e]) * 0.08838834764831845f;
                ks[e] = bf2f(Pg[(size_t)row * 2048 + 512 + h * 128 + e]);
            }
            const float ve = bf2f(Pg[(size_t)row * 2048 + 1024 + h * 256 + e]);
            __syncthreads();
            float acc = 0.f;
#pragma unroll
            for (int d = 0; d < 128; ++d) { S[d] = al[d] * S[d] + ks[d] * ve; acc += qs[d] * S[d]; }
            if (seg) hout[(size_t)row * DM + h * 256 + e] = f2bf(acc);
            __syncthreads();
        }
    }
}

__global__ void __launch_bounds__(256) k_aprep(bf16_t* __restrict__ hm, bf16_t* __restrict__ hg, const bf16_t* __restrict__ side, const float* __restrict__ gm, const float* __restrict__ gg) {
    const int gwv = blockIdx.x * 4 + (threadIdx.x >> 6), lane = threadIdx.x & 63;
    const int row = gwv / 12, u = gwv % 12;
    if (u < 8) {
        const int c0 = u * 128 + lane * 2; const size_t o = (size_t)row * DM + c0;
        float v0 = bf2f(hm[o]) + bf2f(hm[o + (size_t)ML * DM]), v1 = bf2f(hm[o + 1]) + bf2f(hm[o + 1 + (size_t)ML * DM]);
        const float mean = wave_sum(v0 + v1) * (1.f / 128.f); v0 -= mean; v1 -= mean;
        const float rstd = rsqrtf(wave_sum(v0 * v0 + v1 * v1) * (1.f / 128.f) + EPS);
        const float o0 = bf2f(side[(size_t)row * 4096 + c0]), o1 = bf2f(side[(size_t)row * 4096 + c0 + 1]);
        hm[o] = f2bf(v0 * rstd * gm[c0] * sigmoidf_(o0)); hm[o + 1] = f2bf(v1 * rstd * gm[c0 + 1] * sigmoidf_(o1));
    } else {
        const int hh = u - 8; const int c0 = hh * 256 + lane * 4; const size_t o = (size_t)row * DM + c0;
        float v[4]; float ss = 0.f;
#pragma unroll
        for (int i = 0; i < 4; ++i) { v[i] = bf2f(hg[o + i]) + bf2f(hg[o + i + (size_t)ML * DM]); ss += v[i] * v[i]; }
        const float rstd = rsqrtf(wave_sum(ss) * (1.f / 256.f) + EPS);
#pragma unroll
        for (int i = 0; i < 4; ++i) { const float z = bf2f(side[(size_t)row * 4096 + 1024 + c0 + i]); hg[o + i] = f2bf(v[i] * rstd * gg[c0 + i] * siluf_(z)); }
    }
}

__global__ void __launch_bounds__(256) k_ln1(float* __restrict__ r1, const float* __restrict__ g, const float* __restrict__ bta, const float* __restrict__ modv, bf16_t* __restrict__ u2) {
    const int row = blockIdx.x * 4 + (threadIdx.x >> 6), lane = threadIdx.x & 63; float* p = r1 + (size_t)row * DM; const float* mv = modv + (row / SEQ) * 6144;
    float4 v[4]; float s = 0.f;
#pragma unroll
    for (int j = 0; j < 4; ++j) { v[j] = *(const float4*)(p + j * 256 + lane * 4); s += v[j].x + v[j].y + v[j].z + v[j].w; }
    const float mean = wave_sum(s) * (1.f / DM); float q = 0.f;
#pragma unroll
    for (int j = 0; j < 4; ++j) { v[j].x -= mean; v[j].y -= mean; v[j].z -= mean; v[j].w -= mean; q += v[j].x * v[j].x + v[j].y * v[j].y + v[j].z * v[j].z + v[j].w * v[j].w; }
    const float rstd = rsqrtf(wave_sum(q) * (1.f / DM) + EPS);
#pragma unroll
    for (int j = 0; j < 4; ++j) { const int c = j * 256 + lane * 4; const float4 gg = *(const float4*)(g + c), bb = *(const float4*)(bta + c), sh = *(const float4*)(mv + 3072 + c), sc = *(const float4*)(mv + 4096 + c);
        float4 o; o.x = v[j].x * rstd * gg.x + bb.x; o.y = v[j].y * rstd * gg.y + bb.y; o.z = v[j].z * rstd * gg.z + bb.z; o.w = v[j].w * rstd * gg.w + bb.w;
        *(float4*)(p + c) = o;
        ushort4 w; w.x = f2bf(o.x * (1.f + sc.x) + sh.x); w.y = f2bf(o.y * (1.f + sc.y) + sh.y); w.z = f2bf(o.z * (1.f + sc.z) + sh.z); w.w = f2bf(o.w * (1.f + sc.w) + sh.w);
        *(ushort4*)(u2 + (size_t)row * DM + c) = w; }
}
__global__ void __launch_bounds__(256) k_ln2(float* __restrict__ r2, const float* __restrict__ g, const float* __restrict__ bta) {
    const int row = blockIdx.x * 4 + (threadIdx.x >> 6), lane = threadIdx.x & 63; float* p = r2 + (size_t)row * DM;
    float4 v[4]; float s = 0.f;
#pragma unroll
    for (int j = 0; j < 4; ++j) { v[j] = *(const float4*)(p + j * 256 + lane * 4); s += v[j].x + v[j].y + v[j].z + v[j].w; }
    const float mean = wave_sum(s) * (1.f / DM); float q = 0.f;
#pragma unroll
    for (int j = 0; j < 4; ++j) { v[j].x -= mean; v[j].y -= mean; v[j].z -= mean; v[j].w -= mean; q += v[j].x * v[j].x + v[j].y * v[j].y + v[j].z * v[j].z + v[j].w * v[j].w; }
    const float rstd = rsqrtf(wave_sum(q) * (1.f / DM) + EPS);
#pragma unroll
    for (int j = 0; j < 4; ++j) { const int c = j * 256 + lane * 4; const float4 gg = *(const float4*)(g + c), bb = *(const float4*)(bta + c);
        float4 o; o.x = v[j].x * rstd * gg.x + bb.x; o.y = v[j].y * rstd * gg.y + bb.y; o.z = v[j].z * rstd * gg.z + bb.z; o.w = v[j].w * rstd * gg.w + bb.w;
        *(float4*)(p + c) = o; }
}

__global__ void __launch_bounds__(256) k_convglu(const bf16_t* __restrict__ gate, bf16_t* __restrict__ val, const float* __restrict__ cw  , const float* __restrict__ cb) {
    const size_t i = (size_t)blockIdx.x * 256 + threadIdx.x;
    const int row = (int)(i / DFF), ch = (int)(i % DFF);
    const int b = row / SEQ, t = row % SEQ, r = t / GW, c = t % GW;
    float acc = cb[ch];
#pragma unroll
    for (int di = 0; di < 3; ++di)
#pragma unroll
        for (int dj = 0; dj < 3; ++dj) { const int rr = r + di - 1, cc = c + dj - 1;
            if (rr >= 0 && rr < SEQ / GW && cc >= 0 && cc < GW) acc += bf2f(gate[((size_t)b * SEQ + rr * GW + cc) * DFF + ch]) * cw[(di * 3 + dj) * DFF + ch]; }
    val[i] = f2bf(gelu_tanh(acc) * bf2f(val[i]));
}


static bool g_fail = false;
template <bool GLA> static void launch_scan(scan::Args a, hipStream_t stream) {
    auto kern = k_scan_fast<GLA>;
    static bool attr_set = false;
    if (!attr_set) { if (hipFuncSetAttribute((const void*)kern, hipFuncAttributeMaxDynamicSharedMemorySize, scan::LDS_BYTES) != hipSuccess) g_fail = true; attr_set = true; }
    hipLaunchKernelGGL(kern, dim3(256), dim3(512), scan::LDS_BYTES, stream, a);
    if (hipPeekAtLastError() != hipSuccess) g_fail = true;
}
template <class Sched, class Epi> static void launch_gemm(Sched S, Epi E, hipStream_t stream) {
    auto kern = k_gemm_fast<Sched, Epi>;
    static bool attr_set = false;
    if (!attr_set) { (void)hipFuncSetAttribute((const void*)kern, hipFuncAttributeMaxDynamicSharedMemorySize, GEMM_LDS); attr_set = true; }
    hipLaunchKernelGGL(kern, dim3(256), dim3(512), GEMM_LDS, stream, S, E);
}
extern "C" void kernel_launch(void* const* d_in, const int* in_sizes, int n_in, void* d_out, int out_size, void* d_ws, size_t ws_size, hipStream_t stream) {
    if (n_in != 28 || out_size != ML * DM || ws_size < WS_END) { fprintf(stderr, "kernel_launch: unexpected shapes n_in %d out %d ws %zu\n", n_in, out_size, ws_size); return; }
    const float* x = (const float*)d_in[0]; const float* c = (const float*)d_in[1]; const float* ctx = (const float*)d_in[2]; const float* c_ctx = (const float*)d_in[3];
    const float* w_mod = (const float*)d_in[4]; const float* b_mod = (const float*)d_in[5]; const float* w_in = (const float*)d_in[6]; const float* b_in = (const float*)d_in[7];
    const float* conv_qk = (const float*)d_in[8]; const float* gw_f = (const float*)d_in[9]; const float* gb_f = (const float*)d_in[10]; const float* gw_b = (const float*)d_in[11]; const float* gb_b = (const float*)d_in[12];
    const float* mnorm_g = (const float*)d_in[13]; const float* gnorm_g = (const float*)d_in[14]; const float* w_bm = (const float*)d_in[15]; const float* w_bg = (const float*)d_in[16]; const float* w_out = (const float*)d_in[17];
    const float* ln1_g = (const float*)d_in[18]; const float* ln1_b = (const float*)d_in[19]; const float* w_up = (const float*)d_in[20]; const float* b_up = (const float*)d_in[21];
    const float* cw = (const float*)d_in[22]; const float* cb = (const float*)d_in[23]; const float* w_down = (const float*)d_in[24]; const float* b_down = (const float*)d_in[25];
    const float* ln2_g = (const float*)d_in[26]; const float* ln2_b = (const float*)d_in[27];
    unsigned char* ws = (unsigned char*)d_ws; float* out = (float*)d_out;
    float* modv = (float*)(ws + WS_MOD); float* binp = (float*)(ws + WS_BIN);
    bf16_t* Wt_in = (bf16_t*)(ws + WS_WIN); bf16_t* Wt_bm = (bf16_t*)(ws + WS_WBM); bf16_t* Wt_bg = (bf16_t*)(ws + WS_WBG); bf16_t* Wt_out = (bf16_t*)(ws + WS_WOUT);
    bf16_t* Wt_up = (bf16_t*)(ws + WS_WUP); bf16_t* Wt_dn = (bf16_t*)(ws + WS_WDN);
    bf16_t* U = (bf16_t*)(ws + WS_U); unsigned char* big = ws + WS_BIG;
    bf16_t* Pm = (bf16_t*)(big + BIG_PM); bf16_t* Pg = (bf16_t*)(big + BIG_PG); float* small = (float*)(big + BIG_SMALL);
    bf16_t* hm = (bf16_t*)d_out; bf16_t* hg = (bf16_t*)(big + BIG_HG); bf16_t* side = (bf16_t*)(big + BIG_SIDE);
    bf16_t* gate = (bf16_t*)(big + BIG_GATE); bf16_t* val = (bf16_t*)(big + BIG_VAL);
    bf16_t* Z = U; bf16_t* u2 = U;

    struct Seg { int src, n, dst; };
    const Seg segs[11] = {{0, 3072, 0}, {4096, 32, 3072}, {7200, 32, 3104}, {4128, 512, 3328}, {4640, 512, 3840}, {5152, 1024, 4352}, {3072, 1024, 5376}, {6176, 1024, 6400}, {7232, 1024, 7424}, {8256, 1024, 8448}, {0, 0, 0}};
    k_zero16<<<(192 * 1024 + 255) / 256, 256, 0, stream>>>(Wt_in + (size_t)3136 * DM, (size_t)192 * DM);
    for (int i = 0; i < 10; ++i) k_transpose_w<<<dim3(segs[i].n / 32, DM / 32), 256, 0, stream>>>(w_in, NIN, DM, segs[i].src, segs[i].n, Wt_in, segs[i].dst);
    k_transpose_w<<<dim3(DM / 32, DM / 32), 256, 0, stream>>>(w_bm, DM, DM, 0, DM, Wt_bm, 0);
    k_transpose_w<<<dim3(DM / 32, DM / 32), 256, 0, stream>>>(w_bg, DM, DM, 0, DM, Wt_bg, 0);
    k_transpose_w<<<dim3(DM / 32, DM / 32), 256, 0, stream>>>(w_out, DM, DM, 0, DM, Wt_out, 0);
    k_transpose_w<<<dim3(2 * DFF / 32, DM / 32), 256, 0, stream>>>(w_up, 2 * DFF, DM, 0, 2 * DFF, Wt_up, 0);
    k_transpose_w<<<dim3(DM / 32, DFF / 32), 256, 0, stream>>>(w_down, DM, DFF, 0, DM, Wt_dn, 0);
    k_bias_perm<<<(NINP + 255) / 256, 256, 0, stream>>>(b_in, binp);
    k_mod<<<dim3(6144 / 256, 17), 256, 0, stream>>>(c, c_ctx, w_mod, b_mod, modv);
    k_modulate<<<(unsigned)((size_t)MT * DM / 4 / 256), 256, 0, stream>>>(x, ctx, modv, U);
    launch_gemm(pg8::SchedPlain{U, Wt_in, MT / 256, N_AB / 256, DM, 0, 0, 0}, pg8::FEpiAB{Pm, Pg, small, binp}, stream);
    launch_scan<false>(scan::Args{Pm, 3072, 0, small, conv_qk, gw_f, gb_f, gw_b, gb_b, hm}, stream);
    launch_scan<true>(scan::Args{Pg, 2048, 0, small, conv_qk, gw_f, gb_f, gw_b, gb_b, hg}, stream);
    launch_gemm(pg8::SchedPlain{U, Wt_in + (size_t)PC_SIDE * DM, ML / 256, N_SIDE / 256, DM, 0, 0, 0}, pg8::FEpiBias{side, binp + PC_SIDE, 4096, 0}, stream);
    k_aprep<<<ML * 12 / 4, 256, 0, stream>>>(hm, hg, side, mnorm_g, gnorm_g);
    launch_gemm(pg8::SchedDual{hm, Wt_bm, hg, Wt_bg, ML / 256, DM / 256, DM, 0, 0, 0}, pg8::FEpiMerge{Z, side}, stream);
    launch_gemm(pg8::SchedPlain{Z, Wt_out, ML / 256, DM / 256, DM, 0, 0, 0}, pg8::FEpiOut{x, modv, out}, stream);
    k_ln1<<<ML / 4, 256, 0, stream>>>(out, ln1_g, ln1_b, modv, u2);
    launch_gemm(pg8::SchedPlain{u2, Wt_up, ML / 256, 2 * DFF / 256, DM, 0, 0, 0}, pg8::FEpiUp{gate, val, b_up}, stream);
    k_convglu<<<(unsigned)((size_t)ML * DFF / 256), 256, 0, stream>>>(gate, val, cw, cb);
    launch_gemm(pg8::SchedPlain{val, Wt_dn, ML / 256, DM / 256, DFF, 0, 0, 0}, pg8::FEpiDown{out, modv, b_down}, stream);
    k_ln2<<<ML / 4, 256, 0, stream>>>(out, ln2_g, ln2_b);
    if (g_fail) (void)hipMemsetAsync(d_out, 0, (size_t)ML * DM * 4, stream);
}
```

```cpp
#include <hip/hip_runtime.h>
#include <cstdio>
#include <cstdint>

typedef unsigned short bf16_t;

constexpr int DM = 1024, NB = 16, SEQ = 2048, CTX = 256, GW = 64;
constexpr int ML = NB * SEQ;
constexpr int MC = NB * CTX;
constexpr int MT = ML + MC;
constexpr int NIN = 9280, NINP = 9472;
constexpr int DFF = 2816;
constexpr float ALPHA = 1.189207115002721f;
constexpr float EPS = 1e-5f;
constexpr int PC_QM = 0, PC_KM = 1024, PC_VM = 2048, PC_SMALL = 3072, PC_QG = 3328, PC_KG = 3840, PC_VG = 4352, PC_SIDE = 5376;
constexpr int N_AB = 5376;
constexpr int N_SIDE = 4096;

constexpr size_t MiB = 1u << 20;
constexpr size_t WS_CTL = 0;
constexpr size_t WS_MOD = 1 * MiB;
constexpr size_t WS_BIN = WS_MOD + 512 * 1024;
constexpr size_t WS_WIN = 4 * MiB;
constexpr size_t WS_WBM = WS_WIN + (size_t)NINP * DM * 2;
constexpr size_t WS_WBG = WS_WBM + 2 * MiB;
constexpr size_t WS_WOUT = WS_WBG + 2 * MiB;
constexpr size_t WS_WUP = WS_WOUT + 2 * MiB;
constexpr size_t WS_WDN = WS_WUP + 11 * MiB;
constexpr size_t WS_U = 46 * MiB;
constexpr size_t WS_BIG = 118 * MiB;
constexpr size_t WS_END = 502 * MiB;
static_assert(WS_WDN + (size_t)DM * DFF * 2 <= WS_U, "weights fit");
constexpr size_t BIG_PM = 0;
constexpr size_t BIG_PG = 216 * MiB;
constexpr size_t BIG_SMALL = 360 * MiB;
constexpr size_t BIG_HG = 0;
constexpr size_t BIG_SIDE = 128 * MiB;
constexpr size_t BIG_GATE = 0;
constexpr size_t BIG_VAL = 176 * MiB;

__device__ __forceinline__ float bf2f(bf16_t v) { return __uint_as_float(((unsigned)v) << 16); }
__device__ __forceinline__ bf16_t f2bf(float f) { unsigned u = __float_as_uint(f); return (bf16_t)((u + 0x7fffu + ((u >> 16) & 1u)) >> 16); }
__device__ __forceinline__ float sigmoidf_(float x) { return 1.f / (1.f + __expf(-x)); }
__device__ __forceinline__ float siluf_(float x) { return x * sigmoidf_(x); }
__device__ __forceinline__ float logsigmoidf_(float x) { return fminf(x, 0.f) - log1pf(__expf(-fabsf(x))); }
__device__ __forceinline__ float gelu_tanh(float x) { const float u = 0.7978845608028654f * (x + 0.044715f * x * x * x); return 0.5f * x * (1.f + tanhf(u)); }
__device__ __forceinline__ float wave_sum(float v) {
#pragma unroll
    for (int o = 1; o < 64; o <<= 1) v += __shfl_xor(v, o);
    return v;
}

namespace pg8 {
#define PG8_LAS __attribute__((address_space(3)))
typedef short bf16x8 __attribute__((ext_vector_type(8)));
typedef float f32x4 __attribute__((ext_vector_type(4)));
typedef unsigned u32x4 __attribute__((ext_vector_type(4)));
constexpr int BM = 256, BK = 64, HALF = 128, HTB = HALF * BK * 2, STAGE_BYTES = 8 * HTB, NXCD = 8, WGM = 8;
__host__ __device__ __forceinline__ int lds_byte(int r, int c) { const int st = (r >> 4) * 2 + (c >> 5), rr = r & 15, cc = c & 31, ob = rr * 64 + cc * 2; return st * 1024 + (ob ^ (((ob >> 9) & 1) << 5)); }
__host__ __device__ __forceinline__ void stage_rc(int b, int& R, int& C) { const int st = b / 1024, sb = b % 1024, swz = sb ^ (((sb >> 9) & 1) << 5); R = (st >> 1) * 16 + swz / 64; C = (st & 1) * 32 + (swz % 64) / 2; }
__host__ __device__ __forceinline__ int perm32(int rho) { const int n = rho >> 4, i = rho & 15; return 8 * (i >> 2) + 4 * n + (i & 3); }
struct Unit { int pm, pn, tag; const bf16_t* A; const bf16_t* B; };
__host__ __device__ __forceinline__ bool tile_of(long L, int nM, int nN, int& pm, int& pn) {
    const int nwg = nM * nN; if (L >= nwg) return false;
    int wgid = (int)L; { const int q = nwg / NXCD, r = nwg % NXCD, xcd = wgid % NXCD, off = wgid / NXCD; wgid = (xcd < r ? xcd * (q + 1) : r * (q + 1) + (xcd - r) * q) + off; }
    const int nig = WGM * nN, gid = wgid / nig, fm = gid * WGM, gsz = (nM - fm) < WGM ? (nM - fm) : WGM;
    pm = fm + ((wgid % nig) % gsz); pn = (wgid % nig) / gsz; return true;
}
struct SchedPlain {
    const bf16_t* A; const bf16_t* Bt; int nM, nN, K, G, c, pad;
    __device__ __forceinline__ bool next(int i, Unit& u) const { if (!tile_of((long)i * G + c, nM, nN, u.pm, u.pn)) return false; u.tag = 1; u.A = A + (size_t)u.pm * BM * K; u.B = Bt + (size_t)u.pn * BM * K; return true; }
};
struct SchedDual {
    const bf16_t* A0; const bf16_t* B0; const bf16_t* A1; const bf16_t* B1; int nM, nN, K, G, c, pad;
    __device__ __forceinline__ bool next(int i, Unit& u) const { if (!tile_of((long)(i >> 1) * G + c, nM, nN, u.pm, u.pn)) return false; u.tag = i & 1;
        u.A = ((i & 1) ? A1 : A0) + (size_t)u.pm * BM * K; u.B = ((i & 1) ? B1 : B0) + (size_t)u.pn * BM * K; return true; }
};
__device__ __forceinline__ unsigned cvt_pk_bf16(float lo, float hi) { unsigned r; asm volatile("v_cvt_pk_bf16_f32 %0, %1, %2" : "=v"(r) : "v"(lo), "v"(hi)); return r; }
__device__ __forceinline__ u32x4 pack8(f32x4 v0, f32x4 v1) { u32x4 w; w.x = cvt_pk_bf16(v0[0], v0[1]); w.y = cvt_pk_bf16(v0[2], v0[3]); w.z = cvt_pk_bf16(v1[0], v1[1]); w.w = cvt_pk_bf16(v1[2], v1[3]); return w; }
__device__ __forceinline__ void unpack8(u32x4 w, f32x4& v0, f32x4& v1) {
    v0[0] = __uint_as_float(w.x << 16); v0[1] = __uint_as_float(w.x & 0xffff0000u); v0[2] = __uint_as_float(w.y << 16); v0[3] = __uint_as_float(w.y & 0xffff0000u);
    v1[0] = __uint_as_float(w.z << 16); v1[1] = __uint_as_float(w.z & 0xffff0000u); v1[2] = __uint_as_float(w.w << 16); v1[3] = __uint_as_float(w.w & 0xffff0000u); }

template <class Epi, class Sched>
__device__ __forceinline__ void gemm_phase(PG8_LAS unsigned char* lds, const int K, const Sched& S, const Epi& E) {
    const int tid = threadIdx.x, wid = __builtin_amdgcn_readfirstlane(tid >> 6), lane = tid & 63, wr = wid >> 2, wc = wid & 3, fr = lane & 15, fq = lane >> 4;
    const int nt = K / BK;
    unsigned voffA[2], voffB[2];
#pragma unroll
    for (int i = 0; i < 2; ++i) { int R, C; stage_rc(tid * 16 + i * 8192, R, C); const int Rb = (R & ~31) + perm32(R & 31);
        voffA[i] = (unsigned)(R * K + C) * 2u; voffB[i] = (unsigned)(Rb * K + C) * 2u; }
    const size_t kstep = (size_t)(BK * 2);
    const size_t hstep = (size_t)HALF * K * 2;
    const unsigned ldsw = (unsigned)wid * 1024u;
    const int aoff = lds_byte(wr * 64 + fr, fq * 8), boff = lds_byte(wc * 32 + fr, fq * 8);
#define PG8_SA(b, h) (((b) * 2 + (h)) * HTB)
#define PG8_SB(b, h) ((4 + (b) * 2 + (h)) * HTB)
#define PG8_STAGE(bufoff, gbase, voff) do { _Pragma("unroll") for (int _i = 0; _i < 2; ++_i) \
        __builtin_amdgcn_global_load_lds((const unsigned*)((const char*)(gbase) + (voff)[_i]), (PG8_LAS unsigned*)(lds + (bufoff) + ldsw + _i * 8192), 16, 0, 0); } while (0)
#define PG8_LDA(dst, b, h) do { _Pragma("unroll") for (int m = 0; m < 4; ++m) _Pragma("unroll") for (int k = 0; k < 2; ++k) dst[m][k] = *(const PG8_LAS bf16x8*)(lds + PG8_SA(b, h) + aoff + m * 2048 + k * 1024); } while (0)
#define PG8_LDB(dst, b, h) do { _Pragma("unroll") for (int n = 0; n < 2; ++n) _Pragma("unroll") for (int k = 0; k < 2; ++k) dst[n][k] = *(const PG8_LAS bf16x8*)(lds + PG8_SB(b, h) + boff + n * 2048 + k * 1024); } while (0)
#define PG8_MMA(ai, bj, At, Bt) do { __builtin_amdgcn_s_setprio(1); _Pragma("unroll") for (int m = 0; m < 4; ++m) _Pragma("unroll") for (int n = 0; n < 2; ++n) _Pragma("unroll") for (int k = 0; k < 2; ++k) \
        acc[ai][bj][m][n] = __builtin_amdgcn_mfma_f32_16x16x32_bf16(Bt[n][k], At[m][k], acc[ai][bj][m][n], 0, 0, 0); __builtin_amdgcn_s_setprio(0); } while (0)
#define PG8_WAIT_V(n) asm volatile("s_waitcnt vmcnt(" #n ")" ::: "memory")
#define PG8_WAIT_L(n) asm volatile("s_waitcnt lgkmcnt(" #n ")" ::: "memory")
#define PG8_BAR __builtin_amdgcn_s_barrier()
#define PG8_SCHED __builtin_amdgcn_sched_barrier(0)
    Unit cur, nxt; int ui = 0;
    if (!S.next(0, cur)) return;
    f32x4 acc[2][2][4][2];
#pragma unroll
    for (int a = 0; a < 2; ++a)
#pragma unroll
        for (int b = 0; b < 2; ++b)
#pragma unroll
            for (int m = 0; m < 4; ++m)
#pragma unroll
                for (int n = 0; n < 2; ++n) acc[a][b][m][n] = (f32x4){0.f, 0.f, 0.f, 0.f};
    bf16x8 At[4][2], B0[2][2], B1[2][2];
    const char* cA = (const char*)cur.A; const char* cB = (const char*)cur.B;
    PG8_STAGE(PG8_SB(0, 0), cB, voffB); PG8_STAGE(PG8_SB(0, 1), cB + hstep, voffB); PG8_STAGE(PG8_SA(0, 0), cA, voffA); PG8_STAGE(PG8_SA(0, 1), cA + hstep, voffA);
    if (wr == 1) PG8_BAR;
    PG8_WAIT_V(2); PG8_BAR;
    PG8_STAGE(PG8_SB(1, 0), cB + kstep, voffB); PG8_STAGE(PG8_SA(1, 0), cA + kstep, voffA); PG8_STAGE(PG8_SB(1, 1), cB + hstep + kstep, voffB);
    PG8_WAIT_V(6); PG8_BAR;
    for (;;) {
        const bool has_next = S.next(ui + 1, nxt);
        const char* nA = has_next ? (const char*)nxt.A : cA; const char* nB = has_next ? (const char*)nxt.B : cB;
        for (int t = 0; t < nt; t += 2) {
            const bool last = (t == nt - 2);
            const char* a1 = cA + (size_t)(t + 1) * kstep;
            const char* a2 = last ? nA : cA + (size_t)(t + 2) * kstep; const char* b2 = last ? nB : cB + (size_t)(t + 2) * kstep;
            const char* a3 = a2 + kstep; const char* b3 = b2 + kstep;
            PG8_LDB(B0, 0, 0); PG8_LDB(B1, 0, 1); PG8_SCHED; PG8_LDA(At, 0, 0); PG8_STAGE(PG8_SA(1, 1), a1 + hstep, voffA);
            PG8_WAIT_V(8); PG8_WAIT_L(0); PG8_BAR; PG8_MMA(0, 0, At, B0); PG8_MMA(0, 1, At, B1); PG8_BAR; PG8_SCHED;
            PG8_LDA(At, 0, 1); PG8_STAGE(PG8_SB(0, 0), b2, voffB); PG8_STAGE(PG8_SB(0, 1), b2 + hstep, voffB); PG8_STAGE(PG8_SA(0, 0), a2, voffA);
            PG8_WAIT_V(8); PG8_WAIT_L(0); PG8_BAR; PG8_MMA(1, 0, At, B0); PG8_MMA(1, 1, At, B1); PG8_BAR; PG8_SCHED;
            PG8_LDB(B0, 1, 0); PG8_LDB(B1, 1, 1); PG8_SCHED; PG8_LDA(At, 1, 0); PG8_STAGE(PG8_SA(0, 1), a2 + hstep, voffA);
            PG8_WAIT_V(8); PG8_WAIT_L(0); PG8_BAR; PG8_MMA(0, 0, At, B0); PG8_MMA(0, 1, At, B1); PG8_BAR; PG8_SCHED;
            PG8_LDA(At, 1, 1); PG8_STAGE(PG8_SB(1, 0), b3, voffB); PG8_STAGE(PG8_SB(1, 1), b3 + hstep, voffB); PG8_STAGE(PG8_SA(1, 0), a3, voffA);
            PG8_WAIT_V(8); PG8_WAIT_L(0); PG8_BAR; PG8_MMA(1, 0, At, B0); PG8_MMA(1, 1, At, B1); PG8_BAR; PG8_SCHED;
        }
        if (wr == 0) PG8_BAR;
        const bool keep = E(acc, cur, wr, wc, fr, fq);
        if (!has_next) break;
        if (!keep) {
#pragma unroll
            for (int a = 0; a < 2; ++a)
#pragma unroll
                for (int b = 0; b < 2; ++b)
#pragma unroll
                    for (int m = 0; m < 4; ++m)
#pragma unroll
                        for (int n = 0; n < 2; ++n) acc[a][b][m][n] = (f32x4){0.f, 0.f, 0.f, 0.f};
        }
        cur = nxt; cA = nA; cB = nB; ++ui;
        if (wr == 1) PG8_BAR;
    }
    PG8_WAIT_V(0);
    PG8_BAR;
#undef PG8_SA
#undef PG8_SB
#undef PG8_STAGE
#undef PG8_LDA
#undef PG8_LDB
#undef PG8_MMA
#undef PG8_WAIT_V
#undef PG8_WAIT_L
#undef PG8_BAR
#undef PG8_SCHED
}

#define PG8_FRAG_LOOP for (int ai = 0; ai < 2; ++ai) _Pragma("unroll") for (int m = 0; m < 4; ++m) _Pragma("unroll") for (int bj = 0; bj < 2; ++bj)
struct FEpiAB { bf16_t* Pm; bf16_t* Pg; float* small; const float* bias;
    __device__ __forceinline__ bool operator()(const f32x4 (&acc)[2][2][4][2], const Unit& u, int wr, int wc, int fr, int fq) const {
        const int row0 = u.pm * BM + wr * 64 + fr, ct = u.pn, cin = wc * 32 + 8 * fq;
        f32x4 bv[2][2];
#pragma unroll
        for (int bj = 0; bj < 2; ++bj)
#pragma unroll
            for (int n = 0; n < 2; ++n) bv[bj][n] = *(const f32x4*)(bias + ct * BM + cin + bj * HALF + 4 * n);
        if (ct == 12) {
            if (cin < 64) {
#pragma unroll
                for (int ai = 0; ai < 2; ++ai)
#pragma unroll
                    for (int m = 0; m < 4; ++m) { float* p = small + (size_t)(row0 + ai * HALF + m * 16) * 64 + cin;
                        *(f32x4*)p = acc[ai][0][m][0] + bv[0][0]; *(f32x4*)(p + 4) = acc[ai][0][m][1] + bv[0][1]; }
            }
            return false;
        }
        bf16_t* base; int ld;
        if (ct < 12) { base = Pm + ct * BM; ld = 3072; } else { base = Pg + (ct - 13) * BM; ld = 2048; }
#pragma unroll
        PG8_FRAG_LOOP { *(u32x4*)(base + (size_t)(row0 + ai * HALF + m * 16) * ld + cin + bj * HALF) = pack8(acc[ai][bj][m][0] + bv[bj][0], acc[ai][bj][m][1] + bv[bj][1]); }
        return false;
    }
};
struct FEpiBias { bf16_t* O; const float* bias; int ld, pad;
    __device__ __forceinline__ bool operator()(const f32x4 (&acc)[2][2][4][2], const Unit& u, int wr, int wc, int fr, int fq) const {
        const int row0 = u.pm * BM + wr * 64 + fr, col0 = u.pn * BM + wc * 32 + 8 * fq;
        f32x4 bv[2][2];
#pragma unroll
        for (int bj = 0; bj < 2; ++bj)
#pragma unroll
            for (int n = 0; n < 2; ++n) bv[bj][n] = *(const f32x4*)(bias + col0 + bj * HALF + 4 * n);
#pragma unroll
        PG8_FRAG_LOOP { *(u32x4*)(O + (size_t)(row0 + ai * HALF + m * 16) * ld + col0 + bj * HALF) = pack8(acc[ai][bj][m][0] + bv[bj][0], acc[ai][bj][m][1] + bv[bj][1]); }
        return false;
    }
};
struct FEpiUp { bf16_t* gate; bf16_t* val; const float* bias;
    __device__ __forceinline__ bool operator()(const f32x4 (&acc)[2][2][4][2], const Unit& u, int wr, int wc, int fr, int fq) const {
        const int row0 = u.pm * BM + wr * 64 + fr, cin = wc * 32 + 8 * fq;
        bf16_t* base = u.pn < 11 ? gate + u.pn * BM : val + (u.pn - 11) * BM;
        f32x4 bv[2][2];
#pragma unroll
        for (int bj = 0; bj < 2; ++bj)
#pragma unroll
            for (int n = 0; n < 2; ++n) bv[bj][n] = *(const f32x4*)(bias + u.pn * BM + cin + bj * HALF + 4 * n);
#pragma unroll
        PG8_FRAG_LOOP { *(u32x4*)(base + (size_t)(row0 + ai * HALF + m * 16) * DFF + cin + bj * HALF) = pack8(acc[ai][bj][m][0] + bv[bj][0], acc[ai][bj][m][1] + bv[bj][1]); }
        return false;
    }
};
__device__ __forceinline__ float fsig(float x) { return __builtin_amdgcn_rcpf(1.f + __expf(-x)); }
struct FEpiMerge { bf16_t* Z; const bf16_t* side;
    __device__ __forceinline__ bool operator()(f32x4 (&acc)[2][2][4][2], const Unit& u, int wr, int wc, int fr, int fq) const {
        const int row0 = u.pm * BM + wr * 64 + fr, col0 = u.pn * BM + wc * 32 + 8 * fq;
        if (u.tag == 0) {
#pragma unroll
            PG8_FRAG_LOOP { const bf16_t* sp = side + (size_t)(row0 + ai * HALF + m * 16) * 4096 + col0 + bj * HALF;
                f32x4 a0, a1, b0, b1; unpack8(*(const u32x4*)(sp + 2048), a0, a1); unpack8(*(const u32x4*)(sp + 3072), b0, b1);
#pragma unroll
                for (int j = 0; j < 4; ++j) { acc[ai][bj][m][0][j] *= (1.f + __expf(-b0[j])) * fsig(a0[j]); acc[ai][bj][m][1][j] *= (1.f + __expf(-b1[j])) * fsig(a1[j]); } }
            return true;
        }
#pragma unroll
        PG8_FRAG_LOOP { const bf16_t* sp = side + (size_t)(row0 + ai * HALF + m * 16) * 4096 + col0 + bj * HALF;
            f32x4 b0, b1; unpack8(*(const u32x4*)(sp + 3072), b0, b1); f32x4 v0 = acc[ai][bj][m][0], v1 = acc[ai][bj][m][1];
#pragma unroll
            for (int j = 0; j < 4; ++j) { v0[j] *= fsig(b0[j]); v1[j] *= fsig(b1[j]); }
            *(u32x4*)(Z + (size_t)(row0 + ai * HALF + m * 16) * DM + col0 + bj * HALF) = pack8(v0, v1); }
        return false;
    }
};
struct FEpiOut { const float* x; const float* modv; float* r1;
    __device__ __forceinline__ bool operator()(const f32x4 (&acc)[2][2][4][2], const Unit& u, int wr, int wc, int fr, int fq) const {
        const int row0 = u.pm * BM + wr * 64 + fr, col0 = u.pn * BM + wc * 32 + 8 * fq;
        const float* g = modv + (u.pm * BM / SEQ) * 6144 + 2048 + col0;
        f32x4 gv[2][2];
#pragma unroll
        for (int bj = 0; bj < 2; ++bj)
#pragma unroll
            for (int n = 0; n < 2; ++n) gv[bj][n] = *(const f32x4*)(g + bj * HALF + 4 * n);
#pragma unroll
        PG8_FRAG_LOOP { const size_t o = (size_t)(row0 + ai * HALF + m * 16) * DM + col0 + bj * HALF;
            const f32x4 x0 = *(const f32x4*)(x + o), x1 = *(const f32x4*)(x + o + 4);
            *(f32x4*)(r1 + o) = x0 * ALPHA + gv[bj][0] * acc[ai][bj][m][0]; *(f32x4*)(r1 + o + 4) = x1 * ALPHA + gv[bj][1] * acc[ai][bj][m][1]; }
        return false;
    }
};
struct FEpiDown { float* h; const float* modv; const float* b_down;
    __device__ __forceinline__ bool operator()(const f32x4 (&acc)[2][2][4][2], const Unit& u, int wr, int wc, int fr, int fq) const {
        const int row0 = u.pm * BM + wr * 64 + fr, col0 = u.pn * BM + wc * 32 + 8 * fq;
        const float* g = modv + (u.pm * BM / SEQ) * 6144 + 5120 + col0;
        f32x4 gv[2][2], bv[2][2];
#pragma unroll
        for (int bj = 0; bj < 2; ++bj)
#pragma unroll
            for (int n = 0; n < 2; ++n) { gv[bj][n] = *(const f32x4*)(g + bj * HALF + 4 * n); bv[bj][n] = *(const f32x4*)(b_down + col0 + bj * HALF + 4 * n); }
#pragma unroll
        PG8_FRAG_LOOP { float* p = h + (size_t)(row0 + ai * HALF + m * 16) * DM + col0 + bj * HALF;
            const f32x4 h0 = *(const f32x4*)p, h1 = *(const f32x4*)(p + 4);
            *(f32x4*)p = h0 * ALPHA + gv[bj][0] * (acc[ai][bj][m][0] + bv[bj][0]); *(f32x4*)(p + 4) = h1 * ALPHA + gv[bj][1] * (acc[ai][bj][m][1] + bv[bj][1]); }
        return false;
    }
};
}

namespace scan {
#define LAS __attribute__((address_space(3)))
typedef short bf16x8 __attribute__((ext_vector_type(8)));
typedef short s16x4 __attribute__((ext_vector_type(4)));
typedef float f32x4 __attribute__((ext_vector_type(4)));
typedef unsigned u32x4 __attribute__((ext_vector_type(4)));
typedef unsigned u32x2 __attribute__((ext_vector_type(2)));
constexpr int RS = 288, RSP = 144, RSE = 528;
constexpr int L_RAWQ = 0, L_RAWK = 17408, L_RAWV = 34816;
constexpr int L_Q = 51200, L_K = L_Q + 64 * RS, L_V = L_K + 64 * RS;
constexpr int L_SC = 106496;
constexpr int SC_EQ = 0, SC_EK = 64, SC_FL = 128, SC_QN = 192, SC_RS = 256  , SC_N = 384  , SC_MISC = 640, SC_DEC = 704  , SC_GB = 832  , SC_END = 960;
constexpr int L_GW = L_SC + SC_END * 4;
constexpr int L_E = L_GW + 8192;
constexpr int L_P = L_E;
constexpr int LDS_BYTES = L_E + 64 * RSE;
static_assert(LDS_BYTES <= 160 * 1024, "scan LDS");

typedef float f32x2_t __attribute__((ext_vector_type(2))); typedef __bf16 bf16x2_t __attribute__((ext_vector_type(2)));
__device__ __forceinline__ unsigned cvt_pk(float lo, float hi) { f32x2_t v = {lo, hi}; bf16x2_t b = __builtin_convertvector(v, bf16x2_t); return __builtin_bit_cast(unsigned, b); }
__device__ __forceinline__ s16x4 tr16(const LAS unsigned char* p) { return __builtin_bit_cast(s16x4, __builtin_amdgcn_ds_read_tr16_b64_v4i16((LAS s16x4*)p)); }
__device__ __forceinline__ bf16x8 cat4(s16x4 a, s16x4 b) { return (bf16x8){a[0], a[1], a[2], a[3], b[0], b[1], b[2], b[3]}; }
__device__ __forceinline__ void unpack8f(u32x4 w, float* v) {
    v[0] = __uint_as_float(w.x << 16); v[1] = __uint_as_float(w.x & 0xffff0000u); v[2] = __uint_as_float(w.y << 16); v[3] = __uint_as_float(w.y & 0xffff0000u);
    v[4] = __uint_as_float(w.z << 16); v[5] = __uint_as_float(w.z & 0xffff0000u); v[6] = __uint_as_float(w.w << 16); v[7] = __uint_as_float(w.w & 0xffff0000u); }
__device__ __forceinline__ float fsilu(float x) { return x * __builtin_amdgcn_rcpf(1.f + __expf(-x)); }

struct Args {
    const bf16_t* P; int ld, pad;
    const float* small;
    const float* conv_qk;
    const float* gw_f; const float* gb_f; const float* gw_b; const float* gb_b;
    bf16_t* hout;
};

template <bool GLA>
__device__ __forceinline__ void scan_item(LAS unsigned char* lds, const Args& a, const int item) {
    const int tid = threadIdx.x, lane = tid & 63, wid = __builtin_amdgcn_readfirstlane(tid >> 6), c = lane & 15, g = lane >> 4;
    LAS float* sc = (LAS float*)(lds + L_SC);
    int b, h, dir, half = 0;
    if (GLA) { half = item & 1; dir = (item >> 1) & 1; h = (item >> 2) & 3; b = item >> 4; } else { dir = item & 1; h = (item >> 1) & 7; b = item >> 4; }
    const int colq = GLA ? h * 128 : h * 128, colk = GLA ? 512 + h * 128 : 1024 + h * 128, colv = GLA ? 1024 + h * 256 + half * 128 : 2048 + h * 128;
    const int ocol = GLA ? h * 256 + half * 128 : h * 128;
    bf16_t* hout = a.hout + (size_t)dir * ML * DM;
    const float* gw = dir ? a.gw_b : a.gw_f; const float* gbp = dir ? a.gb_b : a.gb_f;

    for (int i = tid; i < 256; i += 512) sc[SC_N + i] = 0.f;
    if (GLA) {
        for (int i = tid; i < 2048; i += 512) { const int d = i >> 4, k = i & 15; ((LAS float*)(lds + L_GW))[i] = gw[k * 512 + h * 128 + d]; }
        if (tid < 128) sc[SC_GB + tid] = gbp[h * 128 + tid];
    }
    float wq[3][8], wk[3][8];
    if (!GLA) {
        const int cg = tid & 15;
#pragma unroll
        for (int e = 0; e < 8; ++e) { const int cq = h * 128 + cg * 8 + e, ck = 1024 + cq;
            const float q0 = a.conv_qk[cq], q1 = a.conv_qk[2048 + cq], q2 = a.conv_qk[4096 + cq], k0 = a.conv_qk[ck], k1 = a.conv_qk[2048 + ck], k2 = a.conv_qk[4096 + ck];
            wq[0][e] = dir ? q2 : q0; wq[1][e] = q1; wq[2][e] = dir ? q0 : q2; wk[0][e] = dir ? k2 : k0; wk[1][e] = k1; wk[2][e] = dir ? k0 : k2; }
    }
    f32x4 Cst[8]; f32x4 nst = (f32x4){0.f, 0.f, 0.f, 0.f};
#pragma unroll
    for (int j = 0; j < 8; ++j) Cst[j] = (f32x4){0.f, 0.f, 0.f, 0.f};
    float m_run = 0.f;
    float pre_li = 0.f, pre_lf = 0.f;
    f32x4 pre_r[4];
#pragma unroll
    for (int i = 0; i < 4; ++i) pre_r[i] = (f32x4){0.f, 0.f, 0.f, 0.f};

#define SCAN_ROW(cc_, p_, rowv) do { const int seg_ = (cc_) < 4 ? 0 : 1; const int T_ = seg_ ? SEQ : CTX; const int row0_ = seg_ ? b * SEQ : ML + b * CTX; \
        int pp_ = (p_); pp_ = pp_ < 0 ? 0 : (pp_ > T_ - 1 ? T_ - 1 : pp_); const int t_ = dir ? (T_ - 1 - pp_) : pp_; rowv = row0_ + t_; } while (0)
#define SCAN_ISSUE(cc_) do { const int ci_ = (cc_) < 4 ? (cc_) : (cc_) - 4; \
        for (int n = wid; n < 50; n += 8) { \
            const int which = n < 17 ? 0 : (n < 34 ? 1 : 2); const int nn = n - (which == 0 ? 0 : which == 1 ? 17 : 34); \
            const int piece = nn * 64 + lane; int row; const char* src; unsigned dst; \
            { const int j = piece >> 4, cgp = piece & 15; SCAN_ROW(cc_, ci_ * 64 + j - (which < 2 ? 1 : 0), row); \
                src = (const char*)(a.P + (size_t)row * a.ld + (which == 0 ? colq : which == 1 ? colk : colv) + cgp * 8); dst = (which == 0 ? L_RAWQ : which == 1 ? L_RAWK : L_RAWV) + nn * 1024; } \
            __builtin_amdgcn_global_load_lds((const unsigned*)src, (LAS unsigned*)(lds + dst), 16, 0, 0); } \
        if (!GLA && wid == 0) { int row; SCAN_ROW(cc_, ci_ * 64 + lane, row); pre_li = a.small[(size_t)row * 64 + dir * 8 + h]; pre_lf = a.small[(size_t)row * 64 + 16 + dir * 8 + h]; } \
        if (GLA) { int row; SCAN_ROW(cc_, ci_ * 64 + lane, row); const float* rp_ = a.small + (size_t)row * 64 + 32 + dir * 16; \
            _Pragma("unroll") for (int i_ = 0; i_ < 4; ++i_) pre_r[i_] = *(const f32x4*)(rp_ + 4 * i_); } } while (0)

    SCAN_ISSUE(0);
    for (int cc = 0; cc < 36; ++cc) {
        const int seg = cc < 4 ? 0 : 1, ci = seg ? cc - 4 : cc, T = seg ? SEQ : CTX;
        const int par = cc & 1;
        asm volatile("s_waitcnt vmcnt(0)" ::: "memory");
        __syncthreads();
        if (!GLA) {
            if (wid == 0) {
                const float li = pre_li, lf = logsigmoidf_(pre_lf);
                float bs = lf;
#pragma unroll
                for (int o = 1; o < 64; o <<= 1) { const float v = __shfl_up(bs, o); if (lane >= o) bs += v; }
                const float gg = li - bs; float cm = gg;
#pragma unroll
                for (int o = 1; o < 64; o <<= 1) { const float v = __shfl_up(cm, o); if (lane >= o) cm = fmaxf(cm, v); }
                const float M = fmaxf(m_run, cm), M63 = __shfl(M, 63), b63 = __shfl(bs, 63);
                sc[SC_EQ + lane] = __expf(fminf(M63 - M, 80.f)) * 0.08838834764831845f;
                sc[SC_EK + lane] = __expf(gg - M63);
                sc[SC_FL + lane] = __expf(-(bs + M));
                if (lane == 0) sc[SC_MISC] = __expf(m_run - M63);
                m_run = b63 + M63;
            }
        } else {
            float r[16];
#pragma unroll
            for (int i = 0; i < 4; ++i) { const f32x4 v = pre_r[i]; r[4 * i] = v[0]; r[4 * i + 1] = v[1]; r[4 * i + 2] = v[2]; r[4 * i + 3] = v[3]; }
            for (int e = 0; e < 16; ++e) { const int d = wid * 16 + e; const LAS float* gwd = (const LAS float*)(lds + L_GW) + d * 16;
                float acc = sc[SC_GB + d];
#pragma unroll
                for (int i = 0; i < 4; ++i) { const f32x4 v = *(const LAS f32x4*)(gwd + 4 * i); acc += r[4 * i] * v[0] + r[4 * i + 1] * v[1] + r[4 * i + 2] * v[2] + r[4 * i + 3] * v[3]; }
                float bs = logsigmoidf_(acc) * 0.0625f;
#pragma unroll
                for (int o = 1; o < 64; o <<= 1) { const float v = __shfl_up(bs, o); if (lane >= o) bs += v; }
                const float be = __shfl(bs, 63);
                *(LAS float*)(lds + L_E + lane * RSE + d * 4) = bs - be;
                if (lane == 63) sc[SC_DEC + d] = __expf(be);
            }
        }
        __syncthreads();
#pragma unroll
        for (int it = 0; it < 2; ++it) {
            const int t = (tid >> 4) + 32 * it, cg = tid & 15; const int p = ci * 64 + t;
            const LAS unsigned char* rq = lds + L_RAWQ + (t + 1) * 256 + cg * 16; const LAS unsigned char* rk = lds + L_RAWK + (t + 1) * 256 + cg * 16;
            float xq[8], xk[8];
            if (!GLA) {
                float a0[8], a1[8], a2[8];
                const bool hp = p > 0, hn = p < T - 1;
                if (seg) {
                    unpack8f(*(const LAS u32x4*)(rq - 256), a0); unpack8f(*(const LAS u32x4*)rq, a1); unpack8f(*(const LAS u32x4*)(rq + 256), a2);
                    const float eq = sc[SC_EQ + t];
#pragma unroll
                    for (int e = 0; e < 8; ++e) xq[e] = fsilu(wq[1][e] * a1[e] + (hp ? wq[0][e] * a0[e] : 0.f) + (hn ? wq[2][e] * a2[e] : 0.f)) * eq;
                }
                unpack8f(*(const LAS u32x4*)(rk - 256), a0); unpack8f(*(const LAS u32x4*)rk, a1); unpack8f(*(const LAS u32x4*)(rk + 256), a2);
                const float ek = sc[SC_EK + t];
#pragma unroll
                for (int e = 0; e < 8; ++e) xk[e] = fsilu(wk[1][e] * a1[e] + (hp ? wk[0][e] * a0[e] : 0.f) + (hn ? wk[2][e] * a2[e] : 0.f)) * ek;
            } else {
                float a1[8], ev[8];
                const LAS float* ep = (const LAS float*)(lds + L_E + t * RSE) + cg * 8;
                { const f32x4 e0 = *(const LAS f32x4*)ep, e1 = *(const LAS f32x4*)(ep + 4); ev[0] = e0[0]; ev[1] = e0[1]; ev[2] = e0[2]; ev[3] = e0[3]; ev[4] = e1[0]; ev[5] = e1[1]; ev[6] = e1[2]; ev[7] = e1[3]; }
                if (seg) { unpack8f(*(const LAS u32x4*)rq, a1);
#pragma unroll
                    for (int e = 0; e < 8; ++e) xq[e] = a1[e] * 0.08838834764831845f * __expf(fminf(ev[e], 80.f)); }
                unpack8f(*(const LAS u32x4*)rk, a1);
#pragma unroll
                for (int e = 0; e < 8; ++e) xk[e] = a1[e] * __expf(-ev[e]);
            }
            if (seg) { u32x4 w; w.x = cvt_pk(xq[0], xq[1]); w.y = cvt_pk(xq[2], xq[3]); w.z = cvt_pk(xq[4], xq[5]); w.w = cvt_pk(xq[6], xq[7]); *(LAS u32x4*)(lds + L_Q + t * RS + cg * 16) = w; }
            { u32x4 w; w.x = cvt_pk(xk[0], xk[1]); w.y = cvt_pk(xk[2], xk[3]); w.z = cvt_pk(xk[4], xk[5]); w.w = cvt_pk(xk[6], xk[7]); *(LAS u32x4*)(lds + L_K + t * RS + cg * 16) = w; }
            *(LAS u32x4*)(lds + L_V + t * RS + cg * 16) = *(const LAS u32x4*)(lds + L_RAWV + t * 256 + cg * 16);
        }
        __syncthreads();
        if (cc + 1 < 36) SCAN_ISSUE(cc + 1);
        float dsc = 1.f;
        if (!GLA) { dsc = sc[SC_MISC];
#pragma unroll
            for (int j = 0; j < 8; ++j) Cst[j] *= dsc;
            nst *= dsc;
        } else {
#pragma unroll
            for (int j = 0; j < 8; ++j) { const f32x4 dv = *(const LAS f32x4*)(sc + SC_DEC + 32 * (j >> 1) + 8 * g + 4 * (j & 1)); Cst[j] *= dv; }
        }
        f32x4 O[4];
#pragma unroll
        for (int i = 0; i < 4; ++i) O[i] = (f32x4){0.f, 0.f, 0.f, 0.f};
        if (seg) {
            if (!GLA) {
                const int l = tid >> 3, part = tid & 7; const LAS unsigned char* qp = lds + L_Q + l * RS + part * 32; const LAS float* np = sc + SC_N + par * 128 + part * 16;
                float q[16]; unpack8f(*(const LAS u32x4*)qp, q); unpack8f(*(const LAS u32x4*)(qp + 16), q + 8);
                float s = 0.f;
#pragma unroll
                for (int i = 0; i < 4; ++i) { const f32x4 nv = *(const LAS f32x4*)(np + 4 * i); s += q[4 * i] * nv[0] + q[4 * i + 1] * nv[1] + q[4 * i + 2] * nv[2] + q[4 * i + 3] * nv[3]; }
                s += __shfl_xor(s, 1); s += __shfl_xor(s, 2); s += __shfl_xor(s, 4);
                if (part == 0) sc[SC_QN + l] = s * dsc;
            }
            const int lt = wid >> 1, sth = wid & 1;
            bf16x8 qf[4];
#pragma unroll
            for (int kk = 0; kk < 4; ++kk) qf[kk] = *(const LAS bf16x8*)(lds + L_Q + (16 * lt + c) * RS + (32 * kk + 8 * g) * 2);
            float rs = 0.f;
#pragma unroll
            for (int s2 = 0; s2 < 2; ++s2) { const int st = 2 * sth + s2;
                f32x4 acc = (f32x4){0.f, 0.f, 0.f, 0.f};
                if (st <= lt) {
#pragma unroll
                    for (int kk = 0; kk < 4; ++kk) { const bf16x8 kf = *(const LAS bf16x8*)(lds + L_K + (16 * st + c) * RS + (32 * kk + 8 * g) * 2); acc = __builtin_amdgcn_mfma_f32_16x16x32_bf16(kf, qf[kk], acc, 0, 0, 0); }
                    if (st == lt) {
#pragma unroll
                        for (int i = 0; i < 4; ++i) if (4 * g + i > c) acc[i] = 0.f;
                    }
                }
                rs += (acc[0] + acc[1]) + (acc[2] + acc[3]);
                u32x2 w; w.x = cvt_pk(acc[0], acc[1]); w.y = cvt_pk(acc[2], acc[3]);
                *(LAS u32x2*)(lds + L_P + (16 * lt + c) * RSP + (16 * st + 4 * g) * 2) = w;
            }
            if (!GLA) { rs += __shfl_xor(rs, 16); rs += __shfl_xor(rs, 32); if (g == 0) sc[SC_RS + sth * 64 + 16 * lt + c] = rs; }
#pragma unroll
            for (int kk = 0; kk < 4; ++kk) {
                u32x4 bw; bw.x = cvt_pk(Cst[2 * kk][0], Cst[2 * kk][1]); bw.y = cvt_pk(Cst[2 * kk][2], Cst[2 * kk][3]); bw.z = cvt_pk(Cst[2 * kk + 1][0], Cst[2 * kk + 1][1]); bw.w = cvt_pk(Cst[2 * kk + 1][2], Cst[2 * kk + 1][3]);
                const bf16x8 bfrag = __builtin_bit_cast(bf16x8, bw);
#pragma unroll
                for (int l4 = 0; l4 < 4; ++l4) { const bf16x8 af = *(const LAS bf16x8*)(lds + L_Q + (16 * l4 + c) * RS + (32 * kk + 8 * g) * 2); O[l4] = __builtin_amdgcn_mfma_f32_16x16x32_bf16(af, bfrag, O[l4], 0, 0, 0); }
            }
        }
        bf16x8 vf[2];
        {
            const int q = c >> 2, p = c & 3;
#pragma unroll
            for (int tt = 0; tt < 2; ++tt) { const LAS unsigned char* vp = lds + L_V + (32 * tt + 8 * g + q) * RS + (16 * wid + 4 * p) * 2; vf[tt] = cat4(tr16(vp), tr16(vp + 4 * RS)); }
            const bf16x8 ones = (bf16x8){0x3F80, 0x3F80, 0x3F80, 0x3F80, 0x3F80, 0x3F80, 0x3F80, 0x3F80};
#pragma unroll
            for (int j = 0; j < 8; ++j) {
#pragma unroll
                for (int tt = 0; tt < 2; ++tt) { const LAS unsigned char* kp = lds + L_K + (32 * tt + 8 * g + q) * RS + (32 * (j >> 1) + 8 * p + 4 * (j & 1)) * 2;
                    const bf16x8 kf = cat4(tr16(kp), tr16(kp + 4 * RS));
                    Cst[j] = __builtin_amdgcn_mfma_f32_16x16x32_bf16(kf, vf[tt], Cst[j], 0, 0, 0);
                    if (!GLA) { if (j == wid) nst = __builtin_amdgcn_mfma_f32_16x16x32_bf16(kf, ones, nst, 0, 0, 0); } }
            }
            if (!GLA) { if (c == 0) *(LAS f32x4*)(sc + SC_N + (par ^ 1) * 128 + 32 * (wid >> 1) + 8 * g + 4 * (wid & 1)) = nst; }
        }
        if (seg) {
            __syncthreads();
#pragma unroll
            for (int l4 = 0; l4 < 4; ++l4)
#pragma unroll
                for (int tt = 0; tt < 2; ++tt) { const bf16x8 af = *(const LAS bf16x8*)(lds + L_P + (16 * l4 + c) * RSP + (32 * tt + 8 * g) * 2); O[l4] = __builtin_amdgcn_mfma_f32_16x16x32_bf16(af, vf[tt], O[l4], 0, 0, 0); }
#pragma unroll
            for (int l4 = 0; l4 < 4; ++l4) {
                f32x4 o = O[l4];
                if (!GLA) { const int lb = 16 * l4 + 4 * g;
                    const f32x4 qn = *(const LAS f32x4*)(sc + SC_QN + lb), r0 = *(const LAS f32x4*)(sc + SC_RS + lb), r1 = *(const LAS f32x4*)(sc + SC_RS + 64 + lb), fl = *(const LAS f32x4*)(sc + SC_FL + lb);
#pragma unroll
                    for (int i = 0; i < 4; ++i) { const float den = fmaxf(fabsf(qn[i] + r0[i] + r1[i]), fl[i]); o[i] = o[i] * __builtin_amdgcn_rcpf(den); } }
#pragma unroll
                for (int i = 0; i < 4; ++i) { const int l = 16 * l4 + 4 * g + i; const int pp = ci * 64 + l; const int t = dir ? (T - 1 - pp) : pp;
                    hout[(size_t)(b * SEQ + t) * DM + ocol + 16 * wid + c] = f2bf(o[i]); }
            }
        }
    }
#undef SCAN_ROW
#undef SCAN_ISSUE
}
#undef LAS
}

#include <hip/hip_cooperative_groups.h>
namespace cg = cooperative_groups;
#define LAS __attribute__((address_space(3)))
constexpr int NBLK = 256, NTHR = 512;
constexpr int MEGA_LDS = scan::LDS_BYTES > pg8::STAGE_BYTES ? scan::LDS_BYTES : pg8::STAGE_BYTES;
constexpr size_t WS_MODP = WS_BIG;
struct Params { const float* in[28]; float* out; unsigned char* ws; };
typedef float f32x4v __attribute__((ext_vector_type(4)));
typedef unsigned u32x4v __attribute__((ext_vector_type(4)));

__device__ __forceinline__ void ph_prologue(const Params& p, LAS unsigned char* lds, int c) {
    const int tid = threadIdx.x;
    unsigned char* ws = p.ws;
    LAS float* t = (LAS float*)lds;
    for (int it = c; it < 10400; it += NBLK) {
        const float* W; bf16_t* Wt; int ldw, K, src, nn, dst, tl = it;
        if (tl < 4640) { W = p.in[6]; Wt = (bf16_t*)(ws + WS_WIN); ldw = NIN; K = DM;
            if (tl < 1536) { src = 0; nn = 3072; dst = 0; }
            else if ((tl -= 1536) < 16) { src = 4096; nn = 32; dst = 3072; }
            else if ((tl -= 16) < 16) { src = 7200; nn = 32; dst = 3104; }
            else if ((tl -= 16) < 256) { src = 4128; nn = 512; dst = 3328; }
            else if ((tl -= 256) < 256) { src = 4640; nn = 512; dst = 3840; }
            else if ((tl -= 256) < 512) { src = 5152; nn = 1024; dst = 4352; }
            else if ((tl -= 512) < 512) { src = 3072; nn = 1024; dst = 5376; }
            else if ((tl -= 512) < 512) { src = 6176; nn = 1024; dst = 6400; }
            else if ((tl -= 512) < 512) { src = 7232; nn = 1024; dst = 7424; }
            else { tl -= 512; src = 8256; nn = 1024; dst = 8448; } }
        else if ((tl -= 4640) < 512) { W = p.in[15]; Wt = (bf16_t*)(ws + WS_WBM); ldw = DM; K = DM; src = 0; nn = DM; dst = 0; }
        else if ((tl -= 512) < 512) { W = p.in[16]; Wt = (bf16_t*)(ws + WS_WBG); ldw = DM; K = DM; src = 0; nn = DM; dst = 0; }
        else if ((tl -= 512) < 512) { W = p.in[17]; Wt = (bf16_t*)(ws + WS_WOUT); ldw = DM; K = DM; src = 0; nn = DM; dst = 0; }
        else if ((tl -= 512) < 2816) { W = p.in[20]; Wt = (bf16_t*)(ws + WS_WUP); ldw = 2 * DFF; K = DM; src = 0; nn = 2 * DFF; dst = 0; }
        else { tl -= 2816; W = p.in[24]; Wt = (bf16_t*)(ws + WS_WDN); ldw = DM; K = DFF; src = 0; nn = DM; dst = 0; }
        const int ntn = nn >> 5, kb = tl / ntn, nb = tl - kb * ntn, k0 = kb * 64, n0 = nb * 32;
        { const int tx = tid & 31, ty = tid >> 5;
#pragma unroll
          for (int i = 0; i < 4; ++i) { const int k = ty + 16 * i; t[k * 33 + tx] = W[(size_t)(k0 + k) * ldw + src + n0 + tx]; } }
        __syncthreads();
        { const int kx = tid & 63, ny = tid >> 6;
#pragma unroll
          for (int i = 0; i < 4; ++i) { const int n = ny + 8 * i; Wt[(size_t)(dst + n0 + n) * K + k0 + kx] = f2bf(t[kx * 33 + n]); } }
        __syncthreads();
    }
    { u32x4v* z = (u32x4v*)((bf16_t*)(ws + WS_WIN) + (size_t)3136 * DM);
      for (int i = c * NTHR + tid; i < 24576; i += NBLK * NTHR) z[i] = (u32x4v){0u, 0u, 0u, 0u}; }
    { float* bp = (float*)(ws + WS_BIN); const float* b_in = p.in[7];
      for (int j = c * NTHR + tid; j < NINP; j += NBLK * NTHR) { int s;
        if (j < 3072) s = j; else if (j < 3104) s = 4096 + (j - 3072); else if (j < 3136) s = 7200 + (j - 3104); else if (j < 3328) s = -1;
        else if (j < 3840) s = 4128 + (j - 3328); else if (j < 4352) s = 4640 + (j - 3840); else if (j < 5376) s = 5152 + (j - 4352);
        else if (j < 6400) s = 3072 + (j - 5376); else if (j < 7424) s = 6176 + (j - 6400); else if (j < 8448) s = 7232 + (j - 7424); else s = 8256 + (j - 8448);
        bp[j] = s >= 0 ? b_in[s] : 0.f; } }
    for (int item = c; item < 192; item += NBLK) {
        const int cb = item % 12, ks = item / 12; LAS float* sl = (LAS float*)lds;
        for (int i = tid; i < 17 * 64; i += NTHR) { const int r = i >> 6, k = i & 63; const float cv = r < 16 ? p.in[1][r * DM + ks * 64 + k] : p.in[3][ks * 64 + k]; sl[i] = siluf_(cv); }
        __syncthreads();
        const int col = cb * 512 + tid; float acc[17];
#pragma unroll
        for (int r = 0; r < 17; ++r) acc[r] = 0.f;
        const float* wm = p.in[4] + (size_t)(ks * 64) * 6144 + col;
        for (int k = 0; k < 64; ++k) { const float w = wm[(size_t)k * 6144];
#pragma unroll
            for (int r = 0; r < 17; ++r) acc[r] += sl[r * 64 + k] * w; }
        float* mp = (float*)(ws + WS_MODP) + (size_t)ks * 17 * 6144 + col;
#pragma unroll
        for (int r = 0; r < 17; ++r) mp[(size_t)r * 6144] = acc[r];
        __syncthreads();
    }
}
__device__ __forceinline__ void ph_modulate(const Params& p, LAS unsigned char* lds, int c) {
    const int tid = threadIdx.x, lane = tid & 63, wid = tid >> 6;
    const float* modp = (const float*)(p.ws + WS_MODP); const float* b_mod = p.in[5];
    float* modv = (float*)(p.ws + WS_MOD);
    for (int e = tid; e < 408; e += NTHR) { const int idx = c * 408 + e, r = idx / 6144, j = idx - r * 6144; float s = b_mod[j];
#pragma unroll
        for (int ks = 0; ks < 16; ++ks) s += modp[((size_t)ks * 17 + r) * 6144 + j];
        modv[idx] = s; }
    LAS float* mv = (LAS float*)lds;
    bf16_t* U = (bf16_t*)(p.ws + WS_U) ;
    int curb = -1;
    for (int g = 0; g < 18; ++g) {
        const int r0 = c * 144 + 8 * g, b = r0 < ML ? r0 / SEQ : 16;
        if (b != curb) { __syncthreads();
            for (int j = tid; j < 2048; j += NTHR) { float s = b_mod[j];
#pragma unroll
                for (int ks = 0; ks < 16; ++ks) s += modp[((size_t)ks * 17 + b) * 6144 + j];
                mv[j] = s; }
            __syncthreads(); curb = b; }
        const int row = r0 + wid; const float* src = row < ML ? p.in[0] + (size_t)row * DM : p.in[2] + (size_t)(row - ML) * DM;
#pragma unroll
        for (int i = 0; i < 4; ++i) { const int d = i * 256 + lane * 4; const f32x4v v = *(const f32x4v*)(src + d), sh = *(const LAS f32x4v*)(mv + d), sc = *(const LAS f32x4v*)(mv + 1024 + d);
            ushort4 o; o.x = f2bf(v[0] * (1.f + sc[0]) + sh[0]); o.y = f2bf(v[1] * (1.f + sc[1]) + sh[1]); o.z = f2bf(v[2] * (1.f + sc[2]) + sh[2]); o.w = f2bf(v[3] * (1.f + sc[3]) + sh[3]);
            *(ushort4*)(U + (size_t)row * DM + d) = o; }
    }
}
__device__ __forceinline__ void ph_aprep(const Params& p, int c) {
    const int tid = threadIdx.x, lane = tid & 63, wid = tid >> 6;
    bf16_t* hm = (bf16_t*)p.out; bf16_t* hg = (bf16_t*)(p.ws + WS_BIG + BIG_HG); const bf16_t* side = (const bf16_t*)(p.ws + WS_BIG + BIG_SIDE);
    const float* gm = p.in[13]; const float* gg = p.in[14];
    for (int it = wid; it < 128 * 12; it += 8) {
        const int row = c * 128 + it / 12, u = it % 12;
        if (u < 8) {
            const int c0 = u * 128 + lane * 2; const size_t o = (size_t)row * DM + c0;
            const unsigned a = *(const unsigned*)(hm + o), b = *(const unsigned*)(hm + o + (size_t)ML * DM);
            float v0 = __uint_as_float(a << 16) + __uint_as_float(b << 16), v1 = __uint_as_float(a & 0xffff0000u) + __uint_as_float(b & 0xffff0000u);
            const float mean = wave_sum(v0 + v1) * (1.f / 128.f); v0 -= mean; v1 -= mean;
            const float rstd = rsqrtf(wave_sum(v0 * v0 + v1 * v1) * (1.f / 128.f) + EPS);
            const unsigned om = *(const unsigned*)(side + (size_t)row * 4096 + c0);
            const float o0 = __uint_as_float(om << 16), o1 = __uint_as_float(om & 0xffff0000u);
            *(unsigned*)(hm + o) = (unsigned)f2bf(v0 * rstd * gm[c0] * sigmoidf_(o0)) | ((unsigned)f2bf(v1 * rstd * gm[c0 + 1] * sigmoidf_(o1)) << 16);
        } else {
            const int hh = u - 8; const int c0 = hh * 256 + lane * 4; const size_t o = (size_t)row * DM + c0;
            const uint2 a = *(const uint2*)(hg + o), b = *(const uint2*)(hg + o + (size_t)ML * DM), zz = *(const uint2*)(side + (size_t)row * 4096 + 1024 + c0);
            float v[4] = {__uint_as_float(a.x << 16) + __uint_as_float(b.x << 16), __uint_as_float(a.x & 0xffff0000u) + __uint_as_float(b.x & 0xffff0000u),
                          __uint_as_float(a.y << 16) + __uint_as_float(b.y << 16), __uint_as_float(a.y & 0xffff0000u) + __uint_as_float(b.y & 0xffff0000u)};
            const float z[4] = {__uint_as_float(zz.x << 16), __uint_as_float(zz.x & 0xffff0000u), __uint_as_float(zz.y << 16), __uint_as_float(zz.y & 0xffff0000u)};
            const float rstd = rsqrtf(wave_sum(v[0] * v[0] + v[1] * v[1] + v[2] * v[2] + v[3] * v[3]) * (1.f / 256.f) + EPS);
            const f32x4v g4 = *(const f32x4v*)(gg + c0);
            uint2 w; w.x = (unsigned)f2bf(v[0] * rstd * g4[0] * siluf_(z[0])) | ((unsigned)f2bf(v[1] * rstd * g4[1] * siluf_(z[1])) << 16);
            w.y = (unsigned)f2bf(v[2] * rstd * g4[2] * siluf_(z[2])) | ((unsigned)f2bf(v[3] * rstd * g4[3] * siluf_(z[3])) << 16);
            *(uint2*)(hg + o) = w;
        }
    }
}
template <int MODE>
__device__ __forceinline__ void ph_ln(const Params& p, int c) {
    const int tid = threadIdx.x, lane = tid & 63, wid = tid >> 6;
    const float* g = MODE == 1 ? p.in[18] : p.in[26]; const float* bta = MODE == 1 ? p.in[19] : p.in[27];
    const float* mv = (const float*)(p.ws + WS_MOD) + (c * 128 / SEQ) * 6144; bf16_t* u2 = (bf16_t*)(p.ws + WS_U);
    for (int rr = wid; rr < 128; rr += 8) {
        const int row = c * 128 + rr; float* ptr = p.out + (size_t)row * DM;
        f32x4v v[4]; float s = 0.f;
#pragma unroll
        for (int j = 0; j < 4; ++j) { v[j] = *(const f32x4v*)(ptr + j * 256 + lane * 4); s += (v[j][0] + v[j][1]) + (v[j][2] + v[j][3]); }
        const float mean = wave_sum(s) * (1.f / DM); float q = 0.f;
#pragma unroll
        for (int j = 0; j < 4; ++j) { v[j] = v[j] - mean; q += (v[j][0] * v[j][0] + v[j][1] * v[j][1]) + (v[j][2] * v[j][2] + v[j][3] * v[j][3]); }
        const float rstd = rsqrtf(wave_sum(q) * (1.f / DM) + EPS);
#pragma unroll
        for (int j = 0; j < 4; ++j) { const int cc = j * 256 + lane * 4; const f32x4v o = v[j] * rstd * *(const f32x4v*)(g + cc) + *(const f32x4v*)(bta + cc);
            *(f32x4v*)(ptr + cc) = o;
            if (MODE == 1) { const f32x4v sh = *(const f32x4v*)(mv + 3072 + cc), sc = *(const f32x4v*)(mv + 4096 + cc); const f32x4v w = o * (sc + 1.f) + sh;
                ushort4 ww; ww.x = f2bf(w[0]); ww.y = f2bf(w[1]); ww.z = f2bf(w[2]); ww.w = f2bf(w[3]); *(ushort4*)(u2 + (size_t)row * DM + cc) = ww; } }
    }
}
__device__ __forceinline__ void ph_convglu(const Params& p, LAS unsigned char* lds, int c) {
    const int tid = threadIdx.x;
    const bf16_t* gate = (const bf16_t*)(p.ws + WS_BIG + BIG_GATE); bf16_t* val = (bf16_t*)(p.ws + WS_BIG + BIG_VAL);
    LAS float* cw = (LAS float*)lds;
    for (int i = tid; i < 9 * DFF; i += NTHR) cw[i] = p.in[22][i];
    for (int i = tid; i < DFF; i += NTHR) cw[9 * DFF + i] = p.in[23][i];
    __syncthreads();
    const int b = c >> 4, rimg0 = (c & 15) * 2;
    for (int i = tid; i < 128 * 352; i += NTHR) {
        const int rl = i / 352, cgp = i - rl * 352, ch = cgp * 8; const int r = rimg0 + (rl >> 6), col = rl & 63;
        float acc[8];
        { const f32x4v b0 = *(const LAS f32x4v*)(cw + 9 * DFF + ch), b1 = *(const LAS f32x4v*)(cw + 9 * DFF + ch + 4);
          acc[0] = b0[0]; acc[1] = b0[1]; acc[2] = b0[2]; acc[3] = b0[3]; acc[4] = b1[0]; acc[5] = b1[1]; acc[6] = b1[2]; acc[7] = b1[3]; }
#pragma unroll
        for (int di = 0; di < 3; ++di)
#pragma unroll
            for (int dj = 0; dj < 3; ++dj) { const int rr = r + di - 1, cc = col + dj - 1;
                if (rr >= 0 && rr < SEQ / GW && cc >= 0 && cc < GW) {
                    const u32x4v gv = *(const u32x4v*)(gate + ((size_t)b * SEQ + rr * GW + cc) * DFF + ch);
                    const f32x4v w0 = *(const LAS f32x4v*)(cw + (di * 3 + dj) * DFF + ch), w1 = *(const LAS f32x4v*)(cw + (di * 3 + dj) * DFF + ch + 4);
                    acc[0] += __uint_as_float(gv.x << 16) * w0[0]; acc[1] += __uint_as_float(gv.x & 0xffff0000u) * w0[1]; acc[2] += __uint_as_float(gv.y << 16) * w0[2]; acc[3] += __uint_as_float(gv.y & 0xffff0000u) * w0[3];
                    acc[4] += __uint_as_float(gv.z << 16) * w1[0]; acc[5] += __uint_as_float(gv.z & 0xffff0000u) * w1[1]; acc[6] += __uint_as_float(gv.w << 16) * w1[2]; acc[7] += __uint_as_float(gv.w & 0xffff0000u) * w1[3]; } }
        bf16_t* vp = val + ((size_t)c * 128 + rl) * DFF + ch; const u32x4v vv = *(const u32x4v*)vp;
        const float vf[8] = {__uint_as_float(vv.x << 16), __uint_as_float(vv.x & 0xffff0000u), __uint_as_float(vv.y << 16), __uint_as_float(vv.y & 0xffff0000u),
                             __uint_as_float(vv.z << 16), __uint_as_float(vv.z & 0xffff0000u), __uint_as_float(vv.w << 16), __uint_as_float(vv.w & 0xffff0000u)};
        u32x4v o; o.x = (unsigned)f2bf(gelu_tanh(acc[0]) * vf[0]) | ((unsigned)f2bf(gelu_tanh(acc[1]) * vf[1]) << 16); o.y = (unsigned)f2bf(gelu_tanh(acc[2]) * vf[2]) | ((unsigned)f2bf(gelu_tanh(acc[3]) * vf[3]) << 16);
        o.z = (unsigned)f2bf(gelu_tanh(acc[4]) * vf[4]) | ((unsigned)f2bf(gelu_tanh(acc[5]) * vf[5]) << 16); o.w = (unsigned)f2bf(gelu_tanh(acc[6]) * vf[6]) | ((unsigned)f2bf(gelu_tanh(acc[7]) * vf[7]) << 16);
        *(u32x4v*)vp = o;
    }
}

__global__ void __launch_bounds__(NTHR, 2) mega_fwd(Params p) {
    extern __shared__ __attribute__((aligned(16))) unsigned char lds_dyn[];
    LAS unsigned char* lds = (LAS unsigned char*)lds_dyn;
    cg::grid_group grid = cg::this_grid();
    const int c = blockIdx.x;
    unsigned char* ws = p.ws; unsigned char* big = ws + WS_BIG;
    float* modv = (float*)(ws + WS_MOD); float* binp = (float*)(ws + WS_BIN);
    bf16_t* Wt_in = (bf16_t*)(ws + WS_WIN); bf16_t* U = (bf16_t*)(ws + WS_U);
    bf16_t* Pm = (bf16_t*)(big + BIG_PM); bf16_t* Pg = (bf16_t*)(big + BIG_PG); float* small = (float*)(big + BIG_SMALL);
    bf16_t* hm = (bf16_t*)p.out; bf16_t* hg = (bf16_t*)(big + BIG_HG); bf16_t* side = (bf16_t*)(big + BIG_SIDE);
    bf16_t* gate = (bf16_t*)(big + BIG_GATE); bf16_t* val = (bf16_t*)(big + BIG_VAL);
#define GRID_SYNC() grid.sync()
    ph_prologue(p, lds, c);
    GRID_SYNC();
    ph_modulate(p, lds, c);
    GRID_SYNC();
    { pg8::SchedPlain S{U, Wt_in, MT / 256, N_AB / 256, DM, NBLK, c, 0}; pg8::FEpiAB E{Pm, Pg, small, binp}; pg8::gemm_phase(lds, DM, S, E); }
    GRID_SYNC();
    { scan::Args a{Pm, 3072, 0, small, p.in[8], p.in[9], p.in[10], p.in[11], p.in[12], hm}; scan::scan_item<false>(lds, a, c); }
    GRID_SYNC();
    { scan::Args a{Pg, 2048, 0, small, p.in[8], p.in[9], p.in[10], p.in[11], p.in[12], hg}; scan::scan_item<true>(lds, a, c); }
    GRID_SYNC();
    { pg8::SchedPlain S{U, Wt_in + (size_t)PC_SIDE * DM, ML / 256, N_SIDE / 256, DM, NBLK, c, 0}; pg8::FEpiBias E{side, binp + PC_SIDE, 4096, 0}; pg8::gemm_phase(lds, DM, S, E); }
    GRID_SYNC();
    ph_aprep(p, c);
    GRID_SYNC();
    { pg8::SchedDual S{hm, (const bf16_t*)(ws + WS_WBM), hg, (const bf16_t*)(ws + WS_WBG), ML / 256, DM / 256, DM, NBLK, c, 0}; pg8::FEpiMerge E{U, side}; pg8::gemm_phase(lds, DM, S, E); }
    GRID_SYNC();
    { pg8::SchedPlain S{U, (const bf16_t*)(ws + WS_WOUT), ML / 256, DM / 256, DM, NBLK, c, 0}; pg8::FEpiOut E{p.in[0], modv, p.out}; pg8::gemm_phase(lds, DM, S, E); }
    GRID_SYNC();
    ph_ln<1>(p, c);
    GRID_SYNC();
    { pg8::SchedPlain S{U, (const bf16_t*)(ws + WS_WUP), ML / 256, 2 * DFF / 256, DM, NBLK, c, 0}; pg8::FEpiUp E{gate, val, p.in[21]}; pg8::gemm_phase(lds, DM, S, E); }
    GRID_SYNC();
    ph_convglu(p, lds, c);
    GRID_SYNC();
    { pg8::SchedPlain S{val, (const bf16_t*)(ws + WS_WDN), ML / 256, DM / 256, DFF, NBLK, c, 0}; pg8::FEpiDown E{p.out, modv, p.in[25]}; pg8::gemm_phase(lds, DFF, S, E); }
    GRID_SYNC();
    ph_ln<2>(p, c);
}

extern "C" void kernel_launch(void* const* d_in, const int* in_sizes, int n_in, void* d_out, int out_size, void* d_ws, size_t ws_size, hipStream_t stream) {
    if (n_in != 28 || out_size != ML * DM || ws_size < WS_END) { fprintf(stderr, "kernel_launch: unexpected shapes n_in %d out %d ws %zu\n", n_in, out_size, ws_size); return; }
    static bool attr_set = false;
    if (!attr_set) { (void)hipFuncSetAttribute((const void*)mega_fwd, hipFuncAttributeMaxDynamicSharedMemorySize, MEGA_LDS); attr_set = true; }
    Params p{};
    for (int i = 0; i < 28; ++i) p.in[i] = (const float*)d_in[i];
    p.out = (float*)d_out; p.ws = (unsigned char*)d_ws;
    void* args[] = {&p};
    hipError_t e = hipLaunchCooperativeKernel((const void*)mega_fwd, dim3(NBLK), dim3(NTHR), args, MEGA_LDS, stream);
    if (e != hipSuccess) fprintf(stderr, "cooperative launch failed: %s\n", hipGetErrorString(e));
}
```

```cpp
#include <hip/hip_runtime.h>
#include <cstdio>
#include <cstdint>

typedef unsigned short bf16_t;

constexpr int DM = 1024, NB = 16, SEQ = 2048, CTX = 256, GW = 64;
constexpr int ML = NB * SEQ;
constexpr int MC = NB * CTX;
constexpr int MT = ML + MC;
constexpr int NIN = 9280, NINP = 9472;
constexpr int DFF = 2816;
constexpr float ALPHA = 1.189207115002721f;
constexpr float EPS = 1e-5f;
constexpr int PC_QM = 0, PC_KM = 1024, PC_VM = 2048, PC_SMALL = 3072, PC_QG = 3328, PC_KG = 3840, PC_VG = 4352, PC_SIDE = 5376;
constexpr int N_AB = 5376;
constexpr int N_SIDE = 4096;

constexpr size_t MiB = 1u << 20;
constexpr size_t WS_CTL = 0;
constexpr size_t WS_MOD = 1 * MiB;
constexpr size_t WS_BIN = WS_MOD + 512 * 1024;
constexpr size_t WS_WIN = 4 * MiB;
constexpr size_t WS_WBM = WS_WIN + (size_t)NINP * DM * 2;
constexpr size_t WS_WBG = WS_WBM + 2 * MiB;
constexpr size_t WS_WOUT = WS_WBG + 2 * MiB;
constexpr size_t WS_WUP = WS_WOUT + 2 * MiB;
constexpr size_t WS_WDN = WS_WUP + 11 * MiB;
constexpr size_t WS_U = 46 * MiB;
constexpr size_t WS_BIG = 118 * MiB;
constexpr size_t WS_END = 502 * MiB;
static_assert(WS_WDN + (size_t)DM * DFF * 2 <= WS_U, "weights fit");
constexpr size_t BIG_PM = 0;
constexpr size_t BIG_PG = 216 * MiB;
constexpr size_t BIG_SMALL = 360 * MiB;
constexpr size_t BIG_HG = 0;
constexpr size_t BIG_SIDE = 128 * MiB;
constexpr size_t BIG_GATE = 0;
constexpr size_t BIG_VAL = 176 * MiB;

__device__ __forceinline__ float bf2f(bf16_t v) { return __uint_as_float(((unsigned)v) << 16); }
__device__ __forceinline__ bf16_t f2bf(float f) { unsigned u = __float_as_uint(f); return (bf16_t)((u + 0x7fffu + ((u >> 16) & 1u)) >> 16); }
__device__ __forceinline__ float sigmoidf_(float x) { return 1.f / (1.f + __expf(-x)); }
__device__ __forceinline__ float siluf_(float x) { return x * sigmoidf_(x); }
__device__ __forceinline__ float logsigmoidf_(float x) { return fminf(x, 0.f) - log1pf(__expf(-fabsf(x))); }
__device__ __forceinline__ float gelu_tanh(float x) { const float u = 0.7978845608028654f * (x + 0.044715f * x * x * x); return 0.5f * x * (1.f + tanhf(u)); }
__device__ __forceinline__ float wave_sum(float v) {
#pragma unroll
    for (int o = 1; o < 64; o <<= 1) v += __shfl_xor(v, o);
    return v;
}

namespace pg8 {
#define PG8_LAS __attribute__((address_space(3)))
typedef short bf16x8 __attribute__((ext_vector_type(8)));
typedef float f32x4 __attribute__((ext_vector_type(4)));
typedef unsigned u32x4 __attribute__((ext_vector_type(4)));
constexpr int BM = 256, BK = 64, HALF = 128, HTB = HALF * BK * 2, STAGE_BYTES = 8 * HTB, NXCD = 8, WGM = 8;
__host__ __device__ __forceinline__ int lds_byte(int r, int c) { const int st = (r >> 4) * 2 + (c >> 5), rr = r & 15, cc = c & 31, ob = rr * 64 + cc * 2; return st * 1024 + (ob ^ (((ob >> 9) & 1) << 5)); }
__host__ __device__ __forceinline__ void stage_rc(int b, int& R, int& C) { const int st = b / 1024, sb = b % 1024, swz = sb ^ (((sb >> 9) & 1) << 5); R = (st >> 1) * 16 + swz / 64; C = (st & 1) * 32 + (swz % 64) / 2; }
__host__ __device__ __forceinline__ int perm32(int rho) { const int n = rho >> 4, i = rho & 15; return 8 * (i >> 2) + 4 * n + (i & 3); }
struct Unit { int pm, pn, tag; const bf16_t* A; const bf16_t* B; };
__host__ __device__ __forceinline__ bool tile_of(long L, int nM, int nN, int& pm, int& pn) {
    const int nwg = nM * nN; if (L >= nwg) return false;
    int wgid = (int)L; { const int q = nwg / NXCD, r = nwg % NXCD, xcd = wgid % NXCD, off = wgid / NXCD; wgid = (xcd < r ? xcd * (q + 1) : r * (q + 1) + (xcd - r) * q) + off; }
    const int nig = WGM * nN, gid = wgid / nig, fm = gid * WGM, gsz = (nM - fm) < WGM ? (nM - fm) : WGM;
    pm = fm + ((wgid % nig) % gsz); pn = (wgid % nig) / gsz; return true;
}
struct SchedPlain {
    const bf16_t* A; const bf16_t* Bt; int nM, nN, K, G, c, pad;
    __device__ __forceinline__ bool next(int i, Unit& u) const { if (!tile_of((long)i * G + c, nM, nN, u.pm, u.pn)) return false; u.tag = 1; u.A = A + (size_t)u.pm * BM * K; u.B = Bt + (size_t)u.pn * BM * K; return true; }
};
struct SchedDual {
    const bf16_t* A0; const bf16_t* B0; const bf16_t* A1; const bf16_t* B1; int nM, nN, K, G, c, pad;
    __device__ __forceinline__ bool next(int i, Unit& u) const { if (!tile_of((long)(i >> 1) * G + c, nM, nN, u.pm, u.pn)) return false; u.tag = i & 1;
        u.A = ((i & 1) ? A1 : A0) + (size_t)u.pm * BM * K; u.B = ((i & 1) ? B1 : B0) + (size_t)u.pn * BM * K; return true; }
};
__device__ __forceinline__ unsigned cvt_pk_bf16(float lo, float hi) { unsigned r; asm volatile("v_cvt_pk_bf16_f32 %0, %1, %2" : "=v"(r) : "v"(lo), "v"(hi)); return r; }
__device__ __forceinline__ u32x4 pack8(f32x4 v0, f32x4 v1) { u32x4 w; w.x = cvt_pk_bf16(v0[0], v0[1]); w.y = cvt_pk_bf16(v0[2], v0[3]); w.z = cvt_pk_bf16(v1[0], v1[1]); w.w = cvt_pk_bf16(v1[2], v1[3]); return w; }
__device__ __forceinline__ void unpack8(u32x4 w, f32x4& v0, f32x4& v1) {
    v0[0] = __uint_as_float(w.x << 16); v0[1] = __uint_as_float(w.x & 0xffff0000u); v0[2] = __uint_as_float(w.y << 16); v0[3] = __uint_as_float(w.y & 0xffff0000u);
    v1[0] = __uint_as_float(w.z << 16); v1[1] = __uint_as_float(w.z & 0xffff0000u); v1[2] = __uint_as_float(w.w << 16); v1[3] = __uint_as_float(w.w & 0xffff0000u); }

template <class Epi, class Sched>
__device__ __forceinline__ void gemm_phase(PG8_LAS unsigned char* lds, const int K, const Sched& S, const Epi& E) {
    const int tid = threadIdx.x, wid = __builtin_amdgcn_readfirstlane(tid >> 6), lane = tid & 63, wr = wid >> 2, wc = wid & 3, fr = lane & 15, fq = lane >> 4;
    const int nt = K / BK;
    unsigned voffA[2], voffB[2];
#pragma unroll
    for (int i = 0; i < 2; ++i) { int R, C; stage_rc(tid * 16 + i * 8192, R, C); const int Rb = (R & ~31) + perm32(R & 31);
        voffA[i] = (unsigned)(R * K + C) * 2u; voffB[i] = (unsigned)(Rb * K + C) * 2u; }
    const size_t kstep = (size_t)(BK * 2);
    const size_t hstep = (size_t)HALF * K * 2;
    const unsigned ldsw = (unsigned)wid * 1024u;
    const int aoff = lds_byte(wr * 64 + fr, fq * 8), boff = lds_byte(wc * 32 + fr, fq * 8);
#define PG8_SA(b, h) (((b) * 2 + (h)) * HTB)
#define PG8_SB(b, h) ((4 + (b) * 2 + (h)) * HTB)
#define PG8_STAGE(bufoff, gbase, voff) do { _Pragma("unroll") for (int _i = 0; _i < 2; ++_i) \
        __builtin_amdgcn_global_load_lds((const unsigned*)((const char*)(gbase) + (voff)[_i]), (PG8_LAS unsigned*)(lds + (bufoff) + ldsw + _i * 8192), 16, 0, 0); } while (0)
#define PG8_LDA(dst, b, h) do { _Pragma("unroll") for (int m = 0; m < 4; ++m) _Pragma("unroll") for (int k = 0; k < 2; ++k) dst[m][k] = *(const PG8_LAS bf16x8*)(lds + PG8_SA(b, h) + aoff + m * 2048 + k * 1024); } while (0)
#define PG8_LDB(dst, b, h) do { _Pragma("unroll") for (int n = 0; n < 2; ++n) _Pragma("unroll") for (int k = 0; k < 2; ++k) dst[n][k] = *(const PG8_LAS bf16x8*)(lds + PG8_SB(b, h) + boff + n * 2048 + k * 1024); } while (0)
#define PG8_MMA(ai, bj, At, Bt) do { __builtin_amdgcn_s_setprio(1); _Pragma("unroll") for (int m = 0; m < 4; ++m) _Pragma("unroll") for (int n = 0; n < 2; ++n) _Pragma("unroll") for (int k = 0; k < 2; ++k) \
        acc[ai][bj][m][n] = __builtin_amdgcn_mfma_f32_16x16x32_bf16(Bt[n][k], At[m][k], acc[ai][bj][m][n], 0, 0, 0); __builtin_amdgcn_s_setprio(0); } while (0)
#define PG8_WAIT_V(n) asm volatile("s_waitcnt vmcnt(" #n ")" ::: "memory")
#define PG8_WAIT_L(n) asm volatile("s_waitcnt lgkmcnt(" #n ")" ::: "memory")
#define PG8_BAR __builtin_amdgcn_s_barrier()
#define PG8_SCHED __builtin_amdgcn_sched_barrier(0)
    Unit cur, nxt; int ui = 0;
    if (!S.next(0, cur)) return;
    f32x4 acc[2][2][4][2];
#pragma unroll
    for (int a = 0; a < 2; ++a)
#pragma unroll
        for (int b = 0; b < 2; ++b)
#pragma unroll
            for (int m = 0; m < 4; ++m)
#pragma unroll
                for (int n = 0; n < 2; ++n) acc[a][b][m][n] = (f32x4){0.f, 0.f, 0.f, 0.f};
    bf16x8 At[4][2], B0[2][2], B1[2][2];
    const char* cA = (const char*)cur.A; const char* cB = (const char*)cur.B;
    PG8_STAGE(PG8_SB(0, 0), cB, voffB); PG8_STAGE(PG8_SB(0, 1), cB + hstep, voffB); PG8_STAGE(PG8_SA(0, 0), cA, voffA); PG8_STAGE(PG8_SA(0, 1), cA + hstep, voffA);
    if (wr == 1) PG8_BAR;
    PG8_WAIT_V(2); PG8_BAR;
    PG8_STAGE(PG8_SB(1, 0), cB + kstep, voffB); PG8_STAGE(PG8_SA(1, 0), cA + kstep, voffA); PG8_STAGE(PG8_SB(1, 1), cB + hstep + kstep, voffB);
    PG8_WAIT_V(6); PG8_BAR;
    for (;;) {
        const bool has_next = S.next(ui + 1, nxt);
        const char* nA = has_next ? (const char*)nxt.A : cA; const char* nB = has_next ? (const char*)nxt.B : cB;
        for (int t = 0; t < nt; t += 2) {
            const bool last = (t == nt - 2);
            const char* a1 = cA + (size_t)(t + 1) * kstep;
            const char* a2 = last ? nA : cA + (size_t)(t + 2) * kstep; const char* b2 = last ? nB : cB + (size_t)(t + 2) * kstep;
            const char* a3 = a2 + kstep; const char* b3 = b2 + kstep;
            PG8_LDB(B0, 0, 0); PG8_LDB(B1, 0, 1); PG8_SCHED; PG8_LDA(At, 0, 0); PG8_STAGE(PG8_SA(1, 1), a1 + hstep, voffA);
            PG8_WAIT_V(8); PG8_WAIT_L(0); PG8_BAR; PG8_MMA(0, 0, At, B0); PG8_MMA(0, 1, At, B1); PG8_BAR; PG8_SCHED;
            PG8_LDA(At, 0, 1); PG8_STAGE(PG8_SB(0, 0), b2, voffB); PG8_STAGE(PG8_SB(0, 1), b2 + hstep, voffB); PG8_STAGE(PG8_SA(0, 0), a2, voffA);
            PG8_WAIT_V(8); PG8_WAIT_L(0); PG8_BAR; PG8_MMA(1, 0, At, B0); PG8_MMA(1, 1, At, B1); PG8_BAR; PG8_SCHED;
            PG8_LDB(B0, 1, 0); PG8_LDB(B1, 1, 1); PG8_SCHED; PG8_LDA(At, 1, 0); PG8_STAGE(PG8_SA(0, 1), a2 + hstep, voffA);
            PG8_WAIT_V(8); PG8_WAIT_L(0); PG8_BAR; PG8_MMA(0, 0, At, B0); PG8_MMA(0, 1, At, B1); PG8_BAR; PG8_SCHED;
            PG8_LDA(At, 1, 1); PG8_STAGE(PG8_SB(1, 0), b3, voffB); PG8_STAGE(PG8_SB(1, 1), b3 + hstep, voffB); PG8_STAGE(PG8_SA(1, 0), a3, voffA);
            PG8_WAIT_V(8); PG8_WAIT_L(0); PG8_BAR; PG8_MMA(1, 0, At, B0); PG8_MMA(1, 1, At, B1); PG8_BAR; PG8_SCHED;
        }
        if (wr == 0) PG8_BAR;
        const bool keep = E(acc, cur, wr, wc, fr, fq);
        if (!has_next) break;
        if (!keep) {
#pragma unroll
            for (int a = 0; a < 2; ++a)
#pragma unroll
                for (int b = 0; b < 2; ++b)
#pragma unroll
                    for (int m = 0; m < 4; ++m)
#pragma unroll
                        for (int n = 0; n < 2; ++n) acc[a][b][m][n] = (f32x4){0.f, 0.f, 0.f, 0.f};
        }
        cur = nxt; cA = nA; cB = nB; ++ui;
        if (wr == 1) PG8_BAR;
    }
    PG8_WAIT_V(0);
    PG8_BAR;
#undef PG8_SA
#undef PG8_SB
#undef PG8_STAGE
#undef PG8_LDA
#undef PG8_LDB
#undef PG8_MMA
#undef PG8_WAIT_V
#undef PG8_WAIT_L
#undef PG8_BAR
#undef PG8_SCHED
}

#define PG8_FRAG_LOOP for (int ai = 0; ai < 2; ++ai) _Pragma("unroll") for (int m = 0; m < 4; ++m) _Pragma("unroll") for (int bj = 0; bj < 2; ++bj)
struct FEpiAB { bf16_t* Pm; bf16_t* Pg; float* small; const float* bias;
    __device__ __forceinline__ bool operator()(const f32x4 (&acc)[2][2][4][2], const Unit& u, int wr, int wc, int fr, int fq) const {
        const int row0 = u.pm * BM + wr * 64 + fr, ct = u.pn, cin = wc * 32 + 8 * fq;
        f32x4 bv[2][2];
#pragma unroll
        for (int bj = 0; bj < 2; ++bj)
#pragma unroll
            for (int n = 0; n < 2; ++n) bv[bj][n] = *(const f32x4*)(bias + ct * BM + cin + bj * HALF + 4 * n);
        if (ct == 12) {
            if (cin < 64) {
#pragma unroll
                for (int ai = 0; ai < 2; ++ai)
#pragma unroll
                    for (int m = 0; m < 4; ++m) { float* p = small + (size_t)(row0 + ai * HALF + m * 16) * 64 + cin;
                        *(f32x4*)p = acc[ai][0][m][0] + bv[0][0]; *(f32x4*)(p + 4) = acc[ai][0][m][1] + bv[0][1]; }
            }
            return false;
        }
        bf16_t* base; int ld;
        if (ct < 12) { base = Pm + ct * BM; ld = 3072; } else { base = Pg + (ct - 13) * BM; ld = 2048; }
#pragma unroll
        PG8_FRAG_LOOP { *(u32x4*)(base + (size_t)(row0 + ai * HALF + m * 16) * ld + cin + bj * HALF) = pack8(acc[ai][bj][m][0] + bv[bj][0], acc[ai][bj][m][1] + bv[bj][1]); }
        return false;
    }
};
struct FEpiBias { bf16_t* O; const float* bias; int ld, pad;
    __device__ __forceinline__ bool operator()(const f32x4 (&acc)[2][2][4][2], const Unit& u, int wr, int wc, int fr, int fq) const {
        const int row0 = u.pm * BM + wr * 64 + fr, col0 = u.pn * BM + wc * 32 + 8 * fq;
        f32x4 bv[2][2];
#pragma unroll
        for (int bj = 0; bj < 2; ++bj)
#pragma unroll
            for (int n = 0; n < 2; ++n) bv[bj][n] = *(const f32x4*)(bias + col0 + bj * HALF + 4 * n);
#pragma unroll
        PG8_FRAG_LOOP { *(u32x4*)(O + (size_t)(row0 + ai * HALF + m * 16) * ld + col0 + bj * HALF) = pack8(acc[ai][bj][m][0] + bv[bj][0], acc[ai][bj][m][1] + bv[bj][1]); }
        return false;
    }
};
struct FEpiUp { bf16_t* gate; bf16_t* val; const float* bias;
    __device__ __forceinline__ bool operator()(const f32x4 (&acc)[2][2][4][2], const Unit& u, int wr, int wc, int fr, int fq) const {
        const int row0 = u.pm * BM + wr * 64 + fr, cin = wc * 32 + 8 * fq;
        bf16_t* base = u.pn < 11 ? gate + u.pn * BM : val + (u.pn - 11) * BM;
        f32x4 bv[2][2];
#pragma unroll
        for (int bj = 0; bj < 2; ++bj)
#pragma unroll
            for (int n = 0; n < 2; ++n) bv[bj][n] = *(const f32x4*)(bias + u.pn * BM + cin + bj * HALF + 4 * n);
#pragma unroll
        PG8_FRAG_LOOP { *(u32x4*)(base + (size_t)(row0 + ai * HALF + m * 16) * DFF + cin + bj * HALF) = pack8(acc[ai][bj][m][0] + bv[bj][0], acc[ai][bj][m][1] + bv[bj][1]); }
        return false;
    }
};
__device__ __forceinline__ float fsig(float x) { return __builtin_amdgcn_rcpf(1.f + __expf(-x)); }
struct FEpiMerge { bf16_t* Z; const bf16_t* side;
    __device__ __forceinline__ bool operator()(f32x4 (&acc)[2][2][4][2], const Unit& u, int wr, int wc, int fr, int fq) const {
        const int row0 = u.pm * BM + wr * 64 + fr, col0 = u.pn * BM + wc * 32 + 8 * fq;
        if (u.tag == 0) {
#pragma unroll
            PG8_FRAG_LOOP { const bf16_t* sp = side + (size_t)(row0 + ai * HALF + m * 16) * 4096 + col0 + bj * HALF;
                f32x4 a0, a1, b0, b1; unpack8(*(const u32x4*)(sp + 2048), a0, a1); unpack8(*(const u32x4*)(sp + 3072), b0, b1);
#pragma unroll
                for (int j = 0; j < 4; ++j) { acc[ai][bj][m][0][j] *= (1.f + __expf(-b0[j])) * fsig(a0[j]); acc[ai][bj][m][1][j] *= (1.f + __expf(-b1[j])) * fsig(a1[j]); } }
            return true;
        }
#pragma unroll
        PG8_FRAG_LOOP { const bf16_t* sp = side + (size_t)(row0 + ai * HALF + m * 16) * 4096 + col0 + bj * HALF;
            f32x4 b0, b1; unpack8(*(const u32x4*)(sp + 3072), b0, b1); f32x4 v0 = acc[ai][bj][m][0], v1 = acc[ai][bj][m][1];
#pragma unroll
            for (int j = 0; j < 4; ++j) { v0[j] *= fsig(b0[j]); v1[j] *= fsig(b1[j]); }
            *(u32x4*)(Z + (size_t)(row0 + ai * HALF + m * 16) * DM + col0 + bj * HALF) = pack8(v0, v1); }
        return false;
    }
};
struct FEpiOut { const float* x; const float* modv; float* r1;
    __device__ __forceinline__ bool operator()(const f32x4 (&acc)[2][2][4][2], const Unit& u, int wr, int wc, int fr, int fq) const {
        const int row0 = u.pm * BM + wr * 64 + fr, col0 = u.pn * BM + wc * 32 + 8 * fq;
        const float* g = modv + (u.pm * BM / SEQ) * 6144 + 2048 + col0;
        f32x4 gv[2][2];
#pragma unroll
        for (int bj = 0; bj < 2; ++bj)
#pragma unroll
            for (int n = 0; n < 2; ++n) gv[bj][n] = *(const f32x4*)(g + bj * HALF + 4 * n);
#pragma unroll
        PG8_FRAG_LOOP { const size_t o = (size_t)(row0 + ai * HALF + m * 16) * DM + col0 + bj * HALF;
            const f32x4 x0 = *(const f32x4*)(x + o), x1 = *(const f32x4*)(x + o + 4);
            *(f32x4*)(r1 + o) = x0 * ALPHA + gv[bj][0] * acc[ai][bj][m][0]; *(f32x4*)(r1 + o + 4) = x1 * ALPHA + gv[bj][1] * acc[ai][bj][m][1]; }
        return false;
    }
};
struct FEpiDown { float* h; const float* modv; const float* b_down;
    __device__ __forceinline__ bool operator()(const f32x4 (&acc)[2][2][4][2], const Unit& u, int wr, int wc, int fr, int fq) const {
        const int row0 = u.pm * BM + wr * 64 + fr, col0 = u.pn * BM + wc * 32 + 8 * fq;
        const float* g = modv + (u.pm * BM / SEQ) * 6144 + 5120 + col0;
        f32x4 gv[2][2], bv[2][2];
#pragma unroll
        for (int bj = 0; bj < 2; ++bj)
#pragma unroll
            for (int n = 0; n < 2; ++n) { gv[bj][n] = *(const f32x4*)(g + bj * HALF + 4 * n); bv[bj][n] = *(const f32x4*)(b_down + col0 + bj * HALF + 4 * n); }
#pragma unroll
        PG8_FRAG_LOOP { float* p = h + (size_t)(row0 + ai * HALF + m * 16) * DM + col0 + bj * HALF;
            const f32x4 h0 = *(const f32x4*)p, h1 = *(const f32x4*)(p + 4);
            *(f32x4*)p = h0 * ALPHA + gv[bj][0] * (acc[ai][bj][m][0] + bv[bj][0]); *(f32x4*)(p + 4) = h1 * ALPHA + gv[bj][1] * (acc[ai][bj][m][1] + bv[bj][1]); }
        return false;
    }
};
}

namespace scan {
#define LAS __attribute__((address_space(3)))
typedef short bf16x8 __attribute__((ext_vector_type(8)));
typedef short s16x4 __attribute__((ext_vector_type(4)));
typedef float f32x4 __attribute__((ext_vector_type(4)));
typedef unsigned u32x4 __attribute__((ext_vector_type(4)));
typedef unsigned u32x2 __attribute__((ext_vector_type(2)));
constexpr int RS = 288, RSP = 144, RSE = 528;
constexpr int L_RAWQ = 0, L_RAWK = 17408, L_RAWV = 34816;
constexpr int L_Q = 51200, L_K = L_Q + 64 * RS, L_V = L_K + 64 * RS;
constexpr int L_SC = 106496;
constexpr int SC_EQ = 0, SC_EK = 64, SC_FL = 128, SC_QN = 192, SC_RS = 256  , SC_N = 384  , SC_MISC = 640, SC_DEC = 704  , SC_GB = 832  , SC_END = 960;
constexpr int L_GW = L_SC + SC_END * 4;
constexpr int L_E = L_GW + 8192;
constexpr int L_P = L_E;
constexpr int LDS_BYTES = L_E + 64 * RSE;
static_assert(LDS_BYTES <= 160 * 1024, "scan LDS");

typedef float f32x2_t __attribute__((ext_vector_type(2))); typedef __bf16 bf16x2_t __attribute__((ext_vector_type(2)));
__device__ __forceinline__ unsigned cvt_pk(float lo, float hi) { f32x2_t v = {lo, hi}; bf16x2_t b = __builtin_convertvector(v, bf16x2_t); return __builtin_bit_cast(unsigned, b); }
__device__ __forceinline__ s16x4 tr16(const LAS unsigned char* p) { return __builtin_bit_cast(s16x4, __builtin_amdgcn_ds_read_tr16_b64_v4i16((LAS s16x4*)p)); }
__device__ __forceinline__ bf16x8 cat4(s16x4 a, s16x4 b) { return (bf16x8){a[0], a[1], a[2], a[3], b[0], b[1], b[2], b[3]}; }
__device__ __forceinline__ void unpack8f(u32x4 w, float* v) {
    v[0] = __uint_as_float(w.x << 16); v[1] = __uint_as_float(w.x & 0xffff0000u); v[2] = __uint_as_float(w.y << 16); v[3] = __uint_as_float(w.y & 0xffff0000u);
    v[4] = __uint_as_float(w.z << 16); v[5] = __uint_as_float(w.z & 0xffff0000u); v[6] = __uint_as_float(w.w << 16); v[7] = __uint_as_float(w.w & 0xffff0000u); }
__device__ __forceinline__ float fsilu(float x) { return x * __builtin_amdgcn_rcpf(1.f + __expf(-x)); }

struct Args {
    const bf16_t* P; int ld, pad;
    const float* small;
    const float* conv_qk;
    const float* gw_f; const float* gb_f; const float* gw_b; const float* gb_b;
    bf16_t* hout;
};

template <bool GLA>
__device__ __forceinline__ void scan_item(LAS unsigned char* lds, const Args& a, const int item) {
    const int tid = threadIdx.x, lane = tid & 63, wid = __builtin_amdgcn_readfirstlane(tid >> 6), c = lane & 15, g = lane >> 4;
    LAS float* sc = (LAS float*)(lds + L_SC);
    int b, h, dir, half = 0;
    if (GLA) { half = item & 1; dir = (item >> 1) & 1; h = (item >> 2) & 3; b = item >> 4; } else { dir = item & 1; h = (item >> 1) & 7; b = item >> 4; }
    const int colq = GLA ? h * 128 : h * 128, colk = GLA ? 512 + h * 128 : 1024 + h * 128, colv = GLA ? 1024 + h * 256 + half * 128 : 2048 + h * 128;
    const int ocol = GLA ? h * 256 + half * 128 : h * 128;
    bf16_t* hout = a.hout + (size_t)dir * ML * DM;
    const float* gw = dir ? a.gw_b : a.gw_f; const float* gbp = dir ? a.gb_b : a.gb_f;

    for (int i = tid; i < 256; i += 512) sc[SC_N + i] = 0.f;
    if (GLA) {
        for (int i = tid; i < 2048; i += 512) { const int d = i >> 4, k = i & 15; ((LAS float*)(lds + L_GW))[i] = gw[k * 512 + h * 128 + d]; }
        if (tid < 128) sc[SC_GB + tid] = gbp[h * 128 + tid];
    }
    float wq[3][8], wk[3][8];
    if (!GLA) {
        const int cg = tid & 15;
#pragma unroll
        for (int e = 0; e < 8; ++e) { const int cq = h * 128 + cg * 8 + e, ck = 1024 + cq;
            const float q0 = a.conv_qk[cq], q1 = a.conv_qk[2048 + cq], q2 = a.conv_qk[4096 + cq], k0 = a.conv_qk[ck], k1 = a.conv_qk[2048 + ck], k2 = a.conv_qk[4096 + ck];
            wq[0][e] = dir ? q2 : q0; wq[1][e] = q1; wq[2][e] = dir ? q0 : q2; wk[0][e] = dir ? k2 : k0; wk[1][e] = k1; wk[2][e] = dir ? k0 : k2; }
    }
    f32x4 Cst[8]; f32x4 nst = (f32x4){0.f, 0.f, 0.f, 0.f};
#pragma unroll
    for (int j = 0; j < 8; ++j) Cst[j] = (f32x4){0.f, 0.f, 0.f, 0.f};
    float m_run = 0.f;
    float pre_li = 0.f, pre_lf = 0.f;
    f32x4 pre_r[4];
#pragma unroll
    for (int i = 0; i < 4; ++i) pre_r[i] = (f32x4){0.f, 0.f, 0.f, 0.f};

#define SCAN_ROW(cc_, p_, rowv) do { const int seg_ = (cc_) < 4 ? 0 : 1; const int T_ = seg_ ? SEQ : CTX; const int row0_ = seg_ ? b * SEQ : ML + b * CTX; \
        int pp_ = (p_); pp_ = pp_ < 0 ? 0 : (pp_ > T_ - 1 ? T_ - 1 : pp_); const int t_ = dir ? (T_ - 1 - pp_) : pp_; rowv = row0_ + t_; } while (0)
#define SCAN_ISSUE(cc_) do { const int ci_ = (cc_) < 4 ? (cc_) : (cc_) - 4; \
        for (int n = wid; n < 50; n += 8) { \
            const int which = n < 17 ? 0 : (n < 34 ? 1 : 2); const int nn = n - (which == 0 ? 0 : which == 1 ? 17 : 34); \
            const int piece = nn * 64 + lane; int row; const char* src; unsigned dst; \
            { const int j = piece >> 4, cgp = piece & 15; SCAN_ROW(cc_, ci_ * 64 + j - (which < 2 ? 1 : 0), row); \
                src = (const char*)(a.P + (size_t)row * a.ld + (which == 0 ? colq : which == 1 ? colk : colv) + cgp * 8); dst = (which == 0 ? L_RAWQ : which == 1 ? L_RAWK : L_RAWV) + nn * 1024; } \
            __builtin_amdgcn_global_load_lds((const unsigned*)src, (LAS unsigned*)(lds + dst), 16, 0, 0); } \
        if (!GLA && wid == 0) { int row; SCAN_ROW(cc_, ci_ * 64 + lane, row); pre_li = a.small[(size_t)row * 64 + dir * 8 + h]; pre_lf = a.small[(size_t)row * 64 + 16 + dir * 8 + h]; } \
        if (GLA) { int row; SCAN_ROW(cc_, ci_ * 64 + lane, row); const float* rp_ = a.small + (size_t)row * 64 + 32 + dir * 16; \
            _Pragma("unroll") for (int i_ = 0; i_ < 4; ++i_) pre_r[i_] = *(const f32x4*)(rp_ + 4 * i_); } } while (0)

    SCAN_ISSUE(0);
    for (int cc = 0; cc < 36; ++cc) {
        const int seg = cc < 4 ? 0 : 1, ci = seg ? cc - 4 : cc, T = seg ? SEQ : CTX;
        const int par = cc & 1;
        asm volatile("s_waitcnt vmcnt(0)" ::: "memory");
        __syncthreads();
        if (!GLA) {
            if (wid == 0) {
                const float li = pre_li, lf = logsigmoidf_(pre_lf);
                float bs = lf;
#pragma unroll
                for (int o = 1; o < 64; o <<= 1) { const float v = __shfl_up(bs, o); if (lane >= o) bs += v; }
                const float gg = li - bs; float cm = gg;
#pragma unroll
                for (int o = 1; o < 64; o <<= 1) { const float v = __shfl_up(cm, o); if (lane >= o) cm = fmaxf(cm, v); }
                const float M = fmaxf(m_run, cm), M63 = __shfl(M, 63), b63 = __shfl(bs, 63);
                sc[SC_EQ + lane] = __expf(fminf(M63 - M, 80.f)) * 0.08838834764831845f;
                sc[SC_EK + lane] = __expf(gg - M63);
                sc[SC_FL + lane] = __expf(-(bs + M));
                if (lane == 0) sc[SC_MISC] = __expf(m_run - M63);
                m_run = b63 + M63;
            }
        } else {
            float r[16];
#pragma unroll
            for (int i = 0; i < 4; ++i) { const f32x4 v = pre_r[i]; r[4 * i] = v[0]; r[4 * i + 1] = v[1]; r[4 * i + 2] = v[2]; r[4 * i + 3] = v[3]; }
            for (int e = 0; e < 16; ++e) { const int d = wid * 16 + e; const LAS float* gwd = (const LAS float*)(lds + L_GW) + d * 16;
                float acc = sc[SC_GB + d];
#pragma unroll
                for (int i = 0; i < 4; ++i) { const f32x4 v = *(const LAS f32x4*)(gwd + 4 * i); acc += r[4 * i] * v[0] + r[4 * i + 1] * v[1] + r[4 * i + 2] * v[2] + r[4 * i + 3] * v[3]; }
                float bs = logsigmoidf_(acc) * 0.0625f;
#pragma unroll
                for (int o = 1; o < 64; o <<= 1) { const float v = __shfl_up(bs, o); if (lane >= o) bs += v; }
                const float be = __shfl(bs, 63);
                *(LAS float*)(lds + L_E + lane * RSE + d * 4) = bs - be;
                if (lane == 63) sc[SC_DEC + d] = __expf(be);
            }
        }
        __syncthreads();
#pragma unroll
        for (int it = 0; it < 2; ++it) {
            const int t = (tid >> 4) + 32 * it, cg = tid & 15; const int p = ci * 64 + t;
            const LAS unsigned char* rq = lds + L_RAWQ + (t + 1) * 256 + cg * 16; const LAS unsigned char* rk = lds + L_RAWK + (t + 1) * 256 + cg * 16;
            float xq[8], xk[8];
            if (!GLA) {
                float a0[8], a1[8], a2[8];
                const bool hp = p > 0, hn = p < T - 1;
                if (seg) {
                    unpack8f(*(const LAS u32x4*)(rq - 256), a0); unpack8f(*(const LAS u32x4*)rq, a1); unpack8f(*(const LAS u32x4*)(rq + 256), a2);
                    const float eq = sc[SC_EQ + t];
#pragma unroll
                    for (int e = 0; e < 8; ++e) xq[e] = fsilu(wq[1][e] * a1[e] + (hp ? wq[0][e] * a0[e] : 0.f) + (hn ? wq[2][e] * a2[e] : 0.f)) * eq;
                }
                unpack8f(*(const LAS u32x4*)(rk - 256), a0); unpack8f(*(const LAS u32x4*)rk, a1); unpack8f(*(const LAS u32x4*)(rk + 256), a2);
                const float ek = sc[SC_EK + t];
#pragma unroll
                for (int e = 0; e < 8; ++e) xk[e] = fsilu(wk[1][e] * a1[e] + (hp ? wk[0][e] * a0[e] : 0.f) + (hn ? wk[2][e] * a2[e] : 0.f)) * ek;
            } else {
                float a1[8], ev[8];
                const LAS float* ep = (const LAS float*)(lds + L_E + t * RSE) + cg * 8;
                { const f32x4 e0 = *(const LAS f32x4*)ep, e1 = *(const LAS f32x4*)(ep + 4); ev[0] = e0[0]; ev[1] = e0[1]; ev[2] = e0[2]; ev[3] = e0[3]; ev[4] = e1[0]; ev[5] = e1[1]; ev[6] = e1[2]; ev[7] = e1[3]; }
                if (seg) { unpack8f(*(const LAS u32x4*)rq, a1);
#pragma unroll
                    for (int e = 0; e < 8; ++e) xq[e] = a1[e] * 0.08838834764831845f * __expf(fminf(ev[e], 80.f)); }
                unpack8f(*(const LAS u32x4*)rk, a1);
#pragma unroll
                for (int e = 0; e < 8; ++e) xk[e] = a1[e] * __expf(-ev[e]);
            }
            if (seg) { u32x4 w; w.x = cvt_pk(xq[0], xq[1]); w.y = cvt_pk(xq[2], xq[3]); w.z = cvt_pk(xq[4], xq[5]); w.w = cvt_pk(xq[6], xq[7]); *(LAS u32x4*)(lds + L_Q + t * RS + cg * 16) = w; }
            { u32x4 w; w.x = cvt_pk(xk[0], xk[1]); w.y = cvt_pk(xk[2], xk[3]); w.z = cvt_pk(xk[4], xk[5]); w.w = cvt_pk(xk[6], xk[7]); *(LAS u32x4*)(lds + L_K + t * RS + cg * 16) = w; }
            *(LAS u32x4*)(lds + L_V + t * RS + cg * 16) = *(const LAS u32x4*)(lds + L_RAWV + t * 256 + cg * 16);
        }
        __syncthreads();
        if (cc + 1 < 36) SCAN_ISSUE(cc + 1);
        float dsc = 1.f;
        if (!GLA) { dsc = sc[SC_MISC];
#pragma unroll
            for (int j = 0; j < 8; ++j) Cst[j] *= dsc;
            nst *= dsc;
        } else {
#pragma unroll
            for (int j = 0; j < 8; ++j) { const f32x4 dv = *(const LAS f32x4*)(sc + SC_DEC + 32 * (j >> 1) + 8 * g + 4 * (j & 1)); Cst[j] *= dv; }
        }
        f32x4 O[4];
#pragma unroll
        for (int i = 0; i < 4; ++i) O[i] = (f32x4){0.f, 0.f, 0.f, 0.f};
        if (seg) {
            if (!GLA) {
                const int l = tid >> 3, part = tid & 7; const LAS unsigned char* qp = lds + L_Q + l * RS + part * 32; const LAS float* np = sc + SC_N + par * 128 + part * 16;
                float q[16]; unpack8f(*(const LAS u32x4*)qp, q); unpack8f(*(const LAS u32x4*)(qp + 16), q + 8);
                float s = 0.f;
#pragma unroll
                for (int i = 0; i < 4; ++i) { const f32x4 nv = *(const LAS f32x4*)(np + 4 * i); s += q[4 * i] * nv[0] + q[4 * i + 1] * nv[1] + q[4 * i + 2] * nv[2] + q[4 * i + 3] * nv[3]; }
                s += __shfl_xor(s, 1); s += __shfl_xor(s, 2); s += __shfl_xor(s, 4);
                if (part == 0) sc[SC_QN + l] = s * dsc;
            }
            const int lt = wid >> 1, sth = wid & 1;
            bf16x8 qf[4];
#pragma unroll
            for (int kk = 0; kk < 4; ++kk) qf[kk] = *(const LAS bf16x8*)(lds + L_Q + (16 * lt + c) * RS + (32 * kk + 8 * g) * 2);
            float rs = 0.f;
#pragma unroll
            for (int s2 = 0; s2 < 2; ++s2) { const int st = 2 * sth + s2;
                f32x4 acc = (f32x4){0.f, 0.f, 0.f, 0.f};
                if (st <= lt) {
#pragma unroll
                    for (int kk = 0; kk < 4; ++kk) { const bf16x8 kf = *(const LAS bf16x8*)(lds + L_K + (16 * st + c) * RS + (32 * kk + 8 * g) * 2); acc = __builtin_amdgcn_mfma_f32_16x16x32_bf16(kf, qf[kk], acc, 0, 0, 0); }
                    if (st == lt) {
#pragma unroll
                        for (int i = 0; i < 4; ++i) if (4 * g + i > c) acc[i] = 0.f;
                    }
                }
                rs += (acc[0] + acc[1]) + (acc[2] + acc[3]);
                u32x2 w; w.x = cvt_pk(acc[0], acc[1]); w.y = cvt_pk(acc[2], acc[3]);
                *(LAS u32x2*)(lds + L_P + (16 * lt + c) * RSP + (16 * st + 4 * g) * 2) = w;
            }
            if (!GLA) { rs += __shfl_xor(rs, 16); rs += __shfl_xor(rs, 32); if (g == 0) sc[SC_RS + sth * 64 + 16 * lt + c] = rs; }
#pragma unroll
            for (int kk = 0; kk < 4; ++kk) {
                u32x4 bw; bw.x = cvt_pk(Cst[2 * kk][0], Cst[2 * kk][1]); bw.y = cvt_pk(Cst[2 * kk][2], Cst[2 * kk][3]); bw.z = cvt_pk(Cst[2 * kk + 1][0], Cst[2 * kk + 1][1]); bw.w = cvt_pk(Cst[2 * kk + 1][2], Cst[2 * kk + 1][3]);
                const bf16x8 bfrag = __builtin_bit_cast(bf16x8, bw);
#pragma unroll
                for (int l4 = 0; l4 < 4; ++l4) { const bf16x8 af = *(const LAS bf16x8*)(lds + L_Q + (16 * l4 + c) * RS + (32 * kk + 8 * g) * 2); O[l4] = __builtin_amdgcn_mfma_f32_16x16x32_bf16(af, bfrag, O[l4], 0, 0, 0); }
            }
        }
        bf16x8 vf[2];
        {
            const int q = c >> 2, p = c & 3;
#pragma unroll
            for (int tt = 0; tt < 2; ++tt) { const LAS unsigned char* vp = lds + L_V + (32 * tt + 8 * g + q) * RS + (16 * wid + 4 * p) * 2; vf[tt] = cat4(tr16(vp), tr16(vp + 4 * RS)); }
            const bf16x8 ones = (bf16x8){0x3F80, 0x3F80, 0x3F80, 0x3F80, 0x3F80, 0x3F80, 0x3F80, 0x3F80};
#pragma unroll
            for (int j = 0; j < 8; ++j) {
#pragma unroll
                for (int tt = 0; tt < 2; ++tt) { const LAS unsigned char* kp = lds + L_K + (32 * tt + 8 * g + q) * RS + (32 * (j >> 1) + 8 * p + 4 * (j & 1)) * 2;
                    const bf16x8 kf = cat4(tr16(kp), tr16(kp + 4 * RS));
                    Cst[j] = __builtin_amdgcn_mfma_f32_16x16x32_bf16(kf, vf[tt], Cst[j], 0, 0, 0);
                    if (!GLA) { if (j == wid) nst = __builtin_amdgcn_mfma_f32_16x16x32_bf16(kf, ones, nst, 0, 0, 0); } }
            }
            if (!GLA) { if (c == 0) *(LAS f32x4*)(sc + SC_N + (par ^ 1) * 128 + 32 * (wid >> 1) + 8 * g + 4 * (wid & 1)) = nst; }
        }
        if (seg) {
            __syncthreads();
#pragma unroll
            for (int l4 = 0; l4 < 4; ++l4)
#pragma unroll
                for (int tt = 0; tt < 2; ++tt) { const bf16x8 af = *(const LAS bf16x8*)(lds + L_P + (16 * l4 + c) * RSP + (32 * tt + 8 * g) * 2); O[l4] = __builtin_amdgcn_mfma_f32_16x16x32_bf16(af, vf[tt], O[l4], 0, 0, 0); }
#pragma unroll
            for (int l4 = 0; l4 < 4; ++l4) {
                f32x4 o = O[l4];
                if (!GLA) { const int lb = 16 * l4 + 4 * g;
                    const f32x4 qn = *(const LAS f32x4*)(sc + SC_QN + lb), r0 = *(const LAS f32x4*)(sc + SC_RS + lb), r1 = *(const LAS f32x4*)(sc + SC_RS + 64 + lb), fl = *(const LAS f32x4*)(sc + SC_FL + lb);
#pragma unroll
                    for (int i = 0; i < 4; ++i) { const float den = fmaxf(fabsf(qn[i] + r0[i] + r1[i]), fl[i]); o[i] = o[i] * __builtin_amdgcn_rcpf(den); } }
#pragma unroll
                for (int i = 0; i < 4; ++i) { const int l = 16 * l4 + 4 * g + i; const int pp = ci * 64 + l; const int t = dir ? (T - 1 - pp) : pp;
                    hout[(size_t)(b * SEQ + t) * DM + ocol + 16 * wid + c] = f2bf(o[i]); }
            }
        }
    }
#undef SCAN_ROW
#undef SCAN_ISSUE
}
#undef LAS
}

#include <hip/hip_cooperative_groups.h>
namespace cg = cooperative_groups;
#define LAS __attribute__((address_space(3)))
constexpr int NBLK = 256, NTHR = 512;
constexpr int MISC_OFF = scan::LDS_BYTES > pg8::STAGE_BYTES ? scan::LDS_BYTES : pg8::STAGE_BYTES;
constexpr int MEGA_LDS = MISC_OFF + 64;
constexpr int CW_BAR = 4096;
constexpr size_t WS_MODP = WS_BIG;
struct Params { const float* in[28]; float* out; unsigned char* ws; };
typedef float f32x4v __attribute__((ext_vector_type(4)));
typedef unsigned u32x4v __attribute__((ext_vector_type(4)));

__device__ __forceinline__ void ph_prologue(const Params& p, LAS unsigned char* lds, int c) {
    const int tid = threadIdx.x;
    unsigned char* ws = p.ws;
    LAS float* t = (LAS float*)lds;
    for (int it = c; it < 10400; it += NBLK) {
        const float* W; bf16_t* Wt; int ldw, K, src, nn, dst, tl = it;
        if (tl < 4640) { W = p.in[6]; Wt = (bf16_t*)(ws + WS_WIN); ldw = NIN; K = DM;
            if (tl < 1536) { src = 0; nn = 3072; dst = 0; }
            else if ((tl -= 1536) < 16) { src = 4096; nn = 32; dst = 3072; }
            else if ((tl -= 16) < 16) { src = 7200; nn = 32; dst = 3104; }
            else if ((tl -= 16) < 256) { src = 4128; nn = 512; dst = 3328; }
            else if ((tl -= 256) < 256) { src = 4640; nn = 512; dst = 3840; }
            else if ((tl -= 256) < 512) { src = 5152; nn = 1024; dst = 4352; }
            else if ((tl -= 512) < 512) { src = 3072; nn = 1024; dst = 5376; }
            else if ((tl -= 512) < 512) { src = 6176; nn = 1024; dst = 6400; }
            else if ((tl -= 512) < 512) { src = 7232; nn = 1024; dst = 7424; }
            else { tl -= 512; src = 8256; nn = 1024; dst = 8448; } }
        else if ((tl -= 4640) < 512) { W = p.in[15]; Wt = (bf16_t*)(ws + WS_WBM); ldw = DM; K = DM; src = 0; nn = DM; dst = 0; }
        else if ((tl -= 512) < 512) { W = p.in[16]; Wt = (bf16_t*)(ws + WS_WBG); ldw = DM; K = DM; src = 0; nn = DM; dst = 0; }
        else if ((tl -= 512) < 512) { W = p.in[17]; Wt = (bf16_t*)(ws + WS_WOUT); ldw = DM; K = DM; src = 0; nn = DM; dst = 0; }
        else if ((tl -= 512) < 2816) { W = p.in[20]; Wt = (bf16_t*)(ws + WS_WUP); ldw = 2 * DFF; K = DM; src = 0; nn = 2 * DFF; dst = 0; }
        else { tl -= 2816; W = p.in[24]; Wt = (bf16_t*)(ws + WS_WDN); ldw = DM; K = DFF; src = 0; nn = DM; dst = 0; }
        const int ntn = nn >> 5, kb = tl / ntn, nb = tl - kb * ntn, k0 = kb * 64, n0 = nb * 32;
        { const int tx = tid & 31, ty = tid >> 5;
#pragma unroll
          for (int i = 0; i < 4; ++i) { const int k = ty + 16 * i; t[k * 33 + tx] = W[(size_t)(k0 + k) * ldw + src + n0 + tx]; } }
        __syncthreads();
        { const int kx = tid & 63, ny = tid >> 6;
#pragma unroll
          for (int i = 0; i < 4; ++i) { const int n = ny + 8 * i; Wt[(size_t)(dst + n0 + n) * K + k0 + kx] = f2bf(t[kx * 33 + n]); } }
        __syncthreads();
    }
    { u32x4v* z = (u32x4v*)((bf16_t*)(ws + WS_WIN) + (size_t)3136 * DM);
      for (int i = c * NTHR + tid; i < 24576; i += NBLK * NTHR) z[i] = (u32x4v){0u, 0u, 0u, 0u}; }
    { float* bp = (float*)(ws + WS_BIN); const float* b_in = p.in[7];
      for (int j = c * NTHR + tid; j < NINP; j += NBLK * NTHR) { int s;
        if (j < 3072) s = j; else if (j < 3104) s = 4096 + (j - 3072); else if (j < 3136) s = 7200 + (j - 3104); else if (j < 3328) s = -1;
        else if (j < 3840) s = 4128 + (j - 3328); else if (j < 4352) s = 4640 + (j - 3840); else if (j < 5376) s = 5152 + (j - 4352);
        else if (j < 6400) s = 3072 + (j - 5376); else if (j < 7424) s = 6176 + (j - 6400); else if (j < 8448) s = 7232 + (j - 7424); else s = 8256 + (j - 8448);
        bp[j] = s >= 0 ? b_in[s] : 0.f; } }
    for (int item = c; item < 192; item += NBLK) {
        const int cb = item % 12, ks = item / 12; LAS float* sl = (LAS float*)lds;
        for (int i = tid; i < 17 * 64; i += NTHR) { const int r = i >> 6, k = i & 63; const float cv = r < 16 ? p.in[1][r * DM + ks * 64 + k] : p.in[3][ks * 64 + k]; sl[i] = siluf_(cv); }
        __syncthreads();
        const int col = cb * 512 + tid; float acc[17];
#pragma unroll
        for (int r = 0; r < 17; ++r) acc[r] = 0.f;
        const float* wm = p.in[4] + (size_t)(ks * 64) * 6144 + col;
        for (int k = 0; k < 64; ++k) { const float w = wm[(size_t)k * 6144];
#pragma unroll
            for (int r = 0; r < 17; ++r) acc[r] += sl[r * 64 + k] * w; }
        float* mp = (float*)(ws + WS_MODP) + (size_t)ks * 17 * 6144 + col;
#pragma unroll
        for (int r = 0; r < 17; ++r) mp[(size_t)r * 6144] = acc[r];
        __syncthreads();
    }
}
__device__ __forceinline__ void ph_modulate(const Params& p, LAS unsigned char* lds, int c) {
    const int tid = threadIdx.x, lane = tid & 63, wid = tid >> 6;
    const float* modp = (const float*)(p.ws + WS_MODP); const float* b_mod = p.in[5];
    float* modv = (float*)(p.ws + WS_MOD);
    for (int e = tid; e < 408; e += NTHR) { const int idx = c * 408 + e, r = idx / 6144, j = idx - r * 6144; float s = b_mod[j];
#pragma unroll
        for (int ks = 0; ks < 16; ++ks) s += modp[((size_t)ks * 17 + r) * 6144 + j];
        modv[idx] = s; }
    LAS float* mv = (LAS float*)lds;
    bf16_t* U = (bf16_t*)(p.ws + WS_U) ;
    int curb = -1;
    for (int g = 0; g < 18; ++g) {
        const int r0 = c * 144 + 8 * g, b = r0 < ML ? r0 / SEQ : 16;
        if (b != curb) { __syncthreads();
            for (int j = tid; j < 2048; j += NTHR) { float s = b_mod[j];
#pragma unroll
                for (int ks = 0; ks < 16; ++ks) s += modp[((size_t)ks * 17 + b) * 6144 + j];
                mv[j] = s; }
            __syncthreads(); curb = b; }
        const int row = r0 + wid; const float* src = row < ML ? p.in[0] + (size_t)row * DM : p.in[2] + (size_t)(row - ML) * DM;
#pragma unroll
        for (int i = 0; i < 4; ++i) { const int d = i * 256 + lane * 4; const f32x4v v = *(const f32x4v*)(src + d), sh = *(const LAS f32x4v*)(mv + d), sc = *(const LAS f32x4v*)(mv + 1024 + d);
            ushort4 o; o.x = f2bf(v[0] * (1.f + sc[0]) + sh[0]); o.y = f2bf(v[1] * (1.f + sc[1]) + sh[1]); o.z = f2bf(v[2] * (1.f + sc[2]) + sh[2]); o.w = f2bf(v[3] * (1.f + sc[3]) + sh[3]);
            *(ushort4*)(U + (size_t)row * DM + d) = o; }
    }
}
__device__ __forceinline__ void ph_aprep(const Params& p, int c) {
    const int tid = threadIdx.x, lane = tid & 63, wid = tid >> 6;
    bf16_t* hm = (bf16_t*)p.out; bf16_t* hg = (bf16_t*)(p.ws + WS_BIG + BIG_HG); const bf16_t* side = (const bf16_t*)(p.ws + WS_BIG + BIG_SIDE);
    const float* gm = p.in[13]; const float* gg = p.in[14];
    for (int it = wid; it < 128 * 12; it += 8) {
        const int row = c * 128 + it / 12, u = it % 12;
        if (u < 8) {
            const int c0 = u * 128 + lane * 2; const size_t o = (size_t)row * DM + c0;
            const unsigned a = *(const unsigned*)(hm + o), b = *(const unsigned*)(hm + o + (size_t)ML * DM);
            float v0 = __uint_as_float(a << 16) + __uint_as_float(b << 16), v1 = __uint_as_float(a & 0xffff0000u) + __uint_as_float(b & 0xffff0000u);
            const float mean = wave_sum(v0 + v1) * (1.f / 128.f); v0 -= mean; v1 -= mean;
            const float rstd = rsqrtf(wave_sum(v0 * v0 + v1 * v1) * (1.f / 128.f) + EPS);
            const unsigned om = *(const unsigned*)(side + (size_t)row * 4096 + c0);
            const float o0 = __uint_as_float(om << 16), o1 = __uint_as_float(om & 0xffff0000u);
            *(unsigned*)(hm + o) = (unsigned)f2bf(v0 * rstd * gm[c0] * sigmoidf_(o0)) | ((unsigned)f2bf(v1 * rstd * gm[c0 + 1] * sigmoidf_(o1)) << 16);
        } else {
            const int hh = u - 8; const int c0 = hh * 256 + lane * 4; const size_t o = (size_t)row * DM + c0;
            const uint2 a = *(const uint2*)(hg + o), b = *(const uint2*)(hg + o + (size_t)ML * DM), zz = *(const uint2*)(side + (size_t)row * 4096 + 1024 + c0);
            float v[4] = {__uint_as_float(a.x << 16) + __uint_as_float(b.x << 16), __uint_as_float(a.x & 0xffff0000u) + __uint_as_float(b.x & 0xffff0000u),
                          __uint_as_float(a.y << 16) + __uint_as_float(b.y << 16), __uint_as_float(a.y & 0xffff0000u) + __uint_as_float(b.y & 0xffff0000u)};
            const float z[4] = {__uint_as_float(zz.x << 16), __uint_as_float(zz.x & 0xffff0000u), __uint_as_float(zz.y << 16), __uint_as_float(zz.y & 0xffff0000u)};
            const float rstd = rsqrtf(wave_sum(v[0] * v[0] + v[1] * v[1] + v[2] * v[2] + v[3] * v[3]) * (1.f / 256.f) + EPS);
            const f32x4v g4 = *(const f32x4v*)(gg + c0);
            uint2 w; w.x = (unsigned)f2bf(v[0] * rstd * g4[0] * siluf_(z[0])) | ((unsigned)f2bf(v[1] * rstd * g4[1] * siluf_(z[1])) << 16);
            w.y = (unsigned)f2bf(v[2] * rstd * g4[2] * siluf_(z[2])) | ((unsigned)f2bf(v[3] * rstd * g4[3] * siluf_(z[3])) << 16);
            *(uint2*)(hg + o) = w;
        }
    }
}
template <int MODE>
__device__ __forceinline__ void ph_ln(const Params& p, int c) {
    const int tid = threadIdx.x, lane = tid & 63, wid = tid >> 6;
    const float* g = MODE == 1 ? p.in[18] : p.in[26]; const float* bta = MODE == 1 ? p.in[19] : p.in[27];
    const float* mv = (const float*)(p.ws + WS_MOD) + (c * 128 / SEQ) * 6144; bf16_t* u2 = (bf16_t*)(p.ws + WS_U);
    for (int rr = wid; rr < 128; rr += 8) {
        const int row = c * 128 + rr; float* ptr = p.out + (size_t)row * DM;
        f32x4v v[4]; float s = 0.f;
#pragma unroll
        for (int j = 0; j < 4; ++j) { v[j] = *(const f32x4v*)(ptr + j * 256 + lane * 4); s += (v[j][0] + v[j][1]) + (v[j][2] + v[j][3]); }
        const float mean = wave_sum(s) * (1.f / DM); float q = 0.f;
#pragma unroll
        for (int j = 0; j < 4; ++j) { v[j] = v[j] - mean; q += (v[j][0] * v[j][0] + v[j][1] * v[j][1]) + (v[j][2] * v[j][2] + v[j][3] * v[j][3]); }
        const float rstd = rsqrtf(wave_sum(q) * (1.f / DM) + EPS);
#pragma unroll
        for (int j = 0; j < 4; ++j) { const int cc = j * 256 + lane * 4; const f32x4v o = v[j] * rstd * *(const f32x4v*)(g + cc) + *(const f32x4v*)(bta + cc);
            *(f32x4v*)(ptr + cc) = o;
            if (MODE == 1) { const f32x4v sh = *(const f32x4v*)(mv + 3072 + cc), sc = *(const f32x4v*)(mv + 4096 + cc); const f32x4v w = o * (sc + 1.f) + sh;
                ushort4 ww; ww.x = f2bf(w[0]); ww.y = f2bf(w[1]); ww.z = f2bf(w[2]); ww.w = f2bf(w[3]); *(ushort4*)(u2 + (size_t)row * DM + cc) = ww; } }
    }
}
__device__ __forceinline__ void ph_convglu(const Params& p, LAS unsigned char* lds, int c) {
    const int tid = threadIdx.x;
    const bf16_t* gate = (const bf16_t*)(p.ws + WS_BIG + BIG_GATE); bf16_t* val = (bf16_t*)(p.ws + WS_BIG + BIG_VAL);
    LAS float* cw = (LAS float*)lds;
    for (int i = tid; i < 9 * DFF; i += NTHR) cw[i] = p.in[22][i];
    for (int i = tid; i < DFF; i += NTHR) cw[9 * DFF + i] = p.in[23][i];
    __syncthreads();
    const int b = c >> 4, rimg0 = (c & 15) * 2;
    for (int i = tid; i < 128 * 352; i += NTHR) {
        const int rl = i / 352, cgp = i - rl * 352, ch = cgp * 8; const int r = rimg0 + (rl >> 6), col = rl & 63;
        float acc[8];
        { const f32x4v b0 = *(const LAS f32x4v*)(cw + 9 * DFF + ch), b1 = *(const LAS f32x4v*)(cw + 9 * DFF + ch + 4);
          acc[0] = b0[0]; acc[1] = b0[1]; acc[2] = b0[2]; acc[3] = b0[3]; acc[4] = b1[0]; acc[5] = b1[1]; acc[6] = b1[2]; acc[7] = b1[3]; }
#pragma unroll
        for (int di = 0; di < 3; ++di)
#pragma unroll
            for (int dj = 0; dj < 3; ++dj) { const int rr = r + di - 1, cc = col + dj - 1;
                if (rr >= 0 && rr < SEQ / GW && cc >= 0 && cc < GW) {
                    const u32x4v gv = *(const u32x4v*)(gate + ((size_t)b * SEQ + rr * GW + cc) * DFF + ch);
                    const f32x4v w0 = *(const LAS f32x4v*)(cw + (di * 3 + dj) * DFF + ch), w1 = *(const LAS f32x4v*)(cw + (di * 3 + dj) * DFF + ch + 4);
                    acc[0] += __uint_as_float(gv.x << 16) * w0[0]; acc[1] += __uint_as_float(gv.x & 0xffff0000u) * w0[1]; acc[2] += __uint_as_float(gv.y << 16) * w0[2]; acc[3] += __uint_as_float(gv.y & 0xffff0000u) * w0[3];
                    acc[4] += __uint_as_float(gv.z << 16) * w1[0]; acc[5] += __uint_as_float(gv.z & 0xffff0000u) * w1[1]; acc[6] += __uint_as_float(gv.w << 16) * w1[2]; acc[7] += __uint_as_float(gv.w & 0xffff0000u) * w1[3]; } }
        bf16_t* vp = val + ((size_t)c * 128 + rl) * DFF + ch; const u32x4v vv = *(const u32x4v*)vp;
        const float vf[8] = {__uint_as_float(vv.x << 16), __uint_as_float(vv.x & 0xffff0000u), __uint_as_float(vv.y << 16), __uint_as_float(vv.y & 0xffff0000u),
                             __uint_as_float(vv.z << 16), __uint_as_float(vv.z & 0xffff0000u), __uint_as_float(vv.w << 16), __uint_as_float(vv.w & 0xffff0000u)};
        u32x4v o; o.x = (unsigned)f2bf(gelu_tanh(acc[0]) * vf[0]) | ((unsigned)f2bf(gelu_tanh(acc[1]) * vf[1]) << 16); o.y = (unsigned)f2bf(gelu_tanh(acc[2]) * vf[2]) | ((unsigned)f2bf(gelu_tanh(acc[3]) * vf[3]) << 16);
        o.z = (unsigned)f2bf(gelu_tanh(acc[4]) * vf[4]) | ((unsigned)f2bf(gelu_tanh(acc[5]) * vf[5]) << 16); o.w = (unsigned)f2bf(gelu_tanh(acc[6]) * vf[6]) | ((unsigned)f2bf(gelu_tanh(acc[7]) * vf[7]) << 16);
        *(u32x4v*)vp = o;
    }
}


#define GAS __attribute__((address_space(1)))
typedef GAS unsigned gu32;
#define RLX_AGENT __ATOMIC_RELAXED, __HIP_MEMORY_SCOPE_AGENT
#define XB_TMO      128
#define XB_XCNT(j)  (256  + 64 * (j))
#define XB_XSUB(j)  (1280 + 64 * (j))
#define XB_XGEN(j)  (2304 + 64 * (j))
#define XB_TOP      3328
#define XB_TOPGEN   3392
#define XCD_BAR_WORDS 3456
#define XB_SPIN_CAP (1u << 18)

__device__ __forceinline__ unsigned xb_ld(unsigned* p)              { return __hip_atomic_load(p, __ATOMIC_RELAXED, __HIP_MEMORY_SCOPE_AGENT); }
__device__ __forceinline__ unsigned xb_add(unsigned* p, unsigned v) { return __hip_atomic_fetch_add(p, v, __ATOMIC_RELAXED, __HIP_MEMORY_SCOPE_AGENT); }
__device__ __forceinline__ unsigned xb_xcc_id() { return (unsigned)__builtin_amdgcn_s_getreg((3 << 11) | 20) & 0xFu; }
#define XB_SPIN(cond, bar) do { unsigned _sp = 0; while (cond) { __builtin_amdgcn_s_sleep(1); \
    if ((++_sp & 255u) == 0u) { if (xb_ld(&(bar)[XB_TMO])) break; if (_sp > XB_SPIN_CAP) { atomicAdd(&(bar)[XB_TMO], 1u); break; } } } } while (0)

struct XcdBarrier {
    unsigned* bar; unsigned x;
    volatile LAS unsigned* st;
};

__device__ __forceinline__ XcdBarrier xcd_barrier_post(unsigned* bar, volatile LAS unsigned* st) {
    XcdBarrier b; b.bar = bar; b.x = xb_xcc_id(); b.st = st;
    if (threadIdx.x == 0) (void)xb_add(&bar[XB_XCNT(b.x)], 1u);
    return b;
}
__device__ __forceinline__ void xcd_barrier_complete(unsigned* bar, unsigned x, unsigned& nloc, unsigned& nx) {
    const unsigned G = gridDim.x * gridDim.y * gridDim.z;
    unsigned sum, cnt, mine, sp = 0u;
    for (;;) {
        sum = 0u; cnt = 0u; mine = 0u;
#pragma unroll
        for (unsigned j = 0; j < 16; ++j) { const unsigned c = xb_ld(&bar[XB_XCNT(j)]); sum += c; cnt += (c > 0u) ? 1u : 0u; mine = (j == x) ? c : mine; }
        if (sum == G) break;
        __builtin_amdgcn_s_sleep(1);
        if ((++sp & 255u) == 0u) { if (xb_ld(&bar[XB_TMO])) break; if (sp > XB_SPIN_CAP) { atomicAdd(&bar[XB_TMO], 1u); break; } }
    }
    nloc = mine > 0u ? mine : 1u; nx = cnt > 0u ? cnt : 1u;
}

__device__ __forceinline__ void xcd_barrier(const XcdBarrier& b) {
    asm volatile("s_waitcnt vmcnt(0)" ::: "memory");
    __syncthreads();
    if (threadIdx.x == 0) {
        unsigned* bar = b.bar;
        __builtin_amdgcn_s_waitcnt(0);
        unsigned nloc = b.st[0], nx = b.st[1];
        if (nloc == 0u) { xcd_barrier_complete(bar, b.x, nloc, nx); b.st[0] = nloc; b.st[1] = nx; }
        const unsigned old = xb_add(&bar[XB_XSUB(b.x)], 1u);
        const unsigned gen = old / nloc;
        if (old + 1u == (gen + 1u) * nloc) {
            __builtin_amdgcn_fence(__ATOMIC_RELEASE, "agent");
            asm volatile("s_waitcnt vmcnt(0)" ::: "memory");
            const unsigned og = xb_add(&bar[XB_TOP], 1u);
            const unsigned tg = og / nx;
            if (og + 1u == (tg + 1u) * nx) xb_add(&bar[XB_TOPGEN], 1u);
            else XB_SPIN(xb_ld(&bar[XB_TOPGEN]) == tg, bar);
            __builtin_amdgcn_fence(__ATOMIC_ACQUIRE, "agent");
            xb_add(&bar[XB_XGEN(b.x)], 1u);
            asm volatile("s_waitcnt vmcnt(0)" ::: "memory");
        } else {
            XB_SPIN(xb_ld(&bar[XB_XGEN(b.x)]) == gen, bar);
            __builtin_amdgcn_fence(__ATOMIC_ACQUIRE, "agent");
            asm volatile("s_waitcnt vmcnt(0)" ::: "memory");
        }
    }
    __syncthreads();
}


__global__ void __launch_bounds__(NTHR, 2) mega_fwd(Params p) {
    extern __shared__ __attribute__((aligned(16))) unsigned char lds_dyn[];
    LAS unsigned char* lds = (LAS unsigned char*)lds_dyn;
    cg::grid_group grid = cg::this_grid();
    const int c = blockIdx.x;
    unsigned char* ws = p.ws; unsigned char* big = ws + WS_BIG;
    float* modv = (float*)(ws + WS_MOD); float* binp = (float*)(ws + WS_BIN);
    bf16_t* Wt_in = (bf16_t*)(ws + WS_WIN); bf16_t* U = (bf16_t*)(ws + WS_U);
    bf16_t* Pm = (bf16_t*)(big + BIG_PM); bf16_t* Pg = (bf16_t*)(big + BIG_PG); float* small = (float*)(big + BIG_SMALL);
    bf16_t* hm = (bf16_t*)p.out; bf16_t* hg = (bf16_t*)(big + BIG_HG); bf16_t* side = (bf16_t*)(big + BIG_SIDE);
    bf16_t* gate = (bf16_t*)(big + BIG_GATE); bf16_t* val = (bf16_t*)(big + BIG_VAL);
    if (threadIdx.x < 16) ((LAS unsigned*)(lds + MISC_OFF))[threadIdx.x] = 0u;
    __syncthreads();
#define GRID_SYNC() xcd_barrier(bar)
    if (c == 0) for (int i = threadIdx.x; i < XCD_BAR_WORDS; i += NTHR) __hip_atomic_store((unsigned*)(ws + WS_CTL) + CW_BAR + i, 0u, __ATOMIC_RELAXED, __HIP_MEMORY_SCOPE_AGENT);
    ph_prologue(p, lds, c);
    grid.sync();
    XcdBarrier bar = xcd_barrier_post((unsigned*)(ws + WS_CTL) + CW_BAR, (volatile LAS unsigned*)(lds + MISC_OFF));
    ph_modulate(p, lds, c);
    GRID_SYNC();
    { pg8::SchedPlain S{U, Wt_in, MT / 256, N_AB / 256, DM, NBLK, c, 0}; pg8::FEpiAB E{Pm, Pg, small, binp}; pg8::gemm_phase(lds, DM, S, E); }
    GRID_SYNC();
    { scan::Args a{Pm, 3072, 0, small, p.in[8], p.in[9], p.in[10], p.in[11], p.in[12], hm}; scan::scan_item<false>(lds, a, c); }
    GRID_SYNC();
    { scan::Args a{Pg, 2048, 0, small, p.in[8], p.in[9], p.in[10], p.in[11], p.in[12], hg}; scan::scan_item<true>(lds, a, c); }
    GRID_SYNC();
    { pg8::SchedPlain S{U, Wt_in + (size_t)PC_SIDE * DM, ML / 256, N_SIDE / 256, DM, NBLK, c, 0}; pg8::FEpiBias E{side, binp + PC_SIDE, 4096, 0}; pg8::gemm_phase(lds, DM, S, E); }
    GRID_SYNC();
    ph_aprep(p, c);
    GRID_SYNC();
    { pg8::SchedDual S{hm, (const bf16_t*)(ws + WS_WBM), hg, (const bf16_t*)(ws + WS_WBG), ML / 256, DM / 256, DM, NBLK, c, 0}; pg8::FEpiMerge E{U, side}; pg8::gemm_phase(lds, DM, S, E); }
    GRID_SYNC();
    { pg8::SchedPlain S{U, (const bf16_t*)(ws + WS_WOUT), ML / 256, DM / 256, DM, NBLK, c, 0}; pg8::FEpiOut E{p.in[0], modv, p.out}; pg8::gemm_phase(lds, DM, S, E); }
    GRID_SYNC();
    ph_ln<1>(p, c);
    GRID_SYNC();
    { pg8::SchedPlain S{U, (const bf16_t*)(ws + WS_WUP), ML / 256, 2 * DFF / 256, DM, NBLK, c, 0}; pg8::FEpiUp E{gate, val, p.in[21]}; pg8::gemm_phase(lds, DM, S, E); }
    GRID_SYNC();
    ph_convglu(p, lds, c);
    GRID_SYNC();
    { pg8::SchedPlain S{val, (const bf16_t*)(ws + WS_WDN), ML / 256, DM / 256, DFF, NBLK, c, 0}; pg8::FEpiDown E{p.out, modv, p.in[25]}; pg8::gemm_phase(lds, DFF, S, E); }
    GRID_SYNC();
    ph_ln<2>(p, c);
}

extern "C" void kernel_launch(void* const* d_in, const int* in_sizes, int n_in, void* d_out, int out_size, void* d_ws, size_t ws_size, hipStream_t stream) {
    if (n_in != 28 || out_size != ML * DM || ws_size < WS_END) { fprintf(stderr, "kernel_launch: unexpected shapes n_in %d out %d ws %zu\n", n_in, out_size, ws_size); return; }
    static bool attr_set = false;
    if (!attr_set) { (void)hipFuncSetAttribute((const void*)mega_fwd, hipFuncAttributeMaxDynamicSharedMemorySize, MEGA_LDS); attr_set = true; }
    (void)hipMemsetAsync((char*)d_ws + WS_CTL, 0, 64 * 1024, stream);
    Params p{};
    for (int i = 0; i < 28; ++i) p.in[i] = (const float*)d_in[i];
    p.out = (float*)d_out; p.ws = (unsigned char*)d_ws;
    void* args[] = {&p};
    hipError_t e = hipLaunchCooperativeKernel((const void*)mega_fwd, dim3(NBLK), dim3(NTHR), args, MEGA_LDS, stream);
    if (e != hipSuccess) fprintf(stderr, "cooperative launch failed: %s\n", hipGetErrorString(e));
}
```

```cpp
#include <hip/hip_runtime.h>
#include <cstdio>
#include <cstdint>

typedef unsigned short bf16_t;

constexpr int DM = 1024, NB = 16, SEQ = 2048, CTX = 256, GW = 64;
constexpr int ML = NB * SEQ;
constexpr int MC = NB * CTX;
constexpr int MT = ML + MC;
constexpr int NIN = 9280, NINP = 9472;
constexpr int DFF = 2816;
constexpr float ALPHA = 1.189207115002721f;
constexpr float EPS = 1e-5f;
constexpr int PC_QM = 0, PC_KM = 1024, PC_VM = 2048, PC_SMALL = 3072, PC_QG = 3328, PC_KG = 3840, PC_VG = 4352, PC_SIDE = 5376;
constexpr int N_AB = 5376;
constexpr int N_SIDE = 4096;

constexpr size_t MiB = 1u << 20;
constexpr size_t WS_CTL = 0;
constexpr size_t WS_MOD = 1 * MiB;
constexpr size_t WS_BIN = WS_MOD + 512 * 1024;
constexpr size_t WS_WIN = 4 * MiB;
constexpr size_t WS_WBM = WS_WIN + (size_t)NINP * DM * 2;
constexpr size_t WS_WBG = WS_WBM + 2 * MiB;
constexpr size_t WS_WOUT = WS_WBG + 2 * MiB;
constexpr size_t WS_WUP = WS_WOUT + 2 * MiB;
constexpr size_t WS_WDN = WS_WUP + 11 * MiB;
constexpr size_t WS_U = 46 * MiB;
constexpr size_t WS_BIG = 118 * MiB;
constexpr size_t WS_END = 509 * MiB;
static_assert(WS_WDN + (size_t)DM * DFF * 2 <= WS_U, "weights fit");
constexpr size_t BIG_PM = 0;
constexpr size_t BIG_PG = 216 * MiB;
constexpr size_t BIG_SMALL = 360 * MiB;
constexpr size_t BIG_HG = 0;
constexpr size_t BIG_SIDE = 128 * MiB;
constexpr size_t BIG_GATE = 0;
constexpr size_t BIG_VAL = 176 * MiB;

__device__ __forceinline__ float bf2f(bf16_t v) { return __uint_as_float(((unsigned)v) << 16); }
__device__ __forceinline__ bf16_t f2bf(float f) { unsigned u = __float_as_uint(f); return (bf16_t)((u + 0x7fffu + ((u >> 16) & 1u)) >> 16); }
__device__ __forceinline__ float sigmoidf_(float x) { return __builtin_amdgcn_rcpf(1.f + __expf(-x)); }
__device__ __forceinline__ float siluf_(float x) { return x * sigmoidf_(x); }
__device__ __forceinline__ float logsigmoidf_(float x) { return fminf(x, 0.f) - __logf(1.f + __expf(-fabsf(x))); }
__device__ __forceinline__ float gelu_tanh(float x) { const float a = x * __builtin_fmaf(x * x, -0.10294324f, -2.3022082f); return x * __builtin_amdgcn_rcpf(1.f + __builtin_amdgcn_exp2f(a)); }
__device__ __forceinline__ float wave_sum(float v) {
#pragma unroll
    for (int o = 1; o < 64; o <<= 1) v += __shfl_xor(v, o);
    return v;
}

namespace pg8 {
#define PG8_LAS __attribute__((address_space(3)))
typedef short bf16x8 __attribute__((ext_vector_type(8)));
typedef float f32x4 __attribute__((ext_vector_type(4)));
typedef unsigned u32x4 __attribute__((ext_vector_type(4)));
constexpr int BM = 256, BK = 64, HALF = 128, HTB = HALF * BK * 2, STAGE_BYTES = 8 * HTB, NXCD = 8, WGM = 4;
__host__ __device__ __forceinline__ int lds_byte(int r, int c) { const int st = (r >> 4) * 2 + (c >> 5), rr = r & 15, cc = c & 31, ob = rr * 64 + cc * 2; return st * 1024 + (ob ^ (((ob >> 9) & 1) << 5)); }
__host__ __device__ __forceinline__ void stage_rc(int b, int& R, int& C) { const int st = b / 1024, sb = b % 1024, swz = sb ^ (((sb >> 9) & 1) << 5); R = (st >> 1) * 16 + swz / 64; C = (st & 1) * 32 + (swz % 64) / 2; }
__host__ __device__ __forceinline__ int perm32(int rho) { const int n = rho >> 4, i = rho & 15; return 8 * (i >> 2) + 4 * n + (i & 3); }
struct Unit { int pm, pn, tag; const bf16_t* A; const bf16_t* B; };
__host__ __device__ __forceinline__ bool tile_local(int L, int nPl, int nN, int& lp, int& pn) {
    if (L >= nPl * nN) return false;
    const int nig = WGM * nN, gid = L / nig, fm = gid * WGM, gsz = (nPl - fm) < WGM ? (nPl - fm) : WGM, rem = L - gid * nig;
    lp = fm + rem % gsz; pn = rem / gsz; return true;
}
struct SchedPlain {
    const bf16_t* A; const bf16_t* Bt; int nPl, nN, K, x, r, pad;
    __device__ __forceinline__ bool next(int i, Unit& u) const { int lp; if (!tile_local(i * 32 + r, nPl, nN, lp, u.pn)) return false; u.pm = lp < 16 ? 16 * x + lp : 128 + 2 * x + (lp - 16); u.tag = 1;
        u.A = A + (size_t)u.pm * BM * K; u.B = Bt + (size_t)u.pn * BM * K; return true; }
};
struct SchedAB {
    const bf16_t* A; const bf16_t* Bt; int K, x, r, pad;
    __device__ __forceinline__ bool next(int i, Unit& u) const { const int L = i * 32 + r; int lp, pn;
        if (L < 320) { (void)tile_local(L, 16, 20, lp, pn); }
        else if (L < 348) { const int q = L - 320, cp = q / 14, idx = q - cp * 14; lp = 16 + cp; pn = idx < 8 ? 4 + idx : 6 + idx; }
        else return false;
        u.pn = pn; u.pm = lp < 16 ? 16 * x + lp : 128 + 2 * x + (lp - 16); u.tag = 1;
        u.A = A + (size_t)u.pm * BM * K; u.B = Bt + (size_t)(pn < 12 ? pn : pn + 1) * BM * K; return true; }
};
struct SchedDual {
    const bf16_t* A0; const bf16_t* B0; const bf16_t* A1; const bf16_t* B1; int nPl, nN, K, x, r, pad;
    __device__ __forceinline__ bool next(int i, Unit& u) const { int lp; if (!tile_local((i >> 1) * 32 + r, nPl, nN, lp, u.pn)) return false; u.pm = 16 * x + lp; u.tag = i & 1;
        u.A = ((i & 1) ? A1 : A0) + (size_t)u.pm * BM * K; u.B = ((i & 1) ? B1 : B0) + (size_t)u.pn * BM * K; return true; }
};
__device__ __forceinline__ unsigned cvt_pk_bf16(float lo, float hi) { unsigned r; asm volatile("v_cvt_pk_bf16_f32 %0, %1, %2" : "=v"(r) : "v"(lo), "v"(hi)); return r; }
__device__ __forceinline__ u32x4 pack8(f32x4 v0, f32x4 v1) { u32x4 w; w.x = cvt_pk_bf16(v0[0], v0[1]); w.y = cvt_pk_bf16(v0[2], v0[3]); w.z = cvt_pk_bf16(v1[0], v1[1]); w.w = cvt_pk_bf16(v1[2], v1[3]); return w; }
__device__ __forceinline__ void unpack8(u32x4 w, f32x4& v0, f32x4& v1) {
    v0[0] = __uint_as_float(w.x << 16); v0[1] = __uint_as_float(w.x & 0xffff0000u); v0[2] = __uint_as_float(w.y << 16); v0[3] = __uint_as_float(w.y & 0xffff0000u);
    v1[0] = __uint_as_float(w.z << 16); v1[1] = __uint_as_float(w.z & 0xffff0000u); v1[2] = __uint_as_float(w.w << 16); v1[3] = __uint_as_float(w.w & 0xffff0000u); }

template <class Epi, class Sched>
__device__ __forceinline__ void gemm_phase(PG8_LAS unsigned char* lds, const int K, const Sched& S, const Epi& E) {
    int tid_ = threadIdx.x; asm volatile("" : "+v"(tid_));
    const int tid = tid_, wid = __builtin_amdgcn_readfirstlane(tid >> 6), lane = tid & 63, wr = wid >> 2, wc = wid & 3, fr = lane & 15, fq = lane >> 4;
    const int nt = K / BK;
    unsigned voffA[2], voffB[2];
#pragma unroll
    for (int i = 0; i < 2; ++i) { int R, C; stage_rc(tid * 16 + i * 8192, R, C); const int Rb = (R & ~31) + perm32(R & 31);
        voffA[i] = (unsigned)(R * K + C) * 2u; voffB[i] = (unsigned)(Rb * K + C) * 2u; }
    const size_t kstep = (size_t)(BK * 2);
    const size_t hstep = (size_t)HALF * K * 2;
    const unsigned ldsw = (unsigned)wid * 1024u;
    const int aoff = lds_byte(wr * 64 + fr, fq * 8), boff = lds_byte(wc * 32 + fr, fq * 8);
#define PG8_SA(b, h) (((b) * 2 + (h)) * HTB)
#define PG8_SB(b, h) ((4 + (b) * 2 + (h)) * HTB)
#define PG8_STAGE(bufoff, gbase, voff) do { _Pragma("unroll") for (int _i = 0; _i < 2; ++_i) \
        __builtin_amdgcn_global_load_lds((const unsigned*)((const char*)(gbase) + (voff)[_i]), (PG8_LAS unsigned*)(lds + (bufoff) + ldsw + _i * 8192), 16, 0, 0); } while (0)
#define PG8_LDA(dst, b, h) do { _Pragma("unroll") for (int m = 0; m < 4; ++m) _Pragma("unroll") for (int k = 0; k < 2; ++k) dst[m][k] = *(const PG8_LAS bf16x8*)(lds + PG8_SA(b, h) + aoff + m * 2048 + k * 1024); } while (0)
#define PG8_LDB(dst, b, h) do { _Pragma("unroll") for (int n = 0; n < 2; ++n) _Pragma("unroll") for (int k = 0; k < 2; ++k) dst[n][k] = *(const PG8_LAS bf16x8*)(lds + PG8_SB(b, h) + boff + n * 2048 + k * 1024); } while (0)
#define PG8_MMA(ai, bj, At, Bt) do { __builtin_amdgcn_s_setprio(1); _Pragma("unroll") for (int m = 0; m < 4; ++m) _Pragma("unroll") for (int n = 0; n < 2; ++n) _Pragma("unroll") for (int k = 0; k < 2; ++k) \
        acc[ai][bj][m][n] = __builtin_amdgcn_mfma_f32_16x16x32_bf16(Bt[n][k], At[m][k], acc[ai][bj][m][n], 0, 0, 0); __builtin_amdgcn_s_setprio(0); } while (0)
#define PG8_WAIT_V_(n) asm volatile("s_waitcnt vmcnt(" #n ")" ::: "memory")
#define PG8_WAIT_V(n) PG8_WAIT_V_(n)
#define PG8_WAIT_L(n) asm volatile("s_waitcnt lgkmcnt(" #n ")" ::: "memory")
#define PG8_BAR __builtin_amdgcn_s_barrier()
#define PG8_SCHED __builtin_amdgcn_sched_barrier(0)
    Unit cur, nxt; int ui = 0;
    if (!S.next(0, cur)) return;
    f32x4 acc[2][2][4][2];
#pragma unroll
    for (int a = 0; a < 2; ++a)
#pragma unroll
        for (int b = 0; b < 2; ++b)
#pragma unroll
            for (int m = 0; m < 4; ++m)
#pragma unroll
                for (int n = 0; n < 2; ++n) acc[a][b][m][n] = (f32x4){0.f, 0.f, 0.f, 0.f};
    bf16x8 At[4][2], B0[2][2], B1[2][2];
    const char* cA = (const char*)cur.A; const char* cB = (const char*)cur.B;
    PG8_STAGE(PG8_SB(0, 0), cB, voffB); PG8_STAGE(PG8_SB(0, 1), cB + hstep, voffB); PG8_STAGE(PG8_SA(0, 0), cA, voffA); PG8_STAGE(PG8_SA(0, 1), cA + hstep, voffA);
    if (wr == 1) PG8_BAR;
    PG8_WAIT_V(2); PG8_BAR;
    PG8_STAGE(PG8_SB(1, 0), cB + kstep, voffB); PG8_STAGE(PG8_SA(1, 0), cA + kstep, voffA); PG8_STAGE(PG8_SB(1, 1), cB + hstep + kstep, voffB);
    PG8_WAIT_V(6); PG8_BAR;
    for (;;) {
        const bool has_next = S.next(ui + 1, nxt);
        const char* nA = has_next ? (const char*)nxt.A : cA; const char* nB = has_next ? (const char*)nxt.B : cB;
#define PG8_ITER(T_, W1, W2) do { const int t_ = (T_); const bool last = (t_ == nt - 2); \
            const char* a1 = cA + (size_t)(t_ + 1) * kstep; \
            const char* a2 = last ? nA : cA + (size_t)(t_ + 2) * kstep; const char* b2 = last ? nB : cB + (size_t)(t_ + 2) * kstep; \
            const char* a3 = a2 + kstep; const char* b3 = b2 + kstep; \
            PG8_LDB(B0, 0, 0); PG8_LDB(B1, 0, 1); PG8_SCHED; PG8_LDA(At, 0, 0); PG8_STAGE(PG8_SA(1, 1), a1 + hstep, voffA); \
            PG8_WAIT_V(W1); PG8_WAIT_L(0); PG8_BAR; PG8_MMA(0, 0, At, B0); PG8_MMA(0, 1, At, B1); PG8_BAR; PG8_SCHED; \
            PG8_LDA(At, 0, 1); PG8_STAGE(PG8_SB(0, 0), b2, voffB); PG8_STAGE(PG8_SB(0, 1), b2 + hstep, voffB); PG8_STAGE(PG8_SA(0, 0), a2, voffA); \
            PG8_WAIT_V(W2); PG8_WAIT_L(0); PG8_BAR; PG8_MMA(1, 0, At, B0); PG8_MMA(1, 1, At, B1); PG8_BAR; PG8_SCHED; \
            PG8_LDB(B0, 1, 0); PG8_LDB(B1, 1, 1); PG8_SCHED; PG8_LDA(At, 1, 0); PG8_STAGE(PG8_SA(0, 1), a2 + hstep, voffA); \
            PG8_WAIT_V(8); PG8_WAIT_L(0); PG8_BAR; PG8_MMA(0, 0, At, B0); PG8_MMA(0, 1, At, B1); PG8_BAR; PG8_SCHED; \
            PG8_LDA(At, 1, 1); PG8_STAGE(PG8_SB(1, 0), b3, voffB); PG8_STAGE(PG8_SB(1, 1), b3 + hstep, voffB); PG8_STAGE(PG8_SA(1, 0), a3, voffA); \
            PG8_WAIT_V(8); PG8_WAIT_L(0); PG8_BAR; PG8_MMA(1, 0, At, B0); PG8_MMA(1, 1, At, B1); PG8_BAR; PG8_SCHED; } while (0)
        int t0 = 0;
        if (Epi::NST == 16 && ui > 0) { PG8_ITER(0, 24, 24); t0 = 2; }
        for (int t = t0; t < nt; t += 2) PG8_ITER(t, 8, 8);
#undef PG8_ITER
        if (wr == 0) PG8_BAR;
        const bool keep = E(acc, cur, wr, wc, fr, fq);
        if (!has_next) break;
        if (!keep) {
#pragma unroll
            for (int a = 0; a < 2; ++a)
#pragma unroll
                for (int b = 0; b < 2; ++b)
#pragma unroll
                    for (int m = 0; m < 4; ++m)
#pragma unroll
                        for (int n = 0; n < 2; ++n) acc[a][b][m][n] = (f32x4){0.f, 0.f, 0.f, 0.f};
        }
        cur = nxt; cA = nA; cB = nB; ++ui;
        if (wr == 1) PG8_BAR;
    }
    PG8_WAIT_V(0);
    PG8_BAR;
#undef PG8_SA
#undef PG8_SB
#undef PG8_STAGE
#undef PG8_LDA
#undef PG8_LDB
#undef PG8_MMA
#undef PG8_WAIT_V
#undef PG8_WAIT_V_
#undef PG8_WAIT_L
#undef PG8_BAR
#undef PG8_SCHED
}

#define PG8_FRAG_LOOP for (int ai = 0; ai < 2; ++ai) _Pragma("unroll") for (int m = 0; m < 4; ++m) _Pragma("unroll") for (int bj = 0; bj < 2; ++bj)
struct FEpiAB { static constexpr int NST = 16; bf16_t* Pm; bf16_t* Pg; const float* bias;
    __device__ __forceinline__ bool operator()(const f32x4 (&acc)[2][2][4][2], const Unit& u, int wr, int wc, int fr, int fq) const {
        asm volatile("" : "+v"(fr), "+v"(fq)); const int row0 = u.pm * BM + wr * 64 + fr, ct = u.pn, cin = wc * 32 + 8 * fq, bt = ct < 12 ? ct : ct + 1;
        f32x4 bv[2][2];
#pragma unroll
        for (int bj = 0; bj < 2; ++bj)
#pragma unroll
            for (int n = 0; n < 2; ++n) bv[bj][n] = *(const f32x4*)(bias + bt * BM + cin + bj * HALF + 4 * n);
        bf16_t* base; int ld;
        if (ct < 12) { base = Pm + ct * BM; ld = 3072; } else { base = Pg + (ct - 12) * BM; ld = 2048; }
#pragma unroll
        PG8_FRAG_LOOP { *(u32x4*)(base + (size_t)(row0 + ai * HALF + m * 16) * ld + cin + bj * HALF) = pack8(acc[ai][bj][m][0] + bv[bj][0], acc[ai][bj][m][1] + bv[bj][1]); }
        return false;
    }
};
struct FEpiBias { static constexpr int NST = 16; bf16_t* O; const float* bias; int ld, pad;
    __device__ __forceinline__ bool operator()(const f32x4 (&acc)[2][2][4][2], const Unit& u, int wr, int wc, int fr, int fq) const {
        const int row0 = u.pm * BM + wr * 64 + fr, col0 = u.pn * BM + wc * 32 + 8 * fq;
        f32x4 bv[2][2];
#pragma unroll
        for (int bj = 0; bj < 2; ++bj)
#pragma unroll
            for (int n = 0; n < 2; ++n) bv[bj][n] = *(const f32x4*)(bias + col0 + bj * HALF + 4 * n);
#pragma unroll
        PG8_FRAG_LOOP { *(u32x4*)(O + (size_t)(row0 + ai * HALF + m * 16) * ld + col0 + bj * HALF) = pack8(acc[ai][bj][m][0] + bv[bj][0], acc[ai][bj][m][1] + bv[bj][1]); }
        return false;
    }
};
struct FEpiUp { static constexpr int NST = 0;      bf16_t* gate; bf16_t* val; const float* bias;
    __device__ __forceinline__ bool operator()(const f32x4 (&acc)[2][2][4][2], const Unit& u, int wr, int wc, int fr, int fq) const {
        asm volatile("" : "+v"(fr), "+v"(fq));
        const int row0 = u.pm * BM + wr * 64 + fr, cin = wc * 32 + 8 * fq;
        const unsigned tb = u.pn < 11 ? (unsigned)(u.pn * BM) * 2u : (unsigned)(176u << 20) + (unsigned)((u.pn - 11) * BM) * 2u;
        const unsigned ob = tb + (unsigned)(row0 * DFF + cin) * 2u; char* gb = (char*)gate;
        f32x4 bv[2][2];
#pragma unroll
        for (int bj = 0; bj < 2; ++bj)
#pragma unroll
            for (int n = 0; n < 2; ++n) bv[bj][n] = *(const f32x4*)(bias + u.pn * BM + cin + bj * HALF + 4 * n);
#pragma unroll
        PG8_FRAG_LOOP { *(u32x4*)(gb + (ob + (unsigned)(((ai * HALF + m * 16) * DFF + bj * HALF) * 2))) = pack8(acc[ai][bj][m][0] + bv[bj][0], acc[ai][bj][m][1] + bv[bj][1]); }
        return false;
    }
};
__device__ __forceinline__ float fsig(float x) { return __builtin_amdgcn_rcpf(1.f + __expf(-x)); }
struct FEpiMerge { static constexpr int NST = 0; bf16_t* Z; const bf16_t* side;
    __device__ __forceinline__ bool operator()(f32x4 (&acc)[2][2][4][2], const Unit& u, int wr, int wc, int fr, int fq) const {
        const int row0 = u.pm * BM + wr * 64 + fr, col0 = u.pn * BM + wc * 32 + 8 * fq;
        if (u.tag == 0) {
#pragma unroll
            PG8_FRAG_LOOP { const bf16_t* sp = side + (size_t)(row0 + ai * HALF + m * 16) * 4096 + col0 + bj * HALF;
                f32x4 a0, a1, b0, b1; unpack8(*(const u32x4*)(sp + 2048), a0, a1); unpack8(*(const u32x4*)(sp + 3072), b0, b1);
#pragma unroll
                for (int j = 0; j < 4; ++j) { acc[ai][bj][m][0][j] *= (1.f + __expf(-b0[j])) * fsig(a0[j]); acc[ai][bj][m][1][j] *= (1.f + __expf(-b1[j])) * fsig(a1[j]); } }
            return true;
        }
#pragma unroll
        PG8_FRAG_LOOP { const bf16_t* sp = side + (size_t)(row0 + ai * HALF + m * 16) * 4096 + col0 + bj * HALF;
            f32x4 b0, b1; unpack8(*(const u32x4*)(sp + 3072), b0, b1); f32x4 v0 = acc[ai][bj][m][0], v1 = acc[ai][bj][m][1];
#pragma unroll
            for (int j = 0; j < 4; ++j) { v0[j] *= fsig(b0[j]); v1[j] *= fsig(b1[j]); }
            *(u32x4*)(Z + (size_t)(row0 + ai * HALF + m * 16) * DM + col0 + bj * HALF) = pack8(v0, v1); }
        return false;
    }
};
struct FEpiOut { static constexpr int NST = 0; const float* x; const float* modv; float* r1;
    __device__ __forceinline__ bool operator()(const f32x4 (&acc)[2][2][4][2], const Unit& u, int wr, int wc, int fr, int fq) const {
        const int row0 = u.pm * BM + wr * 64 + fr, col0 = u.pn * BM + wc * 32 + 8 * fq;
        const float* g = modv + (u.pm * BM / SEQ) * 6144 + 2048 + col0;
        f32x4 gv[2][2];
#pragma unroll
        for (int bj = 0; bj < 2; ++bj)
#pragma unroll
            for (int n = 0; n < 2; ++n) gv[bj][n] = *(const f32x4*)(g + bj * HALF + 4 * n);
#pragma unroll
        PG8_FRAG_LOOP { const size_t o = (size_t)(row0 + ai * HALF + m * 16) * DM + col0 + bj * HALF;
            const f32x4 x0 = *(const f32x4*)(x + o), x1 = *(const f32x4*)(x + o + 4);
            *(f32x4*)(r1 + o) = x0 * ALPHA + gv[bj][0] * acc[ai][bj][m][0]; *(f32x4*)(r1 + o + 4) = x1 * ALPHA + gv[bj][1] * acc[ai][bj][m][1]; }
        return false;
    }
};
struct FEpiDown { static constexpr int NST = 0; float* h; const float* modv; const float* b_down;
    __device__ __forceinline__ bool operator()(const f32x4 (&acc)[2][2][4][2], const Unit& u, int wr, int wc, int fr, int fq) const {
        const int row0 = u.pm * BM + wr * 64 + fr, col0 = u.pn * BM + wc * 32 + 8 * fq;
        const float* g = modv + (u.pm * BM / SEQ) * 6144 + 5120 + col0;
#pragma unroll
        for (int bj = 0; bj < 2; ++bj) {
            const f32x4 g0 = *(const f32x4*)(g + bj * HALF), g1 = *(const f32x4*)(g + bj * HALF + 4);
            const f32x4 c0 = g0 * *(const f32x4*)(b_down + col0 + bj * HALF), c1 = g1 * *(const f32x4*)(b_down + col0 + bj * HALF + 4);
#pragma unroll
            for (int ai = 0; ai < 2; ++ai)
#pragma unroll
                for (int m = 0; m < 4; ++m) { float* p = h + (size_t)(row0 + ai * HALF + m * 16) * DM + col0 + bj * HALF;
                    const f32x4 h0 = *(const f32x4*)p, h1 = *(const f32x4*)(p + 4);
                    *(f32x4*)p = h0 * ALPHA + (g0 * acc[ai][bj][m][0] + c0); *(f32x4*)(p + 4) = h1 * ALPHA + (g1 * acc[ai][bj][m][1] + c1);
                    if (m & 1) asm volatile("" ::: "memory"); }
        }
        return false;
    }
};

typedef unsigned u32x2p __attribute__((ext_vector_type(2)));
__device__ __forceinline__ float sum_rows4(float x) {
    const u32x2p a = __builtin_amdgcn_permlane32_swap(__float_as_uint(x), __float_as_uint(x), false, false); const float y = __uint_as_float(a[0]) + __uint_as_float(a[1]);
    const u32x2p b = __builtin_amdgcn_permlane16_swap(__float_as_uint(y), __float_as_uint(y), false, false); return __uint_as_float(b[0]) + __uint_as_float(b[1]); }
struct LnX { float* stats; unsigned* cnt; PG8_LAS float* sx; int x, pad; };
__device__ __forceinline__ void ln_exchange(const float (&ps)[2][4], const float (&pq)[2][4], const Unit& u, const LnX& L, int wr, int wc, int fr, int fq) {
    int tid = threadIdx.x; asm volatile("" : "+v"(tid)); const int lp = u.pm & 15;
#pragma unroll
    for (int ai = 0; ai < 2; ++ai)
#pragma unroll
        for (int m = 0; m < 4; ++m) { float s = ps[ai][m], q = pq[ai][m];
            s = sum_rows4(s); q = sum_rows4(q);
            if (fq == 0) { const int row = 128 * ai + 64 * wr + 16 * m + fr; L.sx[(wc * 256 + row) * 2] = s; L.sx[(wc * 256 + row) * 2 + 1] = q; } }
    __syncthreads();
    float* sb = L.stats + (size_t)((L.x * 16 + lp) * 4) * 512;
    float s_own = 0.f, q_own = 0.f;
    if (tid < 256) {
#pragma unroll
        for (int w = 0; w < 4; ++w) { s_own += L.sx[(w * 256 + tid) * 2]; q_own += L.sx[(w * 256 + tid) * 2 + 1]; }
        float2 o; o.x = s_own; o.y = q_own; *(float2*)(sb + (size_t)u.pn * 512 + tid * 2) = o; }
    asm volatile("s_waitcnt vmcnt(0)" ::: "memory");
    __syncthreads();
    if (tid == 0) { unsigned* cw = L.cnt + (L.x * 16 + lp) * 64;
        (void)__hip_atomic_fetch_add(cw, 1u, __ATOMIC_RELAXED, __HIP_MEMORY_SCOPE_AGENT);
        unsigned sp = 0; while (__hip_atomic_load(cw, __ATOMIC_RELAXED, __HIP_MEMORY_SCOPE_AGENT) < 4u) { __builtin_amdgcn_s_sleep(1); if (++sp > (1u << 22)) break; } }
    __syncthreads();
    if (tid < 256) {
#pragma unroll
        for (int o = 1; o < 4; ++o) { const int pn2 = (u.pn + o) & 3; const float* pp = sb + (size_t)pn2 * 512 + tid * 2;
            s_own += __hip_atomic_load(pp, __ATOMIC_RELAXED, __HIP_MEMORY_SCOPE_AGENT); q_own += __hip_atomic_load(pp + 1, __ATOMIC_RELAXED, __HIP_MEMORY_SCOPE_AGENT); }
        const float mean = s_own * (1.f / DM); const float var = fmaxf(q_own * (1.f / DM) - mean * mean, 0.f);
        L.sx[(4 * 256 + tid) * 2] = mean; L.sx[(4 * 256 + tid) * 2 + 1] = rsqrtf(var + EPS); }
    __syncthreads();
}
struct FEpiOutLN { static constexpr int NST = 0; const float* x; const float* modv; float* h1; bf16_t* u2; const float* gam; const float* bet; LnX L;
    __device__ __forceinline__ bool operator()(f32x4 (&acc)[2][2][4][2], const Unit& u, int wr, int wc, int fr, int fq) const {
        asm volatile("" : "+v"(fr), "+v"(fq));
        const int row0 = u.pm * BM + wr * 64 + fr, col0 = u.pn * BM + wc * 32 + 8 * fq;
        const float* mv = modv + (u.pm * BM / SEQ) * 6144;
        const unsigned ob = (unsigned)(row0 * DM + col0) * 4u;
        const char* xb = (const char*)x; char* hb = (char*)h1; char* ub = (char*)u2;
        float ps[2][4], pq[2][4];
#pragma unroll
        for (int ai = 0; ai < 2; ++ai)
#pragma unroll
            for (int m = 0; m < 4; ++m) { ps[ai][m] = 0.f; pq[ai][m] = 0.f; }
        unsigned obd = ob;
#pragma unroll
        for (int bj = 0; bj < 2; ++bj) { const f32x4 g0 = *(const f32x4*)(mv + 2048 + col0 + bj * HALF), g1 = *(const f32x4*)(mv + 2048 + col0 + bj * HALF + 4);
#pragma unroll
            for (int ai = 0; ai < 2; ++ai) {
#pragma unroll
                for (int m = 0; m < 4; ++m) { const unsigned o = obd + (unsigned)(((ai * HALF + m * 16) * DM + bj * HALF) * 4);
                    const f32x4 v0 = *(const f32x4*)(xb + o) * ALPHA + g0 * acc[ai][bj][m][0], v1 = *(const f32x4*)(xb + o + 16) * ALPHA + g1 * acc[ai][bj][m][1];
                    acc[ai][bj][m][0] = v0; acc[ai][bj][m][1] = v1;
                    ps[ai][m] += ((v0[0] + v0[1]) + (v0[2] + v0[3])) + ((v1[0] + v1[1]) + (v1[2] + v1[3]));
                    pq[ai][m] += ((v0[0] * v0[0] + v0[1] * v0[1]) + (v0[2] * v0[2] + v0[3] * v0[3])) + ((v1[0] * v1[0] + v1[1] * v1[1]) + (v1[2] * v1[2] + v1[3] * v1[3])); }
                asm volatile("" : "+v"(obd) : "v"(pq[ai][3]), "v"(pq[ai][0]), "v"(pq[ai][1]), "v"(pq[ai][2])); } }
        ln_exchange(ps, pq, u, L, wr, wc, fr, fq);
#pragma unroll
        for (int bj = 0; bj < 2; ++bj) { const int cc = col0 + bj * HALF;
            const f32x4 ga0 = *(const f32x4*)(gam + cc), ga1 = *(const f32x4*)(gam + cc + 4), be0 = *(const f32x4*)(bet + cc), be1 = *(const f32x4*)(bet + cc + 4);
#pragma unroll
            for (int ai = 0; ai < 2; ++ai)
#pragma unroll
                for (int m = 0; m < 4; ++m) { const int rl = 128 * ai + 64 * wr + 16 * m + fr; const float mean = L.sx[(4 * 256 + rl) * 2], rstd = L.sx[(4 * 256 + rl) * 2 + 1];
                    const unsigned o = ob + (unsigned)(((ai * HALF + m * 16) * DM + bj * HALF) * 4);
                    acc[ai][bj][m][0] = (acc[ai][bj][m][0] - mean) * rstd * ga0 + be0; acc[ai][bj][m][1] = (acc[ai][bj][m][1] - mean) * rstd * ga1 + be1;
                    *(f32x4*)(hb + o) = acc[ai][bj][m][0]; *(f32x4*)(hb + o + 16) = acc[ai][bj][m][1];
                    asm volatile("" ::: "memory"); } }
#pragma unroll
        for (int bj = 0; bj < 2; ++bj) { const int cc = col0 + bj * HALF;
            const f32x4 sh0 = *(const f32x4*)(mv + 3072 + cc), sh1 = *(const f32x4*)(mv + 3072 + cc + 4), sc0 = *(const f32x4*)(mv + 4096 + cc) + 1.f, sc1 = *(const f32x4*)(mv + 4096 + cc + 4) + 1.f;
#pragma unroll
            for (int ai = 0; ai < 2; ++ai)
#pragma unroll
                for (int m = 0; m < 4; ++m) { const unsigned o = ob + (unsigned)(((ai * HALF + m * 16) * DM + bj * HALF) * 4);
                    *(u32x4*)(ub + (o >> 1)) = pack8(acc[ai][bj][m][0] * sc0 + sh0, acc[ai][bj][m][1] * sc1 + sh1);
                    asm volatile("" ::: "memory"); } }
        return false;
    }
};
struct FEpiDownLN { static constexpr int NST = 0; float* h; const float* modv; const float* b_down; const float* gam; const float* bet; LnX L;
    __device__ __forceinline__ bool operator()(f32x4 (&acc)[2][2][4][2], const Unit& u, int wr, int wc, int fr, int fq) const {
        asm volatile("" : "+v"(fr), "+v"(fq));
        const int row0 = u.pm * BM + wr * 64 + fr, col0 = u.pn * BM + wc * 32 + 8 * fq;
        const float* mv = modv + (u.pm * BM / SEQ) * 6144;
        const unsigned ob = (unsigned)(row0 * DM + col0) * 4u;
        char* hb = (char*)h;
        float ps[2][4], pq[2][4];
#pragma unroll
        for (int ai = 0; ai < 2; ++ai)
#pragma unroll
            for (int m = 0; m < 4; ++m) { ps[ai][m] = 0.f; pq[ai][m] = 0.f; }
        unsigned obd = ob;
#pragma unroll
        for (int bj = 0; bj < 2; ++bj) { const f32x4 g0 = *(const f32x4*)(mv + 5120 + col0 + bj * HALF), g1 = *(const f32x4*)(mv + 5120 + col0 + bj * HALF + 4);
            const f32x4 c0 = g0 * *(const f32x4*)(b_down + col0 + bj * HALF), c1 = g1 * *(const f32x4*)(b_down + col0 + bj * HALF + 4);
#pragma unroll
            for (int ai = 0; ai < 2; ++ai) {
#pragma unroll
                for (int m = 0; m < 4; ++m) { const unsigned o = obd + (unsigned)(((ai * HALF + m * 16) * DM + bj * HALF) * 4);
                    const f32x4 v0 = *(const f32x4*)(hb + o) * ALPHA + (g0 * acc[ai][bj][m][0] + c0), v1 = *(const f32x4*)(hb + o + 16) * ALPHA + (g1 * acc[ai][bj][m][1] + c1);
                    acc[ai][bj][m][0] = v0; acc[ai][bj][m][1] = v1;
                    ps[ai][m] += ((v0[0] + v0[1]) + (v0[2] + v0[3])) + ((v1[0] + v1[1]) + (v1[2] + v1[3]));
                    pq[ai][m] += ((v0[0] * v0[0] + v0[1] * v0[1]) + (v0[2] * v0[2] + v0[3] * v0[3])) + ((v1[0] * v1[0] + v1[1] * v1[1]) + (v1[2] * v1[2] + v1[3] * v1[3]));
                    }
                asm volatile("" : "+v"(obd) : "v"(pq[ai][3]), "v"(pq[ai][0]), "v"(pq[ai][1]), "v"(pq[ai][2])); } }
        ln_exchange(ps, pq, u, L, wr, wc, fr, fq);
#pragma unroll
        for (int bj = 0; bj < 2; ++bj) { const int cc = col0 + bj * HALF;
            const f32x4 ga0 = *(const f32x4*)(gam + cc), ga1 = *(const f32x4*)(gam + cc + 4), be0 = *(const f32x4*)(bet + cc), be1 = *(const f32x4*)(bet + cc + 4);
#pragma unroll
            for (int ai = 0; ai < 2; ++ai)
#pragma unroll
                for (int m = 0; m < 4; ++m) { const int rl = 128 * ai + 64 * wr + 16 * m + fr; const float mean = L.sx[(4 * 256 + rl) * 2], rstd = L.sx[(4 * 256 + rl) * 2 + 1];
                    const unsigned o = ob + (unsigned)(((ai * HALF + m * 16) * DM + bj * HALF) * 4);
                    *(f32x4*)(hb + o) = (acc[ai][bj][m][0] - mean) * rstd * ga0 + be0; *(f32x4*)(hb + o + 16) = (acc[ai][bj][m][1] - mean) * rstd * ga1 + be1;
                    asm volatile("" ::: "memory"); } }
        return false;
    }
};
struct FEpiSideF { static constexpr int NST = 0; bf16_t* side; const float* bias; bf16_t* hm; bf16_t* hg; const float* gm; const float* gg; PG8_LAS float* sx;
    __device__ __forceinline__ bool operator()(f32x4 (&acc)[2][2][4][2], const Unit& u, int wr, int wc, int fr, int fq) const {
        asm volatile("" : "+v"(fr), "+v"(fq));
        const int row0 = u.pm * BM + wr * 64 + fr, cin = wc * 32 + 8 * fq;
        if (u.pn >= 8) {
            f32x4 bv[2][2];
#pragma unroll
            for (int bj = 0; bj < 2; ++bj)
#pragma unroll
                for (int n = 0; n < 2; ++n) bv[bj][n] = *(const f32x4*)(bias + u.pn * BM + cin + bj * HALF + 4 * n);
#pragma unroll
            PG8_FRAG_LOOP { *(u32x4*)(side + (size_t)(row0 + ai * HALF + m * 16) * 4096 + u.pn * BM + cin + bj * HALF) = pack8(acc[ai][bj][m][0] + bv[bj][0], acc[ai][bj][m][1] + bv[bj][1]); }
            return false;
        }
        const bool isg = u.pn >= 4;
        char* hb = (char*)(isg ? hg : hm); const int hc0 = (u.pn & 3) * BM + cin;
        const unsigned ob = (unsigned)(row0 * DM + hc0) * 2u;
        const unsigned OB = (unsigned)ML * DM * 2u;
        int tid = threadIdx.x; asm volatile("" : "+v"(tid));
        unsigned obd = ob;
#pragma unroll
        for (int bj = 0; bj < 2; ++bj)
            {
                float ps[2][4], pq[2][4];
#pragma unroll
                for (int ai = 0; ai < 2; ++ai)
#pragma unroll
                for (int m = 0; m < 4; ++m) { const unsigned o = obd + (unsigned)(((ai * HALF + m * 16) * DM + bj * HALF) * 2);
                    f32x4 f0, f1, b0, b1; unpack8(*(const u32x4*)(hb + o), f0, f1); unpack8(*(const u32x4*)(hb + o + OB), b0, b1);
                    const f32x4 v0 = f0 + b0, v1 = f1 + b1;
                    ps[ai][m] = ((v0[0] + v0[1]) + (v0[2] + v0[3])) + ((v1[0] + v1[1]) + (v1[2] + v1[3]));
                    pq[ai][m] = ((v0[0] * v0[0] + v0[1] * v0[1]) + (v0[2] * v0[2] + v0[3] * v0[3])) + ((v1[0] * v1[0] + v1[1] * v1[1]) + (v1[2] * v1[2] + v1[3] * v1[3])); }
                asm volatile("" : "+v"(obd) : "v"(pq[0][0]), "v"(pq[0][3]), "v"(pq[1][0]), "v"(pq[1][3]));
#pragma unroll
                for (int ai = 0; ai < 2; ++ai)
#pragma unroll
                for (int m = 0; m < 4; ++m) { const float s = sum_rows4(ps[ai][m]), q = sum_rows4(pq[ai][m]);
                    if (fq == 0) { const int row = 128 * ai + 64 * wr + 16 * m + fr; sx[((wc * 2 + bj) * 256 + row) * 2] = s; sx[((wc * 2 + bj) * 256 + row) * 2 + 1] = q; } } }
        __syncthreads();
        { const int rr = tid & 255, bb = tid >> 8; float s = 0.f, q = 0.f, q2 = 0.f;
#pragma unroll
          for (int w = 0; w < 4; ++w) { s += sx[((w * 2 + bb) * 256 + rr) * 2]; q += sx[((w * 2 + bb) * 256 + rr) * 2 + 1]; q2 += sx[((w * 2 + (bb ^ 1)) * 256 + rr) * 2 + 1]; }
          float mean, rstd;
          if (isg) { mean = 0.f; rstd = rsqrtf((q + q2) * (1.f / 256.f) + EPS); }
          else { mean = s * (1.f / 128.f); rstd = rsqrtf(fmaxf(q * (1.f / 128.f) - mean * mean, 0.f) + EPS); }
          __syncthreads();
          sx[(bb * 256 + rr) * 2] = mean; sx[(bb * 256 + rr) * 2 + 1] = rstd; }
        __syncthreads();
        obd = ob;
#pragma unroll
        for (int bj = 0; bj < 2; ++bj) { const float* bp = bias + u.pn * BM + cin + bj * HALF;
            const f32x4 gma0 = *(const f32x4*)(gm + hc0 + bj * HALF), gma1 = *(const f32x4*)(gm + hc0 + bj * HALF + 4), gga0 = *(const f32x4*)(gg + hc0 + bj * HALF), gga1 = *(const f32x4*)(gg + hc0 + bj * HALF + 4);
            const f32x4 ga0 = isg ? gga0 : gma0, ga1 = isg ? gga1 : gma1, bi0 = *(const f32x4*)bp, bi1 = *(const f32x4*)(bp + 4);
            float dep = 0.f;
#pragma unroll
            for (int ai = 0; ai < 2; ++ai) {
#pragma unroll
                for (int m = 0; m < 4; ++m) { const int rl = 128 * ai + 64 * wr + 16 * m + fr; const float mean = sx[(bj * 256 + rl) * 2], rstd = sx[(bj * 256 + rl) * 2 + 1];
                    const unsigned o = obd + (unsigned)(((ai * HALF + m * 16) * DM + bj * HALF) * 2);
                    f32x4 f0, f1, b0, b1; unpack8(*(const u32x4*)(hb + o), f0, f1); unpack8(*(const u32x4*)(hb + o + OB), b0, b1);
                    const f32x4 g0 = acc[ai][bj][m][0] + bi0, g1 = acc[ai][bj][m][1] + bi1;
                    f32x4 o0 = (f0 + b0 - mean) * rstd * ga0, o1 = (f1 + b1 - mean) * rstd * ga1;
#pragma unroll
                    for (int j = 0; j < 4; ++j) { const float s0 = fsig(g0[j]), s1 = fsig(g1[j]); o0[j] *= isg ? g0[j] * s0 : s0; o1[j] *= isg ? g1[j] * s1 : s1; }
                    *(u32x4*)(hb + o) = pack8(o0, o1); dep = o1[3]; } }
            asm volatile("" : "+v"(obd) : "v"(dep)); }
        return false;
    }
};
}

namespace scan {
#define LAS __attribute__((address_space(3)))
typedef short bf16x8 __attribute__((ext_vector_type(8)));
typedef short s16x4 __attribute__((ext_vector_type(4)));
typedef float f32x4 __attribute__((ext_vector_type(4)));
typedef unsigned u32x4 __attribute__((ext_vector_type(4)));
typedef unsigned u32x2 __attribute__((ext_vector_type(2)));
constexpr int RS = 288, RSP = 144, RSG = 80;
constexpr int TILE = 64 * RS;
constexpr int L_T = 0;
constexpr int L_P = 6 * TILE;
constexpr int L_SC = L_P + 64 * RSP;
constexpr int SC_F = 0, SC_QN = 768  , SC_RS = 832  , SC_N = 896  , SC_DEC = 1152  , SC_GB = 1408  ,
              SC_CW = 1536  , SC_END = 2304;
constexpr int L_GW = L_SC + SC_END * 4;
constexpr int L_R = L_GW + 128 * RSG;
constexpr int LDS_BYTES = L_R + 2 * 64 * RSG;
constexpr int XSLOT = 16640;
static_assert(LDS_BYTES <= 160 * 1024 && L_SC % 16 == 0 && L_GW % 16 == 0 && L_R % 16 == 0, "scan LDS");

typedef float f32x2_t __attribute__((ext_vector_type(2))); typedef __bf16 bf16x2_t __attribute__((ext_vector_type(2)));
__device__ __forceinline__ unsigned cvt_pk(float lo, float hi) { f32x2_t v = {lo, hi}; bf16x2_t b = __builtin_convertvector(v, bf16x2_t); return __builtin_bit_cast(unsigned, b); }
__device__ __forceinline__ s16x4 tr16(const LAS unsigned char* p) { return __builtin_bit_cast(s16x4, __builtin_amdgcn_ds_read_tr16_b64_v4i16((LAS s16x4*)p)); }
__device__ __forceinline__ bf16x8 cat4(s16x4 a, s16x4 b) { return (bf16x8){a[0], a[1], a[2], a[3], b[0], b[1], b[2], b[3]}; }
__device__ __forceinline__ void unpack8f(u32x4 w, float* v) {
    v[0] = __uint_as_float(w.x << 16); v[1] = __uint_as_float(w.x & 0xffff0000u); v[2] = __uint_as_float(w.y << 16); v[3] = __uint_as_float(w.y & 0xffff0000u);
    v[4] = __uint_as_float(w.z << 16); v[5] = __uint_as_float(w.z & 0xffff0000u); v[6] = __uint_as_float(w.w << 16); v[7] = __uint_as_float(w.w & 0xffff0000u); }
__device__ __forceinline__ float fsilu(float x) { return x * __builtin_amdgcn_rcpf(1.f + __expf(-x)); }
template <int CTRL, int RMASK> __device__ __forceinline__ float dpp_f(float old, float x) { return __int_as_float(__builtin_amdgcn_update_dpp(__float_as_int(old), __float_as_int(x), CTRL, RMASK, 0xf, false)); }
__device__ __forceinline__ float scan_sum64(float x) {
    x += dpp_f<0x111, 0xf>(0.f, x); x += dpp_f<0x112, 0xf>(0.f, x); x += dpp_f<0x114, 0xf>(0.f, x); x += dpp_f<0x118, 0xf>(0.f, x);
    x += dpp_f<0x142, 0xa>(0.f, x); x += dpp_f<0x143, 0xc>(0.f, x); return x; }
__device__ __forceinline__ float scan_max64(float x) {
    const float NI = -__builtin_inff();
    x = fmaxf(x, dpp_f<0x111, 0xf>(NI, x)); x = fmaxf(x, dpp_f<0x112, 0xf>(NI, x)); x = fmaxf(x, dpp_f<0x114, 0xf>(NI, x)); x = fmaxf(x, dpp_f<0x118, 0xf>(NI, x));
    x = fmaxf(x, dpp_f<0x142, 0xa>(NI, x)); x = fmaxf(x, dpp_f<0x143, 0xc>(NI, x)); return x; }
__device__ __forceinline__ float lane63(float x) { return __int_as_float(__builtin_amdgcn_readlane(__float_as_int(x), 63)); }

template <int V> struct IC { static constexpr int value = V; };
struct Args {
    const bf16_t* P; int ld, pad;
    const float* small;
    const float* conv_qk;
    const float* gw_f; const float* gb_f; const float* gw_b; const float* gb_b;
    bf16_t* hout;
    unsigned char* xbuf; unsigned* xflag;
};

template <bool GLA>
__device__ __forceinline__ void scan_item(LAS unsigned char* lds, const Args& a, const int item) {
    int tid_ = threadIdx.x; asm volatile("" : "+v"(tid_));
    const int tid = tid_, lane = tid & 63, wid = __builtin_amdgcn_readfirstlane(tid >> 6), c = lane & 15, g = lane >> 4;
    LAS float* sc = (LAS float*)(lds + L_SC);
    int b, h, dir, half = 0;
    if (GLA) { half = item & 1; dir = (item >> 1) & 1; h = (item >> 2) & 3; b = item >> 4; } else { dir = item & 1; h = (item >> 1) & 7; b = item >> 4; }
    const int colq = h * 128, colk = GLA ? 512 + h * 128 : 1024 + h * 128, colv = GLA ? 1024 + h * 256 + half * 128 : 2048 + h * 128;
    const int ocol = GLA ? h * 256 + half * 128 : h * 128;
    bf16_t* hout = a.hout + (size_t)dir * ML * DM;
    const float* gw = dir ? a.gw_b : a.gw_f; const float* gbp = dir ? a.gb_b : a.gb_f;

    for (int i = tid; i < 256; i += 512) sc[SC_N + i] = 0.f;
    if (GLA) {
        for (int i = tid; i < 2048; i += 512) { const int d = i >> 4, k = i & 15; const float v = gw[k * 512 + h * 128 + d] * 1.4426950408889634f; const bf16_t hv = f2bf(v), lv = f2bf(v - bf2f(hv));
            *(LAS bf16_t*)(lds + L_GW + d * RSG + k * 2) = hv; *(LAS bf16_t*)(lds + L_GW + d * RSG + 32 + k * 2) = lv; }
        if (tid < 128) sc[SC_GB + tid] = gbp[h * 128 + tid] * 1.4426950408889634f;
    } else if (tid < 256) { const int e = tid & 127, isk = tid >> 7; const int ch = (isk ? 1024 : 0) + h * 128 + e;
        const float w0 = a.conv_qk[ch] * 1.4426950408889634f, w1 = a.conv_qk[2048 + ch] * 1.4426950408889634f, w2 = a.conv_qk[4096 + ch] * 1.4426950408889634f;
        sc[SC_CW + (isk * 3 + 0) * 128 + e] = dir ? w2 : w0; sc[SC_CW + (isk * 3 + 1) * 128 + e] = w1; sc[SC_CW + (isk * 3 + 2) * 128 + e] = dir ? w0 : w2; }

#define SCAN_ROW(cc_, p_, rowv) do { const int seg_ = (cc_) < 4 ? 0 : 1; const int T_ = seg_ ? SEQ : CTX; const int row0_ = seg_ ? b * SEQ : ML + b * CTX; \
        int pp_ = (p_); pp_ = pp_ < 0 ? 0 : (pp_ > T_ - 1 ? T_ - 1 : pp_); const int t_ = dir ? (T_ - 1 - pp_) : pp_; rowv = row0_ + t_; } while (0)
#define SCAN_CI(cc_) ((cc_) < 4 ? (cc_) : (cc_) - 4)

    if (wid >= 4) {
        const int ptid = tid - 256, pw = wid - 4, cg = ptid & 15;
        __builtin_amdgcn_s_setprio(1);
        u32x4 rawvS[2][4];
        u32x4 rawmS[2][10]; u32x2 rawqS[2][8], rawkS[2][8];
        float m_run = 0.f, pre_liS[2] = {0.f, 0.f}, pre_lfS[2] = {0.f, 0.f};
        f32x4 pre_rS[2][4];
#pragma unroll
        for (int i = 0; i < 4; ++i) { pre_rS[0][i] = (f32x4){0.f, 0.f, 0.f, 0.f}; pre_rS[1][i] = (f32x4){0.f, 0.f, 0.f, 0.f}; }
        const int which = pw >> 1, rg = (ptid >> 4) & 7;
        if (GLA) {
            u32x4 vr[2][4]; u32x2 qr[2][4], kr[2][4]; f32x4 prr[4];
#pragma unroll
            for (int i = 0; i < 4; ++i) prr[i] = (f32x4){0.f, 0.f, 0.f, 0.f};
            const char* pbG = (const char*)a.P; const unsigned ldbG = (unsigned)a.ld * 2u;
#define GLA_GV(S_, cc_) do { const int ci_ = SCAN_CI(cc_); _Pragma("unroll") for (int k_ = 0; k_ < 4; ++k_) { int row; SCAN_ROW(cc_, ci_ * 64 + (ptid >> 4) + 16 * k_, row); \
                vr[S_][k_] = *(const u32x4*)(pbG + ((unsigned)row * ldbG + (unsigned)(colv + cg * 8) * 2u)); } } while (0)
#define GLA_GQK(S_, cc_) do { const int ci_ = SCAN_CI(cc_); const bool sq_ = (cc_) >= 4; _Pragma("unroll") for (int tl_ = 0; tl_ < 4; ++tl_) { int row; SCAN_ROW(cc_, ci_ * 64 + 16 * tl_ + c, row); \
                const unsigned ro_ = (unsigned)row * ldbG + (unsigned)(16 * (4 * half + pw) + 4 * g) * 2u; \
                if (sq_) qr[S_][tl_] = *(const u32x2*)(pbG + (ro_ + (unsigned)colq * 2u)); kr[S_][tl_] = *(const u32x2*)(pbG + (ro_ + (unsigned)colk * 2u)); } } while (0)
#define GLA_GR(cc_) do { if (pw == 0) { const int ci_ = SCAN_CI(cc_); int row; SCAN_ROW(cc_, ci_ * 64 + lane, row); const char* sb_ = (const char*)a.small; const unsigned so_ = (unsigned)row * 256u; \
                _Pragma("unroll") for (int i_ = 0; i_ < 4; ++i_) prr[i_] = *(const f32x4*)(sb_ + (so_ + (unsigned)(32 + dir * 16 + 4 * i_) * 4u)); } } while (0)
            auto grw = [&](const int buf) __attribute__((always_inline)) {
                if (pw == 0) {
                    unsigned hi[8], lo[8];
#pragma unroll
                    for (int i = 0; i < 4; ++i) { const f32x4 v = prr[i]; const unsigned h0 = cvt_pk(v[0], v[1]), h1 = cvt_pk(v[2], v[3]);
                        hi[2 * i] = h0; hi[2 * i + 1] = h1;
                        lo[2 * i] = cvt_pk(v[0] - __uint_as_float(h0 << 16), v[1] - __uint_as_float(h0 & 0xffff0000u)); lo[2 * i + 1] = cvt_pk(v[2] - __uint_as_float(h1 << 16), v[3] - __uint_as_float(h1 & 0xffff0000u)); }
                    LAS unsigned char* rp = lds + L_R + buf * (64 * RSG) + lane * RSG;
                    *(LAS u32x4*)rp = (u32x4){hi[0], hi[1], hi[2], hi[3]}; *(LAS u32x4*)(rp + 16) = (u32x4){hi[4], hi[5], hi[6], hi[7]};
                    *(LAS u32x4*)(rp + 32) = (u32x4){lo[0], lo[1], lo[2], lo[3]}; *(LAS u32x4*)(rp + 48) = (u32x4){lo[4], lo[5], lo[6], lo[7]}; }
            };
            auto produce = [&](auto setc, const int cn) __attribute__((always_inline)) {
                constexpr int S = decltype(setc)::value;
                const bool sq = cn >= 4; const int pn = cn & 1, dt = 4 * half + pw;
                unsigned char* xo = a.xbuf + (size_t)(((item * 8) + (cn & 7)) * XSLOT);
                const LAS unsigned char* gwb = lds + L_GW + (16 * dt + c) * RSG + 16 * (g & 1);
                const bf16x8 A1 = *(const LAS bf16x8*)gwb, A2 = *(const LAS bf16x8*)(gwb + 32);
                const f32x4 gbv = *(const LAS f32x4*)(sc + SC_GB + 16 * dt + 4 * g);
                const LAS unsigned char* rb = lds + L_R + pn * (64 * RSG) + c * RSG + 16 * g;
                f32x4 x[4];
#pragma unroll
                for (int tl = 0; tl < 4; ++tl) {
                    const bf16x8 B = *(const LAS bf16x8*)(rb + tl * 16 * RSG);
                    f32x4 acc = __builtin_amdgcn_mfma_f32_16x16x32_bf16(A1, B, gbv, 0, 0, 0);
                    acc = __builtin_amdgcn_mfma_f32_16x16x32_bf16(A2, B, acc, 0, 0, 0);
#pragma unroll
                    for (int i = 0; i < 4; ++i) { float v = __builtin_amdgcn_logf(1.f + __builtin_amdgcn_exp2f(-fmaxf(acc[i], -115.f))) * -0.0625f;
                        v += dpp_f<0x111, 0xf>(0.f, v); v += dpp_f<0x112, 0xf>(0.f, v); v += dpp_f<0x114, 0xf>(0.f, v); v += dpp_f<0x118, 0xf>(0.f, v);
                        acc[i] = v; }
                    x[tl] = acc;
                }
                f32x4 off = (f32x4){0.f, 0.f, 0.f, 0.f};
#pragma unroll
                for (int tl = 0; tl < 4; ++tl) { f32x4 tot;
#pragma unroll
                    for (int i = 0; i < 4; ++i) tot[i] = dpp_f<0x15F, 0xf>(0.f, x[tl][i]);
                    x[tl] += off; off += tot; }
                if (c == 0) { f32x4 dec;
#pragma unroll
                    for (int i = 0; i < 4; ++i) dec[i] = __builtin_amdgcn_exp2f(off[i]);
                    *(f32x4*)(xo + 16384 + (16 * pw + 4 * g) * 4) = dec; }
                const f32x4 offq = off + 3.5f;
#pragma unroll
                for (int tl = 0; tl < 4; ++tl) {
                    const int t = 16 * tl + c;
                    if (sq) { const u32x2 qw = qr[S][tl]; const f32x4 eq = x[tl] - offq;
                        const float q0 = __uint_as_float(qw.x << 16), q1 = __uint_as_float(qw.x & 0xffff0000u), q2 = __uint_as_float(qw.y << 16), q3 = __uint_as_float(qw.y & 0xffff0000u);
                        u32x2 w; w.x = cvt_pk(q0 * __builtin_amdgcn_exp2f(fminf(eq[0], 110.f)), q1 * __builtin_amdgcn_exp2f(fminf(eq[1], 110.f)));
                        w.y = cvt_pk(q2 * __builtin_amdgcn_exp2f(fminf(eq[2], 110.f)), q3 * __builtin_amdgcn_exp2f(fminf(eq[3], 110.f)));
                        *(u32x2*)(xo + t * 128 + (16 * pw + 4 * g) * 2) = w; }
                    { const u32x2 kw = kr[S][tl]; const f32x4 ek = off - x[tl];
                        const float k0 = __uint_as_float(kw.x << 16), k1 = __uint_as_float(kw.x & 0xffff0000u), k2 = __uint_as_float(kw.y << 16), k3 = __uint_as_float(kw.y & 0xffff0000u);
                        u32x2 w; w.x = cvt_pk(k0 * __builtin_amdgcn_exp2f(ek[0]), k1 * __builtin_amdgcn_exp2f(ek[1])); w.y = cvt_pk(k2 * __builtin_amdgcn_exp2f(ek[2]), k3 * __builtin_amdgcn_exp2f(ek[3]));
                        *(u32x2*)(xo + 8192 + t * 128 + (16 * pw + 4 * g) * 2) = w; }
                }
            };
            u32x4 cq[4], ck[4]; f32x4 cd = (f32x4){0.f, 0.f, 0.f, 0.f};
            const int crow = ptid >> 2, cpc = ptid & 3;
            auto cload = [&](const int cn) __attribute__((always_inline)) {
                const unsigned char* xi = a.xbuf + (size_t)(((((item & ~1) | (cpc >> 1)) * 8) + (cn & 7)) * XSLOT) + crow * 128 + (cpc & 1) * 64;
                if (cn >= 4) {
#pragma unroll
                    for (int k = 0; k < 4; ++k) cq[k] = *(const u32x4*)(xi + 16 * k); }
#pragma unroll
                for (int k = 0; k < 4; ++k) ck[k] = *(const u32x4*)(xi + 8192 + 16 * k);
                if (ptid < 32) cd = *(const f32x4*)(a.xbuf + (size_t)(((((item & ~1) | (ptid >> 4)) * 8) + (cn & 7)) * XSLOT) + 16384 + (ptid & 15) * 16);
            };
            auto cstore = [&](auto setc, const int cn) __attribute__((always_inline)) {
                constexpr int S = decltype(setc)::value; const int pn = cn & 1;
                LAS unsigned char* tq = lds + L_T + pn * 3 * TILE; LAS unsigned char* tk = tq + TILE; LAS unsigned char* tv = tq + 2 * TILE;
                if (cn >= 4) {
#pragma unroll
                    for (int k = 0; k < 4; ++k) *(LAS u32x4*)(tq + crow * RS + cpc * 64 + 16 * k) = cq[k]; }
#pragma unroll
                for (int k = 0; k < 4; ++k) *(LAS u32x4*)(tk + crow * RS + cpc * 64 + 16 * k) = ck[k];
#pragma unroll
                for (int k = 0; k < 4; ++k) *(LAS u32x4*)(tv + ((ptid >> 4) + 16 * k) * RS + cg * 16) = vr[S][k];
                if (ptid < 32) *(LAS f32x4*)(sc + SC_DEC + pn * 128 + 64 * (ptid >> 4) + 4 * (ptid & 15)) = cd;
            };
            unsigned flv = 0u;
            auto xpub = [&](const unsigned pubv, const unsigned target, const bool inval) __attribute__((always_inline)) {
                if (ptid == 0) { __hip_atomic_store(a.xflag + item * 64, pubv, __ATOMIC_RELAXED, __HIP_MEMORY_SCOPE_AGENT);
                    if (flv < target) { unsigned sp = 0; while (__hip_atomic_load(a.xflag + (item ^ 1) * 64, __ATOMIC_RELAXED, __HIP_MEMORY_SCOPE_AGENT) < target) { __builtin_amdgcn_s_sleep(1); if (++sp > (1u << 22)) break; } }
                    if (inval) { __builtin_amdgcn_fence(__ATOMIC_ACQUIRE, "agent"); asm volatile("s_waitcnt vmcnt(0)" ::: "memory"); } }
            };
            GLA_GV(0, 0); GLA_GQK(0, 0); GLA_GR(0); GLA_GV(1, 1); GLA_GQK(1, 1);
            grw(0); GLA_GR(1);
            __syncthreads();
            produce(IC<0>{}, 0); GLA_GQK(0, 2);
            grw(1); GLA_GR(2);
            __syncthreads();
            produce(IC<1>{}, 1); GLA_GQK(1, 3);
            grw(0); GLA_GR(3);
            __syncthreads();
            produce(IC<0>{}, 2); GLA_GQK(0, 4);
            grw(1); GLA_GR(4);
            asm volatile("s_waitcnt vmcnt(0)" ::: "memory");
            __syncthreads();
            flv = 0u; xpub(3u, 3u, true);
            __syncthreads();
            cload(0); asm volatile("s_waitcnt vmcnt(0)" ::: "memory"); cstore(IC<0>{}, 0); GLA_GV(0, 2);
            auto gstep = [&](auto setc, const int cn) __attribute__((always_inline)) {
                constexpr int S = decltype(setc)::value;
                if (ptid == 0) flv = __hip_atomic_load(a.xflag + (item ^ 1) * 64, __ATOMIC_RELAXED, __HIP_MEMORY_SCOPE_AGENT);
                if (cn + 1 < 36) cload(cn + 1);
                if (cn + 3 < 36) produce(IC<S ^ 1>{}, cn + 3);
                asm volatile("s_waitcnt vmcnt(0)" ::: "memory");
                if (cn + 1 < 36) cstore(IC<S ^ 1>{}, cn + 1);
            };
            auto gpre = [&](auto setc, const int cn) __attribute__((always_inline)) {
                constexpr int S = decltype(setc)::value;
                GLA_GQK(S ^ 1, cn + 5); GLA_GV(S ^ 1, cn + 3);
                grw(S); GLA_GR(cn + 5);
            };
            for (int cc = 0; cc < 36; cc += 2) {
                __syncthreads();
                gstep(IC<0>{}, cc);
                __syncthreads();
                xpub((unsigned)(cc + 4 < 36 ? cc + 4 : 36), (unsigned)(cc + 3 < 36 ? cc + 3 : 36), (cc % 6) == 0);
                gpre(IC<0>{}, cc);
                __syncthreads();
                gstep(IC<1>{}, cc + 1);
                __syncthreads();
                xpub((unsigned)(cc + 5 < 36 ? cc + 5 : 36), (unsigned)(cc + 4 < 36 ? cc + 4 : 36), ((cc + 1) % 6) == 0);
                gpre(IC<1>{}, cc + 1);
            }
#undef GLA_GV
#undef GLA_GQK
#undef GLA_GR
        } else {
#define SCAN_ISSUE(S_, cc_) do { const int ci_ = SCAN_CI(cc_); const bool sq_ = (cc_) >= 4; const char* pb_ = (const char*)a.P; const unsigned ldb_ = (unsigned)a.ld * 2u; \
        _Pragma("unroll") for (int k_ = 0; k_ < 4; ++k_) { int row; SCAN_ROW(cc_, ci_ * 64 + (ptid >> 4) + 16 * k_, row); rawvS[S_][k_] = *(const u32x4*)(pb_ + ((unsigned)row * ldb_ + (unsigned)(colv + cg * 8) * 2u)); } \
        if (!GLA) { if (which || sq_) { _Pragma("unroll") for (int j_ = 0; j_ < 10; ++j_) { int row; SCAN_ROW(cc_, ci_ * 64 + 8 * rg - 1 + j_, row); \
                rawmS[S_][j_] = *(const u32x4*)(pb_ + ((unsigned)row * ldb_ + (unsigned)((which ? colk : colq) + cg * 8) * 2u)); } } } \
        else { _Pragma("unroll") for (int tl_ = 0; tl_ < 4; ++tl_) { int row; SCAN_ROW(cc_, ci_ * 64 + 16 * tl_ + c, row); const unsigned ro_ = (unsigned)row * ldb_ + (unsigned)(32 * pw + 4 * g) * 2u; \
                _Pragma("unroll") for (int d2_ = 0; d2_ < 2; ++d2_) { if (sq_) rawqS[S_][tl_ * 2 + d2_] = *(const u32x2*)(pb_ + (ro_ + (unsigned)(colq + 16 * d2_) * 2u)); rawkS[S_][tl_ * 2 + d2_] = *(const u32x2*)(pb_ + (ro_ + (unsigned)(colk + 16 * d2_) * 2u)); } } } } while (0)
#define SCAN_GATES(S_, cc_) do { if (pw == 0) { const int ci_ = SCAN_CI(cc_); int row; SCAN_ROW(cc_, ci_ * 64 + lane, row); \
        const char* sb_ = (const char*)a.small; const unsigned so_ = (unsigned)row * 256u; \
        if (!GLA) { pre_liS[S_] = *(const float*)(sb_ + (so_ + (unsigned)(dir * 8 + h) * 4u)); pre_lfS[S_] = *(const float*)(sb_ + (so_ + (unsigned)(16 + dir * 8 + h) * 4u)); } \
        else { _Pragma("unroll") for (int i_ = 0; i_ < 4; ++i_) pre_rS[S_][i_] = *(const f32x4*)(sb_ + (so_ + (unsigned)(32 + dir * 16 + 4 * i_) * 4u)); } } } while (0)
        auto mprepass = [&](auto setc, const int fs) __attribute__((always_inline)) {
            constexpr int S = decltype(setc)::value; const float pre_li = pre_liS[S], pre_lf = pre_lfS[S];
            if (pw == 0) {
                LAS float* f = sc + SC_F + fs * 256;
                const float li = pre_li, lf = logsigmoidf_(pre_lf);
                const float bs = scan_sum64(lf);
                const float gg = li - bs; const float cm = scan_max64(gg);
                const float M = fmaxf(m_run, cm), M63 = lane63(M), b63 = lane63(bs);
                f[lane] = __expf(fminf(M63 - M, 80.f)) * 0.08838834764831845f;
                f[64 + lane] = __expf(gg - M63);
                f[128 + lane] = __expf(-(bs + M));
                if (lane == 0) f[192] = __expf(m_run - M63);
                m_run = b63 + M63;
            }
        };
        auto rwrite = [&](auto setc, const int buf) __attribute__((always_inline)) {
            constexpr int S = decltype(setc)::value;
            if (pw == 0) {
                unsigned hi[8], lo[8];
#pragma unroll
                for (int i = 0; i < 4; ++i) { const f32x4 v = pre_rS[S][i]; const unsigned h0 = cvt_pk(v[0], v[1]), h1 = cvt_pk(v[2], v[3]);
                    hi[2 * i] = h0; hi[2 * i + 1] = h1;
                    lo[2 * i] = cvt_pk(v[0] - __uint_as_float(h0 << 16), v[1] - __uint_as_float(h0 & 0xffff0000u)); lo[2 * i + 1] = cvt_pk(v[2] - __uint_as_float(h1 << 16), v[3] - __uint_as_float(h1 & 0xffff0000u)); }
                LAS unsigned char* rp = lds + L_R + buf * (64 * RSG) + lane * RSG;
                *(LAS u32x4*)rp = (u32x4){hi[0], hi[1], hi[2], hi[3]}; *(LAS u32x4*)(rp + 16) = (u32x4){hi[4], hi[5], hi[6], hi[7]};
                *(LAS u32x4*)(rp + 32) = (u32x4){lo[0], lo[1], lo[2], lo[3]}; *(LAS u32x4*)(rp + 48) = (u32x4){lo[4], lo[5], lo[6], lo[7]}; }
        };
        auto stage = [&](auto setc, const int cn) __attribute__((always_inline)) {
            constexpr int S = decltype(setc)::value;
            const bool sq = cn >= 4; const int ci = SCAN_CI(cn), T = sq ? SEQ : CTX;
            LAS unsigned char* tq = lds + L_T + (cn & 1) * 3 * TILE; LAS unsigned char* tk = tq + TILE; LAS unsigned char* tv = tq + 2 * TILE;
#pragma unroll
            for (int k = 0; k < 4; ++k) *(LAS u32x4*)(tv + ((ptid >> 4) + 16 * k) * RS + cg * 16) = rawvS[S][k];
            if (!GLA) {
                if (which || sq) {
                    const LAS float* f = sc + SC_F + (cn % 3) * 256 + (which ? 64 : 0);
                    float w0[8], w1[8], w2[8];
#define SCAN_LDW(dst, tap) do { const f32x4 x0_ = *(const LAS f32x4*)(sc + SC_CW + (tap) * 128 + cg * 8), x1_ = *(const LAS f32x4*)(sc + SC_CW + (tap) * 128 + cg * 8 + 4); \
                        dst[0] = x0_[0]; dst[1] = x0_[1]; dst[2] = x0_[2]; dst[3] = x0_[3]; dst[4] = x1_[0]; dst[5] = x1_[1]; dst[6] = x1_[2]; dst[7] = x1_[3]; } while (0)
                    SCAN_LDW(w0, which * 3 + 0); SCAN_LDW(w1, which * 3 + 1); SCAN_LDW(w2, which * 3 + 2);
#undef SCAN_LDW
                    u32x4 r0 = rawmS[S][0], r9 = rawmS[S][9];
                    if (ci * 64 + 8 * rg == 0) r0 = (u32x4){0u, 0u, 0u, 0u};
                    if (ci * 64 + 8 * rg + 8 > T - 1) r9 = (u32x4){0u, 0u, 0u, 0u};
                    float pv[8], cu[8], nx[8];
                    unpack8f(r0, pv); unpack8f(rawmS[S][1], cu);
#pragma unroll
                    for (int j = 0; j < 8; ++j) {
                        unpack8f(j == 7 ? r9 : rawmS[S][j + 2], nx);
                        const int t = 8 * rg + j;
                        const float es = f[t] * 0.6931471805599453f;
                        float x[8];
#pragma unroll
                        for (int e = 0; e < 8; ++e) { const float yl = w1[e] * cu[e] + w0[e] * pv[e] + w2[e] * nx[e];
                            x[e] = (yl * es) * __builtin_amdgcn_rcpf(1.f + __builtin_amdgcn_exp2f(-yl)); }
                        u32x4 w; w.x = cvt_pk(x[0], x[1]); w.y = cvt_pk(x[2], x[3]); w.z = cvt_pk(x[4], x[5]); w.w = cvt_pk(x[6], x[7]);
                        *(LAS u32x4*)((which ? tk : tq) + t * RS + cg * 16) = w;
#pragma unroll
                        for (int e = 0; e < 8; ++e) { pv[e] = cu[e]; cu[e] = nx[e]; }
                    }
                }
            } else {
                const int pn = cn & 1;
#pragma unroll
                for (int d2 = 0; d2 < 2; ++d2) {
                    const int dt = 2 * pw + d2;
                    const LAS unsigned char* gwb = lds + L_GW + (16 * dt + c) * RSG + 16 * (g & 1);
                    const bf16x8 A1 = *(const LAS bf16x8*)gwb, A2 = *(const LAS bf16x8*)(gwb + 32);
                    const f32x4 gbv = *(const LAS f32x4*)(sc + SC_GB + 16 * dt + 4 * g);
                    const LAS unsigned char* rb = lds + L_R + pn * (64 * RSG) + c * RSG + 16 * g;
                    f32x4 x[4];
#pragma unroll
                    for (int tl = 0; tl < 4; ++tl) {
                        const bf16x8 B = *(const LAS bf16x8*)(rb + tl * 16 * RSG);
                        f32x4 acc = __builtin_amdgcn_mfma_f32_16x16x32_bf16(A1, B, gbv, 0, 0, 0);
                        acc = __builtin_amdgcn_mfma_f32_16x16x32_bf16(A2, B, acc, 0, 0, 0);
#pragma unroll
                        for (int i = 0; i < 4; ++i) { float v = __builtin_amdgcn_logf(1.f + __builtin_amdgcn_exp2f(-fmaxf(acc[i], -115.f))) * -0.0625f;
                            v += dpp_f<0x111, 0xf>(0.f, v); v += dpp_f<0x112, 0xf>(0.f, v); v += dpp_f<0x114, 0xf>(0.f, v); v += dpp_f<0x118, 0xf>(0.f, v);
                            acc[i] = v; }
                        x[tl] = acc;
                    }
                    f32x4 off = (f32x4){0.f, 0.f, 0.f, 0.f};
#pragma unroll
                    for (int tl = 0; tl < 4; ++tl) { f32x4 tot;
#pragma unroll
                        for (int i = 0; i < 4; ++i) tot[i] = dpp_f<0x15F, 0xf>(0.f, x[tl][i]);
                        x[tl] += off; off += tot; }
                    if (c == 0) { f32x4 dec;
#pragma unroll
                        for (int i = 0; i < 4; ++i) dec[i] = __builtin_amdgcn_exp2f(off[i]);
                        *(LAS f32x4*)(sc + SC_DEC + pn * 128 + 16 * dt + 4 * g) = dec; }
                    const f32x4 offq = off + 3.5f;
#pragma unroll
                    for (int tl = 0; tl < 4; ++tl) {
                        const int t = 16 * tl + c;
                        if (sq) { const u32x2 qw = rawqS[S][tl * 2 + d2]; const f32x4 eq = x[tl] - offq;
                            const float q0 = __uint_as_float(qw.x << 16), q1 = __uint_as_float(qw.x & 0xffff0000u), q2 = __uint_as_float(qw.y << 16), q3 = __uint_as_float(qw.y & 0xffff0000u);
                            u32x2 w; w.x = cvt_pk(q0 * __builtin_amdgcn_exp2f(fminf(eq[0], 110.f)), q1 * __builtin_amdgcn_exp2f(fminf(eq[1], 110.f)));
                            w.y = cvt_pk(q2 * __builtin_amdgcn_exp2f(fminf(eq[2], 110.f)), q3 * __builtin_amdgcn_exp2f(fminf(eq[3], 110.f)));
                            *(LAS u32x2*)(tq + t * RS + (16 * dt + 4 * g) * 2) = w; }
                        { const u32x2 kw = rawkS[S][tl * 2 + d2]; const f32x4 ek = off - x[tl];
                            const float k0 = __uint_as_float(kw.x << 16), k1 = __uint_as_float(kw.x & 0xffff0000u), k2 = __uint_as_float(kw.y << 16), k3 = __uint_as_float(kw.y & 0xffff0000u);
                            u32x2 w; w.x = cvt_pk(k0 * __builtin_amdgcn_exp2f(ek[0]), k1 * __builtin_amdgcn_exp2f(ek[1])); w.y = cvt_pk(k2 * __builtin_amdgcn_exp2f(ek[2]), k3 * __builtin_amdgcn_exp2f(ek[3]));
                            *(LAS u32x2*)(tk + t * RS + (16 * dt + 4 * g) * 2) = w; }
                    }
                }
            }
        };
        auto pstep = [&](auto setc, const int cn) __attribute__((always_inline)) {
            constexpr int S = decltype(setc)::value;
            if (GLA) { rwrite(IC<S ^ 1>{}, (cn + 1) & 1); SCAN_GATES(S ^ 1, cn + 3); }
            else { mprepass(IC<S ^ 1>{}, (cn + 1) % 3); SCAN_GATES(S ^ 1, cn + 3); }
            stage(setc, cn);
            SCAN_ISSUE(S, cn + 2);
        };
        SCAN_ISSUE(0, 0); SCAN_GATES(0, 0); SCAN_ISSUE(1, 1);
        if (GLA) rwrite(IC<0>{}, 0); else mprepass(IC<0>{}, 0);
        SCAN_GATES(1, 1); SCAN_GATES(0, 2);
        __syncthreads();
        pstep(IC<0>{}, 0);
        for (int cc = 0; cc < 36; cc += 2) {
            __syncthreads();
            pstep(IC<1>{}, cc + 1);
            __syncthreads();
            __syncthreads();
            if (cc + 2 < 36) pstep(IC<0>{}, cc + 2);
            __syncthreads();
        }
        }
        __builtin_amdgcn_s_setprio(0);
#undef SCAN_ISSUE
#undef SCAN_GATES
    } else {
        f32x4 Cst[2][8]; f32x4 nst[2];
#pragma unroll
        for (int hv = 0; hv < 2; ++hv)
#pragma unroll
            for (int j = 0; j < 8; ++j) Cst[hv][j] = (f32x4){0.f, 0.f, 0.f, 0.f};
        nst[0] = (f32x4){0.f, 0.f, 0.f, 0.f}; nst[1] = (f32x4){0.f, 0.f, 0.f, 0.f};
        const int q4 = c >> 2, p4 = c & 3;
        __syncthreads();
        if (GLA) { __syncthreads(); __syncthreads(); __syncthreads(); __syncthreads(); }
        auto cchunk = [&](auto segc, const int cc) __attribute__((always_inline)) {
            constexpr int seg = decltype(segc)::value;
            const int ci = seg ? cc - 4 : cc, T = seg ? SEQ : CTX, par = cc & 1;
            const LAS unsigned char* tq = lds + L_T + par * 3 * TILE; const LAS unsigned char* tk = tq + TILE; const LAS unsigned char* tv = tq + 2 * TILE;
            const LAS float* fset = sc + SC_F + (cc % 3) * 256;
            __syncthreads();
            float dsc = 1.f;
            if (!GLA) { dsc = fset[192];
#pragma unroll
                for (int hv = 0; hv < 2; ++hv)
#pragma unroll
                    for (int j = 0; j < 8; ++j) Cst[hv][j] *= dsc;
                nst[0] *= dsc; nst[1] *= dsc;
            } else {
#pragma unroll
                for (int j = 0; j < 8; ++j) { const f32x4 dv = *(const LAS f32x4*)(sc + SC_DEC + par * 128 + 32 * (j >> 1) + 8 * g + 4 * (j & 1)); Cst[0][j] *= dv; Cst[1][j] *= dv; }
            }
            f32x4 O[2][4];
#pragma unroll
            for (int hv = 0; hv < 2; ++hv)
#pragma unroll
                for (int i = 0; i < 4; ++i) O[hv][i] = (f32x4){0.f, 0.f, 0.f, 0.f};
            bf16x8 vf[2][2], fa[4], fb[4];
#define SCAN_QFRAG(l4_, kk_) (*(const LAS bf16x8*)(tq + (16 * (l4_) + c) * RS + (32 * (kk_) + 8 * g) * 2))
#define SCAN_KROW(st_, kk_) (*(const LAS bf16x8*)(tk + (16 * (st_) + c) * RS + (32 * (kk_) + 8 * g) * 2))
#define SCAN_KT(dst, j_, tt_) do { const LAS unsigned char* kp_ = tk + (32 * (tt_) + 8 * g + q4) * RS + (32 * ((j_) >> 1) + 8 * p4 + 4 * ((j_) & 1)) * 2; dst = cat4(tr16(kp_), tr16(kp_ + 4 * RS)); } while (0)
#define SCAN_SB() __builtin_amdgcn_sched_barrier(0)
#define SCAN_VF() do { _Pragma("unroll") for (int hv = 0; hv < 2; ++hv) _Pragma("unroll") for (int tt = 0; tt < 2; ++tt) { \
                const LAS unsigned char* vp = tv + (32 * tt + 8 * g + q4) * RS + (32 * wid + 16 * hv + 4 * p4) * 2; vf[hv][tt] = cat4(tr16(vp), tr16(vp + 4 * RS)); } } while (0)
            if constexpr (seg != 0) {
                if (!GLA) {
                    const int l = tid >> 2, part = tid & 3; const LAS unsigned char* qp = tq + l * RS + part * 64; const LAS float* np = sc + SC_N + par * 128 + part * 32;
                    float s = 0.f;
#pragma unroll
                    for (int hq = 0; hq < 2; ++hq) { float q[16]; unpack8f(*(const LAS u32x4*)(qp + 32 * hq), q); unpack8f(*(const LAS u32x4*)(qp + 32 * hq + 16), q + 8);
#pragma unroll
                        for (int i = 0; i < 4; ++i) { const f32x4 nv = *(const LAS f32x4*)(np + 16 * hq + 4 * i); s += q[4 * i] * nv[0] + q[4 * i + 1] * nv[1] + q[4 * i + 2] * nv[2] + q[4 * i + 3] * nv[3]; } }
                    s += __shfl_xor(s, 1); s += __shfl_xor(s, 2);
                    if (part == 0) sc[SC_QN + l] = s * dsc;
                }
                const int lt = wid;
                bf16x8 qf[4];
#pragma unroll
                for (int kk = 0; kk < 4; ++kk) qf[kk] = SCAN_QFRAG(lt, kk);
#pragma unroll
                for (int kk = 0; kk < 4; ++kk) fa[kk] = SCAN_KROW(0, kk);
#pragma unroll
                for (int kk = 0; kk < 4; ++kk) fb[kk] = SCAN_KROW(1, kk);
                SCAN_SB();
                f32x4 accs[4];
#pragma unroll
                for (int i = 0; i < 4; ++i) accs[i] = (f32x4){0.f, 0.f, 0.f, 0.f};
#pragma unroll
                for (int kk = 0; kk < 4; ++kk) accs[0] = __builtin_amdgcn_mfma_f32_16x16x32_bf16(fa[kk], qf[kk], accs[0], 0, 0, 0);
                SCAN_SB();
#pragma unroll
                for (int kk = 0; kk < 4; ++kk) fa[kk] = SCAN_KROW(2, kk);
#pragma unroll
                for (int kk = 0; kk < 4; ++kk) accs[1] = __builtin_amdgcn_mfma_f32_16x16x32_bf16(fb[kk], qf[kk], accs[1], 0, 0, 0);
                SCAN_SB();
#pragma unroll
                for (int kk = 0; kk < 4; ++kk) fb[kk] = SCAN_KROW(3, kk);
#pragma unroll
                for (int kk = 0; kk < 4; ++kk) accs[2] = __builtin_amdgcn_mfma_f32_16x16x32_bf16(fa[kk], qf[kk], accs[2], 0, 0, 0);
                SCAN_SB();
#pragma unroll
                for (int i = 0; i < 4; ++i) fa[i] = SCAN_QFRAG(i, 0);
#pragma unroll
                for (int kk = 0; kk < 4; ++kk) accs[3] = __builtin_amdgcn_mfma_f32_16x16x32_bf16(fb[kk], qf[kk], accs[3], 0, 0, 0);
                SCAN_SB();
#pragma unroll
                for (int i = 0; i < 4; ++i) fb[i] = SCAN_QFRAG(i, 1);
                float rs = 0.f;
#pragma unroll
                for (int st = 0; st < 4; ++st) { f32x4 acc = accs[st];
                    int lim = st < lt ? 64 : (st == lt ? c : -1); asm volatile("" : "+v"(lim));
#pragma unroll
                    for (int i = 0; i < 4; ++i) acc[i] = (4 * g + i > lim) ? 0.f : acc[i];
                    rs += (acc[0] + acc[1]) + (acc[2] + acc[3]);
                    u32x2 w; w.x = cvt_pk(acc[0], acc[1]); w.y = cvt_pk(acc[2], acc[3]);
                    *(LAS u32x2*)(lds + L_P + (16 * lt + c) * RSP + (16 * st + 4 * g) * 2) = w;
                }
                if (!GLA) { rs += __shfl_xor(rs, 16); rs += __shfl_xor(rs, 32); if (g == 0) sc[SC_RS + 16 * lt + c] = rs; }
#define SCAN_CF(dst, hv_, kk_) do { u32x4 bw_; bw_.x = cvt_pk(Cst[hv_][2 * (kk_)][0], Cst[hv_][2 * (kk_)][1]); bw_.y = cvt_pk(Cst[hv_][2 * (kk_)][2], Cst[hv_][2 * (kk_)][3]); \
                    bw_.z = cvt_pk(Cst[hv_][2 * (kk_) + 1][0], Cst[hv_][2 * (kk_) + 1][1]); bw_.w = cvt_pk(Cst[hv_][2 * (kk_) + 1][2], Cst[hv_][2 * (kk_) + 1][3]); dst = __builtin_bit_cast(bf16x8, bw_); } while (0)
#define SCAN_2B(fr, kk_) do { bf16x8 c0_, c1_; SCAN_CF(c0_, 0, kk_); SCAN_CF(c1_, 1, kk_); \
                    _Pragma("unroll") for (int i = 0; i < 4; ++i) { O[0][i] = __builtin_amdgcn_mfma_f32_16x16x32_bf16(c0_, fr[i], O[0][i], 0, 0, 0); O[1][i] = __builtin_amdgcn_mfma_f32_16x16x32_bf16(c1_, fr[i], O[1][i], 0, 0, 0); } } while (0)
                SCAN_SB();
                SCAN_2B(fa, 0);
#pragma unroll
                for (int i = 0; i < 4; ++i) fa[i] = SCAN_QFRAG(i, 2);
                SCAN_SB();
                SCAN_2B(fb, 1);
#pragma unroll
                for (int i = 0; i < 4; ++i) fb[i] = SCAN_QFRAG(i, 3);
                SCAN_SB();
                SCAN_2B(fa, 2);
                SCAN_VF();
#pragma unroll
                for (int i = 0; i < 4; ++i) SCAN_KT(fa[i], i >> 1, i & 1);
                SCAN_SB();
                SCAN_2B(fb, 3);
#undef SCAN_2B
#undef SCAN_CF
            } else {
                SCAN_VF();
#pragma unroll
                for (int i = 0; i < 4; ++i) SCAN_KT(fa[i], i >> 1, i & 1);
            }
#define SCAN_3(fr, j0_) do { _Pragma("unroll") for (int i = 0; i < 4; ++i) { Cst[0][(j0_) + (i >> 1)] = __builtin_amdgcn_mfma_f32_16x16x32_bf16(fr[i], vf[0][i & 1], Cst[0][(j0_) + (i >> 1)], 0, 0, 0); \
                Cst[1][(j0_) + (i >> 1)] = __builtin_amdgcn_mfma_f32_16x16x32_bf16(fr[i], vf[1][i & 1], Cst[1][(j0_) + (i >> 1)], 0, 0, 0); } } while (0)
#pragma unroll
            for (int i = 0; i < 4; ++i) SCAN_KT(fb[i], 2 + (i >> 1), i & 1);
            SCAN_SB();
            SCAN_3(fa, 0);
#pragma unroll
            for (int i = 0; i < 4; ++i) SCAN_KT(fa[i], 4 + (i >> 1), i & 1);
            SCAN_SB();
            SCAN_3(fb, 2);
#pragma unroll
            for (int i = 0; i < 4; ++i) SCAN_KT(fb[i], 6 + (i >> 1), i & 1);
            SCAN_SB();
            SCAN_3(fa, 4);
            if (!GLA) {
#pragma unroll
                for (int i = 0; i < 4; ++i) SCAN_KT(fa[i], 2 * wid + (i >> 1), i & 1);
            }
            SCAN_SB();
            SCAN_3(fb, 6);
#undef SCAN_3
            if (!GLA) {
                const bf16x8 ones = (bf16x8){0x3F80, 0x3F80, 0x3F80, 0x3F80, 0x3F80, 0x3F80, 0x3F80, 0x3F80};
#pragma unroll
                for (int i = 0; i < 4; ++i) nst[i >> 1] = __builtin_amdgcn_mfma_f32_16x16x32_bf16(fa[i], ones, nst[i >> 1], 0, 0, 0);
                if (c == 0) {
#pragma unroll
                    for (int j2 = 0; j2 < 2; ++j2) *(LAS f32x4*)(sc + SC_N + (par ^ 1) * 128 + 32 * wid + 8 * g + 4 * j2) = nst[j2]; }
            }
            __syncthreads();
            if constexpr (seg != 0) {
#pragma unroll
                for (int i = 0; i < 4; ++i) fa[i] = *(const LAS bf16x8*)(lds + L_P + (16 * (i >> 1) + c) * RSP + (32 * (i & 1) + 8 * g) * 2);
#pragma unroll
                for (int i = 0; i < 4; ++i) fb[i] = *(const LAS bf16x8*)(lds + L_P + (16 * (2 + (i >> 1)) + c) * RSP + (32 * (i & 1) + 8 * g) * 2);
                SCAN_SB();
#pragma unroll
                for (int i = 0; i < 4; ++i) { O[0][i >> 1] = __builtin_amdgcn_mfma_f32_16x16x32_bf16(vf[0][i & 1], fa[i], O[0][i >> 1], 0, 0, 0); O[1][i >> 1] = __builtin_amdgcn_mfma_f32_16x16x32_bf16(vf[1][i & 1], fa[i], O[1][i >> 1], 0, 0, 0); }
#pragma unroll
                for (int i = 0; i < 4; ++i) { O[0][2 + (i >> 1)] = __builtin_amdgcn_mfma_f32_16x16x32_bf16(vf[0][i & 1], fb[i], O[0][2 + (i >> 1)], 0, 0, 0); O[1][2 + (i >> 1)] = __builtin_amdgcn_mfma_f32_16x16x32_bf16(vf[1][i & 1], fb[i], O[1][2 + (i >> 1)], 0, 0, 0); }
#pragma unroll
                for (int l4 = 0; l4 < 4; ++l4) {
                    const int l = 16 * l4 + c; float rc = 1.f; asm volatile("" : "+v"(rc));
                    if (!GLA) { const float den = fmaxf(fabsf(sc[SC_QN + l] + sc[SC_RS + l]), fset[128 + l]); rc = __builtin_amdgcn_rcpf(den); }
                    const int pp = ci * 64 + l; const int t = dir ? (T - 1 - pp) : pp;
                    const f32x4 oa = O[0][l4] * rc, ob = O[1][l4] * rc;
                    const unsigned a0 = cvt_pk(oa[0], oa[1]), a1 = cvt_pk(oa[2], oa[3]), b0 = cvt_pk(ob[0], ob[1]), b1 = cvt_pk(ob[2], ob[3]);
                    const u32x2 s0 = __builtin_amdgcn_permlane16_swap(a0, b0, false, false), s1 = __builtin_amdgcn_permlane16_swap(a1, b1, false, false);
                    *(u32x4*)((char*)hout + ((unsigned)((b * SEQ + t) * DM + ocol + 32 * wid + 16 * (g & 1) + 8 * (g >> 1)) * 2u)) = (u32x4){s0[0], s1[0], s0[1], s1[1]};
                }
            }
#undef SCAN_QFRAG
#undef SCAN_KROW
#undef SCAN_KT
#undef SCAN_SB
#undef SCAN_VF
        };
        for (int cc = 0; cc < 4; ++cc) cchunk(IC<0>{}, cc);
        for (int cc = 4; cc < 36; ++cc) cchunk(IC<1>{}, cc);
    }
#undef SCAN_ROW
#undef SCAN_CI
}
#undef LAS
}

#include <hip/hip_cooperative_groups.h>
namespace cg = cooperative_groups;
#define LAS __attribute__((address_space(3)))
constexpr int NBLK = 256, NTHR = 512;
constexpr int MISC_OFF = scan::LDS_BYTES > pg8::STAGE_BYTES ? scan::LDS_BYTES : pg8::STAGE_BYTES;
constexpr int MEGA_LDS = MISC_OFF + 64;
constexpr int CW_LN = 16384;
constexpr size_t WS_LNX = 2 * MiB;
constexpr int CW_GX = 32768;
constexpr size_t BIG_GX = 130 * MiB;
constexpr int CW_RANK = 8192;
constexpr int CW_BAR = 4096;
constexpr size_t WS_MODP = 502 * MiB;
struct Params { const float* in[28]; float* out; unsigned char* ws; };
typedef float f32x4v __attribute__((ext_vector_type(4)));
typedef unsigned u32x4v __attribute__((ext_vector_type(4)));

__device__ __forceinline__ void ph_prologue(const Params& p, LAS unsigned char* lds, int c) {
    int tid = threadIdx.x; asm volatile("" : "+v"(tid));
    unsigned char* ws = p.ws;
    LAS float* t = (LAS float*)lds;
    auto wdec = [&](const int it, const float*& s0, const float*& s1, bf16_t*& dp) __attribute__((always_inline)) {
        const float* W; bf16_t* Wt; int ldw, K, srcA, srcB, dst, kb, tl = it;
        if (tl < 2320) { W = p.in[6]; Wt = (bf16_t*)(ws + WS_WIN); ldw = NIN; K = DM; kb = tl / 145; const int nt = tl - kb * 145; int jn;
            if (nt < 48) { srcA = 64 * nt; dst = 64 * nt; }
            else if (nt == 48) { srcA = 4096; dst = 3072; }
            else if ((jn = nt - 49) < 8) { srcA = 4128 + 64 * jn; dst = 3328 + 64 * jn; }
            else if ((jn = nt - 57) < 8) { srcA = 4640 + 64 * jn; dst = 3840 + 64 * jn; }
            else if ((jn = nt - 65) < 16) { srcA = 5152 + 64 * jn; dst = 4352 + 64 * jn; }
            else if ((jn = nt - 81) < 16) { srcA = 3072 + 64 * jn; dst = 5376 + 64 * jn; }
            else if ((jn = nt - 97) < 16) { srcA = 6176 + 64 * jn; dst = 6400 + 64 * jn; }
            else if ((jn = nt - 113) < 16) { srcA = 7232 + 64 * jn; dst = 7424 + 64 * jn; }
            else { jn = nt - 129; srcA = 8256 + 64 * jn; dst = 8448 + 64 * jn; }
            srcB = nt == 48 ? 7200 : srcA + 32; }
        else { int ntn;
            if ((tl -= 2320) < 256) { W = p.in[15]; Wt = (bf16_t*)(ws + WS_WBM); ldw = DM; K = DM; ntn = 16; }
            else if ((tl -= 256) < 256) { W = p.in[16]; Wt = (bf16_t*)(ws + WS_WBG); ldw = DM; K = DM; ntn = 16; }
            else if ((tl -= 256) < 256) { W = p.in[17]; Wt = (bf16_t*)(ws + WS_WOUT); ldw = DM; K = DM; ntn = 16; }
            else if ((tl -= 256) < 1408) { W = p.in[20]; Wt = (bf16_t*)(ws + WS_WUP); ldw = 2 * DFF; K = DM; ntn = 88; }
            else { tl -= 1408; W = p.in[24]; Wt = (bf16_t*)(ws + WS_WDN); ldw = DM; K = DFF; ntn = 16; }
            kb = tl / ntn; srcA = 64 * (tl - kb * ntn); srcB = srcA + 32; dst = srcA; }
        const int k0 = kb * 64, n = 4 * (tid & 15), kk = tid >> 4;
        const float* sp = W + (size_t)(k0 + kk) * ldw + (n < 32 ? srcA + n : srcB + n - 32);
        s0 = sp; s1 = sp + (size_t)32 * ldw;
        dp = Wt + (size_t)(dst + (tid >> 3)) * K + k0 + 8 * (tid & 7);
    };
    { const float* s0; const float* s1; bf16_t* dp; f32x4v pv0 = (f32x4v){0.f, 0.f, 0.f, 0.f}, pv1 = pv0;
      if (c < 5200) { wdec(c, s0, s1, dp); pv0 = *(const f32x4v*)s0; pv1 = *(const f32x4v*)s1; }
      int ib = 0;
      for (int it = c; it < 5200; it += NBLK, ++ib) {
        bf16_t* dcur = dp; const f32x4v v0 = pv0, v1 = pv1; LAS float* tb = t + (ib & 1) * (64 * 65);
        if (it + NBLK < 5200) { wdec(it + NBLK, s0, s1, dp); pv0 = *(const f32x4v*)s0; pv1 = *(const f32x4v*)s1; }
        { const int k = tid >> 4, n = 4 * (tid & 15);
          tb[k * 65 + n] = v0[0]; tb[k * 65 + n + 1] = v0[1]; tb[k * 65 + n + 2] = v0[2]; tb[k * 65 + n + 3] = v0[3];
          tb[(k + 32) * 65 + n] = v1[0]; tb[(k + 32) * 65 + n + 1] = v1[1]; tb[(k + 32) * 65 + n + 2] = v1[2]; tb[(k + 32) * 65 + n + 3] = v1[3]; }
        __syncthreads();
        { const int n = tid >> 3, kq = tid & 7; const LAS float* tp = tb + (8 * kq) * 65 + n;
          u32x4v o; o.x = scan::cvt_pk(tp[0], tp[65]); o.y = scan::cvt_pk(tp[130], tp[195]); o.z = scan::cvt_pk(tp[260], tp[325]); o.w = scan::cvt_pk(tp[390], tp[455]);
          *(u32x4v*)dcur = o; }
      }
      __syncthreads(); }
    { u32x4v* z = (u32x4v*)((bf16_t*)(ws + WS_WIN) + (size_t)3136 * DM);
      for (int i = c * NTHR + tid; i < 24576; i += NBLK * NTHR) z[i] = (u32x4v){0u, 0u, 0u, 0u}; }
    { float* bp = (float*)(ws + WS_BIN); const float* b_in = p.in[7];
      for (int j = c * NTHR + tid; j < NINP; j += NBLK * NTHR) { int s;
        if (j < 3072) s = j; else if (j < 3104) s = 4096 + (j - 3072); else if (j < 3136) s = 7200 + (j - 3104); else if (j < 3328) s = -1;
        else if (j < 3840) s = 4128 + (j - 3328); else if (j < 4352) s = 4640 + (j - 3840); else if (j < 5376) s = 5152 + (j - 4352);
        else if (j < 6400) s = 3072 + (j - 5376); else if (j < 7424) s = 6176 + (j - 6400); else if (j < 8448) s = 7232 + (j - 7424); else s = 8256 + (j - 8448);
        bp[j] = s >= 0 ? b_in[s] : 0.f; } }
    for (int item = c; item < 192; item += NBLK) {
        const int cb = item % 12, ks = item / 12; LAS float* sl = (LAS float*)lds;
        for (int i = tid; i < 17 * 64; i += NTHR) { const int r = i >> 6, k = i & 63; const float cv = r < 16 ? p.in[1][r * DM + ks * 64 + k] : p.in[3][ks * 64 + k]; sl[i] = siluf_(cv); }
        __syncthreads();
        const int col = cb * 512 + tid; float acc[17];
#pragma unroll
        for (int r = 0; r < 17; ++r) acc[r] = 0.f;
        const float* wm = p.in[4] + (size_t)(ks * 64) * 6144 + col;
        for (int k = 0; k < 64; ++k) { const float w = wm[(size_t)k * 6144];
#pragma unroll
            for (int r = 0; r < 17; ++r) acc[r] += sl[r * 64 + k] * w; }
        float* mp = (float*)(ws + WS_MODP) + (size_t)ks * 17 * 6144 + col;
#pragma unroll
        for (int r = 0; r < 17; ++r) mp[(size_t)r * 6144] = acc[r];
        __syncthreads();
    }
}
__device__ __forceinline__ void ph_modulate(const Params& p, LAS unsigned char* lds, int c) {
    int tid = threadIdx.x; asm volatile("" : "+v"(tid)); const int lane = tid & 63, wid = tid >> 6;
    const float* modp = (const float*)(p.ws + WS_MODP); const float* b_mod = p.in[5];
    float* modv = (float*)(p.ws + WS_MOD);
    { const bf16_t* Ws = (const bf16_t*)(p.ws + WS_WIN) + (size_t)3072 * DM; LAS unsigned char* wl = lds + 8192;
#pragma unroll
      for (int h2 = 0; h2 < 2; ++h2) { u32x4v wv[8];
#pragma unroll
          for (int k = 0; k < 8; ++k) { const int i = tid + NTHR * (8 * h2 + k), r = i >> 7, pc = i & 127; wv[k] = *(const u32x4v*)(Ws + (size_t)r * DM + pc * 8); }
#pragma unroll
          for (int k = 0; k < 8; ++k) { const int i = tid + NTHR * (8 * h2 + k), r = i >> 7, pc = i & 127; *(LAS u32x4v*)(wl + r * 2064 + pc * 16) = wv[k]; } } }
    for (int e = tid; e < 408; e += NTHR) { const int idx = c * 408 + e, r = idx / 6144, j = idx - r * 6144; float s = b_mod[j];
#pragma unroll
        for (int ks = 0; ks < 16; ++ks) s += modp[((size_t)ks * 17 + r) * 6144 + j];
        modv[idx] = s; }
    LAS float* mv = (LAS float*)lds;
    bf16_t* U = (bf16_t*)(p.ws + WS_U) ;
    for (int pass = 0; pass < 2; ++pass) {
        const int b = pass ? 16 : c >> 4;
        __syncthreads();
        for (int j = tid; j < 2048; j += NTHR) { float s = b_mod[j];
#pragma unroll
            for (int ks = 0; ks < 16; ++ks) s += modp[((size_t)ks * 17 + b) * 6144 + j];
            mv[j] = s; }
        __syncthreads();
        f32x4v shv[4], scv[4];
#pragma unroll
        for (int i = 0; i < 4; ++i) { const int d = i * 256 + lane * 4; shv[i] = *(const LAS f32x4v*)(mv + d); scv[i] = *(const LAS f32x4v*)(mv + 1024 + d) + 1.f; }
        const int nrow = pass ? 16 : 128;
        for (int r0 = wid; r0 < nrow; r0 += 32) {
            f32x4v v[4][4];
#pragma unroll
            for (int k = 0; k < 4; ++k) { const int rr = r0 + 8 * k; if (rr < nrow) { const float* src = pass ? p.in[2] + (size_t)(16 * c + rr) * DM : p.in[0] + (size_t)(128 * c + rr) * DM;
#pragma unroll
                for (int i = 0; i < 4; ++i) v[k][i] = *(const f32x4v*)(src + i * 256 + lane * 4); } }
#pragma unroll
            for (int k = 0; k < 4; ++k) { const int rr = r0 + 8 * k; if (rr < nrow) { const int row = pass ? ML + 16 * c + rr : 128 * c + rr;
#pragma unroll
                for (int i = 0; i < 4; ++i) { const f32x4v w = v[k][i] * scv[i] + shv[i];
                    uint2 o; o.x = scan::cvt_pk(w[0], w[1]); o.y = scan::cvt_pk(w[2], w[3]);
                    *(uint2*)(U + (size_t)row * DM + i * 256 + lane * 4) = o; } } }
        }
    }
    asm volatile("s_waitcnt vmcnt(0)" ::: "memory");
    __syncthreads();
    { LAS unsigned char* wl = lds + 8192;
      int c16 = lane & 15, g4 = lane >> 4; asm volatile("" : "+v"(c16), "+v"(g4));
      const float* bsm = (const float*)(p.ws + WS_BIN) + 3072; char* smb = (char*)(p.ws + WS_BIG + BIG_SMALL); const char* ub = (const char*)U;
      const LAS unsigned char* wlb = wl + c16 * 2064 + g4 * 16;
      const unsigned ao = (unsigned)((128 * c + 16 * wid + c16) * DM + 8 * g4) * 2u, aoc = (unsigned)((ML + 16 * c + c16) * DM + 8 * g4) * 2u + (unsigned)(256 * wid);
      scan::bf16x8 fa[32], fc[4];
#pragma unroll
      for (int u = 0; u < 32; ++u) fa[u] = *(const scan::bf16x8*)(ub + (ao + (unsigned)(64 * u)));
#pragma unroll
      for (int u = 0; u < 4; ++u) fc[u] = *(const scan::bf16x8*)(ub + (aoc + (unsigned)(64 * u)));
      f32x4v acc[4], accc[4];
#pragma unroll
      for (int nt = 0; nt < 4; ++nt) { const float bz = bsm[16 * nt + c16]; acc[nt] = (f32x4v){bz, bz, bz, bz}; accc[nt] = (f32x4v){0.f, 0.f, 0.f, 0.f}; }
#pragma unroll
      for (int u = 0; u < 32; ++u)
#pragma unroll
          for (int nt = 0; nt < 4; ++nt) { const scan::bf16x8 bf = *(const LAS scan::bf16x8*)(wlb + nt * 16 * 2064 + 64 * u);
              acc[nt] = __builtin_amdgcn_mfma_f32_16x16x32_bf16(fa[u], bf, acc[nt], 0, 0, 0); }
#pragma unroll
      for (int u = 0; u < 4; ++u)
#pragma unroll
          for (int nt = 0; nt < 4; ++nt) { const scan::bf16x8 bf = *(const LAS scan::bf16x8*)(wlb + nt * 16 * 2064 + 64 * (4 * wid + u));
              accc[nt] = __builtin_amdgcn_mfma_f32_16x16x32_bf16(fc[u], bf, accc[nt], 0, 0, 0); }
      { const unsigned so = (unsigned)((128 * c + 16 * wid + 4 * g4) * 64 + c16) * 4u;
#pragma unroll
        for (int nt = 0; nt < 4; ++nt)
#pragma unroll
            for (int i = 0; i < 4; ++i) *(float*)(smb + (so + (unsigned)((i * 64 + 16 * nt) * 4))) = acc[nt][i]; }
      __syncthreads();
      LAS float* part = (LAS float*)wl;
#pragma unroll
      for (int nt = 0; nt < 4; ++nt)
#pragma unroll
          for (int i = 0; i < 4; ++i) part[(wid * 16 + 4 * g4 + i) * 64 + 16 * nt + c16] = accc[nt][i];
      __syncthreads();
#pragma unroll
      for (int o2 = 0; o2 < 2; ++o2) { const int o = tid + 512 * o2, row = o >> 6, col = o & 63; float sacc = bsm[col];
#pragma unroll
          for (int w = 0; w < 8; ++w) sacc += part[(w * 16 + row) * 64 + col];
          *(float*)(smb + (unsigned)((ML + 16 * c + row) * 64 + col) * 4u) = sacc; }
    }
}
__device__ __forceinline__ void aprep_unpack16(u32x4v a, u32x4v b, float* v) {
    v[0] = __uint_as_float(a.x << 16); v[1] = __uint_as_float(a.x & 0xffff0000u); v[2] = __uint_as_float(a.y << 16); v[3] = __uint_as_float(a.y & 0xffff0000u);
    v[4] = __uint_as_float(a.z << 16); v[5] = __uint_as_float(a.z & 0xffff0000u); v[6] = __uint_as_float(a.w << 16); v[7] = __uint_as_float(a.w & 0xffff0000u);
    v[8] = __uint_as_float(b.x << 16); v[9] = __uint_as_float(b.x & 0xffff0000u); v[10] = __uint_as_float(b.y << 16); v[11] = __uint_as_float(b.y & 0xffff0000u);
    v[12] = __uint_as_float(b.z << 16); v[13] = __uint_as_float(b.z & 0xffff0000u); v[14] = __uint_as_float(b.w << 16); v[15] = __uint_as_float(b.w & 0xffff0000u); }
__device__ __forceinline__ void ph_aprep(const Params& p, int c) {
    int tid = threadIdx.x; asm volatile("" : "+v"(tid)); const int lane = tid & 63, wid = tid >> 6;
    bf16_t* hm = (bf16_t*)p.out; bf16_t* hg = (bf16_t*)(p.ws + WS_BIG + BIG_HG); const bf16_t* side = (const bf16_t*)(p.ws + WS_BIG + BIG_SIDE);
    float gmv[16], ggv[16];
#pragma unroll
    for (int i = 0; i < 4; ++i) { const f32x4v a = *(const f32x4v*)(p.in[13] + lane * 16 + 4 * i), b = *(const f32x4v*)(p.in[14] + lane * 16 + 4 * i);
        gmv[4 * i] = a[0]; gmv[4 * i + 1] = a[1]; gmv[4 * i + 2] = a[2]; gmv[4 * i + 3] = a[3]; ggv[4 * i] = b[0]; ggv[4 * i + 1] = b[1]; ggv[4 * i + 2] = b[2]; ggv[4 * i + 3] = b[3]; }
    u32x4v raw[2][12];
#define APREP_LD(buf, rq_) do { const int row_ = c * 128 + 8 * (rq_) + wid; const size_t o_ = (size_t)row_ * DM + lane * 16; const bf16_t* sp_ = side + (size_t)row_ * 4096 + lane * 16; \
        raw[buf][0] = *(const u32x4v*)(hm + o_); raw[buf][1] = *(const u32x4v*)(hm + o_ + 8); raw[buf][2] = *(const u32x4v*)(hm + o_ + (size_t)ML * DM); raw[buf][3] = *(const u32x4v*)(hm + o_ + (size_t)ML * DM + 8); \
        raw[buf][4] = *(const u32x4v*)sp_; raw[buf][5] = *(const u32x4v*)(sp_ + 8); \
        raw[buf][6] = *(const u32x4v*)(hg + o_); raw[buf][7] = *(const u32x4v*)(hg + o_ + 8); raw[buf][8] = *(const u32x4v*)(hg + o_ + (size_t)ML * DM); raw[buf][9] = *(const u32x4v*)(hg + o_ + (size_t)ML * DM + 8); \
        raw[buf][10] = *(const u32x4v*)(sp_ + 1024); raw[buf][11] = *(const u32x4v*)(sp_ + 1024 + 8); } while (0)
    APREP_LD(0, 0);
    for (int rq2 = 0; rq2 < 16; rq2 += 2) {
#pragma unroll
        for (int u = 0; u < 2; ++u) {
            const int rq = rq2 + u; const int row = c * 128 + 8 * rq + wid; const size_t o = (size_t)row * DM + lane * 16;
            if (rq + 1 < 16) APREP_LD(u ^ 1, rq + 1);
            float v[16], w[16], g[16];
            { aprep_unpack16(raw[u][0], raw[u][1], v); aprep_unpack16(raw[u][2], raw[u][3], w); aprep_unpack16(raw[u][4], raw[u][5], g);
              float s = 0.f;
#pragma unroll
              for (int i = 0; i < 16; ++i) { v[i] += w[i]; s += v[i]; }
              s += __shfl_xor(s, 1); s += __shfl_xor(s, 2); s += __shfl_xor(s, 4);
              const float mean = s * (1.f / 128.f); float q = 0.f;
#pragma unroll
              for (int i = 0; i < 16; ++i) { v[i] -= mean; q += v[i] * v[i]; }
              q += __shfl_xor(q, 1); q += __shfl_xor(q, 2); q += __shfl_xor(q, 4);
              const float rstd = rsqrtf(q * (1.f / 128.f) + EPS);
              unsigned ow[8];
#pragma unroll
              for (int e = 0; e < 16; e += 2) ow[e >> 1] = scan::cvt_pk(v[e] * rstd * gmv[e] * sigmoidf_(g[e]), v[e + 1] * rstd * gmv[e + 1] * sigmoidf_(g[e + 1]));
              *(u32x4v*)(hm + o) = (u32x4v){ow[0], ow[1], ow[2], ow[3]}; *(u32x4v*)(hm + o + 8) = (u32x4v){ow[4], ow[5], ow[6], ow[7]}; }
            { aprep_unpack16(raw[u][6], raw[u][7], v); aprep_unpack16(raw[u][8], raw[u][9], w); aprep_unpack16(raw[u][10], raw[u][11], g);
              float q = 0.f;
#pragma unroll
              for (int i = 0; i < 16; ++i) { v[i] += w[i]; q += v[i] * v[i]; }
              q += __shfl_xor(q, 1); q += __shfl_xor(q, 2); q += __shfl_xor(q, 4); q += __shfl_xor(q, 8);
              const float rstd = rsqrtf(q * (1.f / 256.f) + EPS);
              unsigned ow[8];
#pragma unroll
              for (int e = 0; e < 16; e += 2) ow[e >> 1] = scan::cvt_pk(v[e] * rstd * ggv[e] * siluf_(g[e]), v[e + 1] * rstd * ggv[e + 1] * siluf_(g[e + 1]));
              *(u32x4v*)(hg + o) = (u32x4v){ow[0], ow[1], ow[2], ow[3]}; *(u32x4v*)(hg + o + 8) = (u32x4v){ow[4], ow[5], ow[6], ow[7]}; }
        }
    }
#undef APREP_LD
}
template <int MODE>
__device__ __forceinline__ void ph_ln(const Params& p, int c) {
    int tid = threadIdx.x; asm volatile("" : "+v"(tid)); const int lane = tid & 63, wid = tid >> 6;
    const float* g = MODE == 1 ? p.in[18] : p.in[26]; const float* bta = MODE == 1 ? p.in[19] : p.in[27];
    const float* mv = (const float*)(p.ws + WS_MOD) + (c * 128 / SEQ) * 6144; bf16_t* u2 = (bf16_t*)(p.ws + WS_U);
    f32x4v vn[4];
#pragma unroll
    for (int j = 0; j < 4; ++j) vn[j] = *(const f32x4v*)(p.out + (size_t)(c * 128 + wid) * DM + j * 256 + lane * 4);
    for (int rr = wid; rr < 128; rr += 8) {
        const int row = c * 128 + rr; float* ptr = p.out + (size_t)row * DM;
        f32x4v v[4]; float s = 0.f;
#pragma unroll
        for (int j = 0; j < 4; ++j) { v[j] = vn[j]; s += (v[j][0] + v[j][1]) + (v[j][2] + v[j][3]); }
        if (rr + 8 < 128) {
#pragma unroll
            for (int j = 0; j < 4; ++j) vn[j] = *(const f32x4v*)(ptr + (size_t)8 * DM + j * 256 + lane * 4); }
        const float mean = wave_sum(s) * (1.f / DM); float q = 0.f;
#pragma unroll
        for (int j = 0; j < 4; ++j) { v[j] = v[j] - mean; q += (v[j][0] * v[j][0] + v[j][1] * v[j][1]) + (v[j][2] * v[j][2] + v[j][3] * v[j][3]); }
        const float rstd = rsqrtf(wave_sum(q) * (1.f / DM) + EPS);
#pragma unroll
        for (int j = 0; j < 4; ++j) { const int cc = j * 256 + lane * 4; const f32x4v o = v[j] * rstd * *(const f32x4v*)(g + cc) + *(const f32x4v*)(bta + cc);
            *(f32x4v*)(ptr + cc) = o;
            if (MODE == 1) { const f32x4v sh = *(const f32x4v*)(mv + 3072 + cc), sc = *(const f32x4v*)(mv + 4096 + cc); const f32x4v w = o * (sc + 1.f) + sh;
                uint2 ww; ww.x = scan::cvt_pk(w[0], w[1]); ww.y = scan::cvt_pk(w[2], w[3]); *(uint2*)(u2 + (size_t)row * DM + cc) = ww; } }
    }
}
__device__ __forceinline__ void ph_convglu(const Params& p, LAS unsigned char* lds, int c) {
    int tid = threadIdx.x; asm volatile("" : "+v"(tid));
    const bf16_t* gate = (const bf16_t*)(p.ws + WS_BIG + BIG_GATE); bf16_t* val = (bf16_t*)(p.ws + WS_BIG + BIG_VAL);
    LAS float* cw = (LAS float*)lds;
    for (int i = tid; i < 9 * DFF; i += NTHR) cw[i] = p.in[22][i];
    for (int i = tid; i < DFF; i += NTHR) cw[9 * DFF + i] = p.in[23][i];
    __syncthreads();
    const int b = c >> 4, rimg0 = (c & 15) * 2;
    for (int rnd = 0; rnd < 6; ++rnd) {
        const int wv = tid >> 6, wi = rnd < 5 ? wv + 8 * rnd : 40 + (wv >> 1), cofs = rnd < 5 ? 0 : 8 * (wv & 1), nq = rnd < 5 ? 4 : 2;
        const int cs = wi / 11, grp = wi - cs * 11, rsel = (tid >> 5) & 1, cgp = 32 * grp + (tid & 31), ch = cgp * 8;
        const int r = rimg0 + rsel, col0 = 16 * cs + cofs;
        const bool up = r > 0, dn = r < SEQ / GW - 1;
        const bf16_t* g0 = gate + ((size_t)b * SEQ + r * GW) * DFF + ch;
        const bf16_t* gu = up ? g0 - (size_t)GW * DFF : g0; const bf16_t* gd = dn ? g0 + (size_t)GW * DFF : g0;
        bf16_t* v0 = val + ((size_t)c * 128 + rsel * 64 + col0) * DFF + ch;
        float w[9][8];
#pragma unroll
        for (int k = 0; k < 9; ++k) { const f32x4v a0 = *(const LAS f32x4v*)(cw + k * DFF + ch), a1 = *(const LAS f32x4v*)(cw + k * DFF + ch + 4);
            const bool ok = k < 3 ? up : (k >= 6 ? dn : true);
#pragma unroll
            for (int e = 0; e < 4; ++e) { w[k][e] = ok ? a0[e] : 0.f; w[k][4 + e] = ok ? a1[e] : 0.f; } }
        float win[4][3][8];
#define CONV_LD(dst, col_) do { const int cc_ = (col_) < 0 ? 0 : ((col_) > GW - 1 ? GW - 1 : (col_)); dst[0] = *(const u32x4v*)(gu + (size_t)cc_ * DFF); dst[1] = *(const u32x4v*)(g0 + (size_t)cc_ * DFF); dst[2] = *(const u32x4v*)(gd + (size_t)cc_ * DFF); } while (0)
#define CONV_UNP(slot_, src, okc) do { _Pragma("unroll") for (int di_ = 0; di_ < 3; ++di_) { u32x4v q_ = src[di_]; if (!(okc)) q_ = (u32x4v){0u, 0u, 0u, 0u}; \
            win[slot_][di_][0] = __uint_as_float(q_.x << 16); win[slot_][di_][1] = __uint_as_float(q_.x & 0xffff0000u); win[slot_][di_][2] = __uint_as_float(q_.y << 16); win[slot_][di_][3] = __uint_as_float(q_.y & 0xffff0000u); \
            win[slot_][di_][4] = __uint_as_float(q_.z << 16); win[slot_][di_][5] = __uint_as_float(q_.z & 0xffff0000u); win[slot_][di_][6] = __uint_as_float(q_.w << 16); win[slot_][di_][7] = __uint_as_float(q_.w & 0xffff0000u); } } while (0)
        u32x4v rawn[3];
        { u32x4v ra[3], rb[3]; CONV_LD(ra, col0 - 1); CONV_LD(rb, col0); CONV_LD(rawn, col0 + 1);
          CONV_UNP(3, ra, col0 > 0); CONV_UNP(0, rb, true); }
        for (int q = 0; q < nq; ++q) {
#pragma unroll
            for (int u = 0; u < 4; ++u) {
                const int px = 4 * q + u, col = col0 + px;
                const int sl = (u + 3) & 3, sm = u, sr = (u + 1) & 3;
                CONV_UNP(sr, rawn, col + 1 < GW);
                const u32x4v vv = *(const u32x4v*)(v0 + (size_t)px * DFF);
                CONV_LD(rawn, col + 2);
                float acc[8];
                { const LAS float* bp = cw + 9 * DFF + ch; asm volatile("" : "+v"(bp));
                  const f32x4v a0 = *(const LAS f32x4v*)bp, a1 = *(const LAS f32x4v*)(bp + 4);
#pragma unroll
                  for (int e = 0; e < 4; ++e) { acc[e] = a0[e]; acc[4 + e] = a1[e]; } }
#pragma unroll
                for (int di = 0; di < 3; ++di)
#pragma unroll
                    for (int e = 0; e < 8; ++e) acc[e] += w[di * 3][e] * win[sl][di][e] + w[di * 3 + 1][e] * win[sm][di][e] + w[di * 3 + 2][e] * win[sr][di][e];
                const float vf[8] = {__uint_as_float(vv.x << 16), __uint_as_float(vv.x & 0xffff0000u), __uint_as_float(vv.y << 16), __uint_as_float(vv.y & 0xffff0000u),
                                     __uint_as_float(vv.z << 16), __uint_as_float(vv.z & 0xffff0000u), __uint_as_float(vv.w << 16), __uint_as_float(vv.w & 0xffff0000u)};
                u32x4v o; o.x = scan::cvt_pk(gelu_tanh(acc[0]) * vf[0], gelu_tanh(acc[1]) * vf[1]); o.y = scan::cvt_pk(gelu_tanh(acc[2]) * vf[2], gelu_tanh(acc[3]) * vf[3]);
                o.z = scan::cvt_pk(gelu_tanh(acc[4]) * vf[4], gelu_tanh(acc[5]) * vf[5]); o.w = scan::cvt_pk(gelu_tanh(acc[6]) * vf[6], gelu_tanh(acc[7]) * vf[7]);
                *(u32x4v*)(v0 + (size_t)px * DFF) = o;
            }
        }
#undef CONV_LD
#undef CONV_UNP
    }
}


#define GAS __attribute__((address_space(1)))
typedef GAS unsigned gu32;
#define RLX_AGENT __ATOMIC_RELAXED, __HIP_MEMORY_SCOPE_AGENT
#define XB_TMO      128
#define XB_XCNT(j)  (256  + 64 * (j))
#define XB_XSUB(j)  (1280 + 64 * (j))
#define XB_XGEN(j)  (2304 + 64 * (j))
#define XB_TOP      3328
#define XB_TOPGEN   3392
#define XCD_BAR_WORDS 3456
#define XB_SPIN_CAP (1u << 18)

__device__ __forceinline__ unsigned xb_ld(unsigned* p)              { return __hip_atomic_load(p, __ATOMIC_RELAXED, __HIP_MEMORY_SCOPE_AGENT); }
__device__ __forceinline__ unsigned xb_add(unsigned* p, unsigned v) { return __hip_atomic_fetch_add(p, v, __ATOMIC_RELAXED, __HIP_MEMORY_SCOPE_AGENT); }
__device__ __forceinline__ unsigned xb_xcc_id() { return (unsigned)__builtin_amdgcn_s_getreg((3 << 11) | 20) & 0xFu; }
#define XB_SPIN(cond, bar) do { unsigned _sp = 0; while (cond) { __builtin_amdgcn_s_sleep(1); \
    if ((++_sp & 255u) == 0u) { if (xb_ld(&(bar)[XB_TMO])) break; if (_sp > XB_SPIN_CAP) { atomicAdd(&(bar)[XB_TMO], 1u); break; } } } } while (0)

struct XcdBarrier {
    unsigned* bar; unsigned x;
    volatile LAS unsigned* st;
};

__device__ __forceinline__ XcdBarrier xcd_barrier_post(unsigned* bar, volatile LAS unsigned* st) {
    XcdBarrier b; b.bar = bar; b.x = xb_xcc_id(); b.st = st;
    if (threadIdx.x == 0) (void)xb_add(&bar[XB_XCNT(b.x)], 1u);
    return b;
}
__device__ __forceinline__ void xcd_barrier_complete(unsigned* bar, unsigned x, unsigned& nloc, unsigned& nx) {
    const unsigned G = gridDim.x * gridDim.y * gridDim.z;
    unsigned sum, cnt, mine, sp = 0u;
    for (;;) {
        sum = 0u; cnt = 0u; mine = 0u;
#pragma unroll
        for (unsigned j = 0; j < 16; ++j) { const unsigned c = xb_ld(&bar[XB_XCNT(j)]); sum += c; cnt += (c > 0u) ? 1u : 0u; mine = (j == x) ? c : mine; }
        if (sum == G) break;
        __builtin_amdgcn_s_sleep(1);
        if ((++sp & 255u) == 0u) { if (xb_ld(&bar[XB_TMO])) break; if (sp > XB_SPIN_CAP) { atomicAdd(&bar[XB_TMO], 1u); break; } }
    }
    nloc = mine > 0u ? mine : 1u; nx = cnt > 0u ? cnt : 1u;
}

template <bool LOCAL>
__device__ __forceinline__ void xcd_barrier(const XcdBarrier& b) {
    asm volatile("s_waitcnt vmcnt(0)" ::: "memory");
    __syncthreads();
    if (threadIdx.x == 0) {
        unsigned* bar = b.bar;
        __builtin_amdgcn_s_waitcnt(0);
        unsigned nloc = b.st[0], nx = b.st[1];
        if (nloc == 0u) { xcd_barrier_complete(bar, b.x, nloc, nx); b.st[0] = nloc; b.st[1] = nx; }
        const unsigned old = xb_add(&bar[XB_XSUB(b.x)], 1u);
        const unsigned gen = old / nloc;
        if (LOCAL) {
            if (old + 1u == (gen + 1u) * nloc) xb_add(&bar[XB_XGEN(b.x)], 1u);
            else XB_SPIN(xb_ld(&bar[XB_XGEN(b.x)]) == gen, bar);
            __builtin_amdgcn_fence(__ATOMIC_ACQUIRE, "agent");
            asm volatile("s_waitcnt vmcnt(0)" ::: "memory");
        } else if (old + 1u == (gen + 1u) * nloc) {
            __builtin_amdgcn_fence(__ATOMIC_RELEASE, "agent");
            asm volatile("s_waitcnt vmcnt(0)" ::: "memory");
            const unsigned og = xb_add(&bar[XB_TOP], 1u);
            const unsigned tg = og / nx;
            if (og + 1u == (tg + 1u) * nx) xb_add(&bar[XB_TOPGEN], 1u);
            else XB_SPIN(xb_ld(&bar[XB_TOPGEN]) == tg, bar);
            __builtin_amdgcn_fence(__ATOMIC_ACQUIRE, "agent");
            xb_add(&bar[XB_XGEN(b.x)], 1u);
            asm volatile("s_waitcnt vmcnt(0)" ::: "memory");
        } else {
            XB_SPIN(xb_ld(&bar[XB_XGEN(b.x)]) == gen, bar);
            __builtin_amdgcn_fence(__ATOMIC_ACQUIRE, "agent");
            asm volatile("s_waitcnt vmcnt(0)" ::: "memory");
        }
    }
    __syncthreads();
}


__global__ void __launch_bounds__(NTHR, 2) mega_fwd(Params p) {
    extern __shared__ __attribute__((aligned(16))) unsigned char lds_dyn[];
    LAS unsigned char* lds = (LAS unsigned char*)lds_dyn;
    cg::grid_group grid = cg::this_grid();
    const int c = blockIdx.x;
    unsigned char* ws = p.ws; unsigned char* big = ws + WS_BIG;
    float* modv = (float*)(ws + WS_MOD); float* binp = (float*)(ws + WS_BIN);
    bf16_t* Wt_in = (bf16_t*)(ws + WS_WIN); bf16_t* U = (bf16_t*)(ws + WS_U);
    bf16_t* Pm = (bf16_t*)(big + BIG_PM); bf16_t* Pg = (bf16_t*)(big + BIG_PG); float* small = (float*)(big + BIG_SMALL);
    bf16_t* hm = (bf16_t*)p.out; bf16_t* hg = (bf16_t*)(big + BIG_HG); bf16_t* side = (bf16_t*)(big + BIG_SIDE);
    bf16_t* gate = (bf16_t*)(big + BIG_GATE); bf16_t* val = (bf16_t*)(big + BIG_VAL);
    if (threadIdx.x < 16) ((LAS unsigned*)(lds + MISC_OFF))[threadIdx.x] = 0u;
    __syncthreads();
#define GRID_SYNC() xcd_barrier<false>(bar)
#define XCD_SYNC() xcd_barrier<true>(bar)
    if (c == 0) { for (int i = threadIdx.x; i < XCD_BAR_WORDS; i += NTHR) __hip_atomic_store((unsigned*)(ws + WS_CTL) + CW_BAR + i, 0u, __ATOMIC_RELAXED, __HIP_MEMORY_SCOPE_AGENT);
                  if (threadIdx.x < 16) __hip_atomic_store((unsigned*)(ws + WS_CTL) + CW_RANK + 64 * threadIdx.x, 0u, __ATOMIC_RELAXED, __HIP_MEMORY_SCOPE_AGENT);
                  if (threadIdx.x < 256) { __hip_atomic_store((unsigned*)(ws + WS_CTL) + CW_LN + 64 * threadIdx.x, 0u, __ATOMIC_RELAXED, __HIP_MEMORY_SCOPE_AGENT);
                                           __hip_atomic_store((unsigned*)(ws + WS_CTL) + CW_GX + 64 * threadIdx.x, 0u, __ATOMIC_RELAXED, __HIP_MEMORY_SCOPE_AGENT); } }
    asm volatile("s_waitcnt vmcnt(0)" ::: "memory");
    grid.sync();
    XcdBarrier bar = xcd_barrier_post((unsigned*)(ws + WS_CTL) + CW_BAR, (volatile LAS unsigned*)(lds + MISC_OFF));
    if (threadIdx.x == 0) ((volatile LAS unsigned*)(lds + MISC_OFF))[4] = xb_add((unsigned*)(ws + WS_CTL) + CW_RANK + 64 * bar.x, 1u);
    __syncthreads();
    const int xr = __builtin_amdgcn_readfirstlane((int)((volatile LAS unsigned*)(lds + MISC_OFF))[4]);
    const int xx = __builtin_amdgcn_readfirstlane((int)bar.x & 7), v = 32 * xx + (xr & 31);
    ph_prologue(p, lds, c);
    GRID_SYNC();
    ph_modulate(p, lds, v);
    GRID_SYNC();
    { pg8::SchedAB S{U, Wt_in, DM, xx, xr & 31, 0}; pg8::FEpiAB E{Pm, Pg, binp}; pg8::gemm_phase(lds, DM, S, E); }
    XCD_SYNC();
    { scan::Args a{Pm, 3072, 0, small, p.in[8], p.in[9], p.in[10], p.in[11], p.in[12], hm, nullptr, nullptr}; scan::scan_item<false>(lds, a, v); }
    GRID_SYNC();
    { scan::Args a{Pg, 2048, 0, small, p.in[8], p.in[9], p.in[10], p.in[11], p.in[12], hg, big + BIG_GX, (unsigned*)(ws + WS_CTL) + CW_GX}; scan::scan_item<true>(lds, a, v); }
    GRID_SYNC();
    { pg8::SchedPlain S{U, Wt_in + (size_t)PC_SIDE * DM, 16, N_SIDE / 256, DM, xx, xr & 31, 0};
      pg8::FEpiSideF E{side, binp + PC_SIDE, hm, hg, p.in[13], p.in[14], (LAS float*)(lds + pg8::STAGE_BYTES)}; pg8::gemm_phase(lds, DM, S, E); }
    XCD_SYNC();
    { pg8::SchedDual S{hm, (const bf16_t*)(ws + WS_WBM), hg, (const bf16_t*)(ws + WS_WBG), 16, DM / 256, DM, xx, xr & 31, 0}; pg8::FEpiMerge E{U, side}; pg8::gemm_phase(lds, DM, S, E); }
    XCD_SYNC();
    { pg8::SchedPlain S{U, (const bf16_t*)(ws + WS_WOUT), 16, DM / 256, DM, xx, xr & 31, 0};
      pg8::FEpiOutLN E{p.in[0], modv, p.out, U, p.in[18], p.in[19], pg8::LnX{(float*)(ws + WS_LNX), (unsigned*)(ws + WS_CTL) + CW_LN, (LAS float*)(lds + pg8::STAGE_BYTES), xx, 0}}; pg8::gemm_phase(lds, DM, S, E); }
    GRID_SYNC();
    { pg8::SchedPlain S{U, (const bf16_t*)(ws + WS_WUP), 16, 2 * DFF / 256, DM, xx, xr & 31, 0}; pg8::FEpiUp E{gate, val, p.in[21]}; pg8::gemm_phase(lds, DM, S, E); }
    XCD_SYNC();
    ph_convglu(p, lds, v);
    XCD_SYNC();
    { pg8::SchedPlain S{val, (const bf16_t*)(ws + WS_WDN), 16, DM / 256, DFF, xx, xr & 31, 0};
      pg8::FEpiDownLN E{p.out, modv, p.in[25], p.in[26], p.in[27], pg8::LnX{(float*)(ws + WS_LNX + MiB), (unsigned*)(ws + WS_CTL) + CW_LN + 128 * 64, (LAS float*)(lds + pg8::STAGE_BYTES), xx, 0}}; pg8::gemm_phase(lds, DFF, S, E); }
    if (xb_ld(&bar.bar[XB_TMO]) != 0u || xr >= 32 || bar.x >= 8u) { __syncthreads(); if (threadIdx.x == 0) p.out[(size_t)v * 128 * DM] = __builtin_nanf(""); }
}

extern "C" void kernel_launch(void* const* d_in, const int* in_sizes, int n_in, void* d_out, int out_size, void* d_ws, size_t ws_size, hipStream_t stream) {
    if (n_in != 28 || out_size != ML * DM || ws_size < WS_END) { fprintf(stderr, "kernel_launch: unexpected shapes n_in %d out %d ws %zu\n", n_in, out_size, ws_size); return; }
    static bool attr_set = false;
    if (!attr_set) { (void)hipFuncSetAttribute((const void*)mega_fwd, hipFuncAttributeMaxDynamicSharedMemorySize, MEGA_LDS); attr_set = true; }
    Params p{};
    for (int i = 0; i < 28; ++i) p.in[i] = (const float*)d_in[i];
    p.out = (float*)d_out; p.ws = (unsigned char*)d_ws;
    void* args[] = {&p};
    hipError_t e = hipLaunchCooperativeKernel((const void*)mega_fwd, dim3(NBLK), dim3(NTHR), args, MEGA_LDS, stream);
    if (e != hipSuccess) fprintf(stderr, "cooperative launch failed: %s\n", hipGetErrorString(e));
}
```

```cpp
#include <hip/hip_runtime.h>
#include <cstdio>
#include <cstdint>

typedef unsigned short bf16_t;

constexpr int DM = 1024, NB = 16, SEQ = 2048, CTX = 256, GW = 64;
constexpr int ML = NB * SEQ;
constexpr int MC = NB * CTX;
constexpr int MT = ML + MC;
constexpr int NIN = 9280, NINP = 9472;
constexpr int DFF = 2816;
constexpr float ALPHA = 1.189207115002721f;
constexpr float EPS = 1e-5f;
constexpr int PC_QM = 0, PC_KM = 1024, PC_VM = 2048, PC_SMALL = 3072, PC_QG = 3328, PC_KG = 3840, PC_VG = 4352, PC_SIDE = 5376;
constexpr int N_AB = 5376;
constexpr int N_SIDE = 4096;

constexpr size_t MiB = 1u << 20;
constexpr size_t WS_CTL = 0;
constexpr size_t WS_MOD = 1 * MiB;
constexpr size_t WS_BIN = WS_MOD + 512 * 1024;
constexpr size_t WS_WIN = 4 * MiB;
constexpr size_t WS_WBM = WS_WIN + (size_t)NINP * DM * 2;
constexpr size_t WS_WBG = WS_WBM + 2 * MiB;
constexpr size_t WS_WOUT = WS_WBG + 2 * MiB;
constexpr size_t WS_WUP = WS_WOUT + 2 * MiB;
constexpr size_t WS_WDN = WS_WUP + 11 * MiB;
constexpr size_t WS_U = 46 * MiB;
constexpr size_t WS_BIG = 118 * MiB;
constexpr size_t WS_END = 509 * MiB;
static_assert(WS_WDN + (size_t)DM * DFF * 2 <= WS_U, "weights fit");
constexpr size_t BIG_PM = 0;
constexpr size_t BIG_PG = 216 * MiB;
constexpr size_t BIG_SMALL = 360 * MiB;
constexpr size_t BIG_HG = 0;
constexpr size_t BIG_SIDE = 128 * MiB;
constexpr size_t BIG_GATE = 0;
constexpr size_t BIG_VAL = 176 * MiB;

__device__ __forceinline__ float bf2f(bf16_t v) { return __uint_as_float(((unsigned)v) << 16); }
__device__ __forceinline__ bf16_t f2bf(float f) { unsigned u = __float_as_uint(f); return (bf16_t)((u + 0x7fffu + ((u >> 16) & 1u)) >> 16); }
__device__ __forceinline__ float sigmoidf_(float x) { return __builtin_amdgcn_rcpf(1.f + __expf(-x)); }
__device__ __forceinline__ float siluf_(float x) { return x * sigmoidf_(x); }
__device__ __forceinline__ float logsigmoidf_(float x) { return fminf(x, 0.f) - __logf(1.f + __expf(-fabsf(x))); }
__device__ __forceinline__ float gelu_tanh(float x) { const float a = x * __builtin_fmaf(x * x, -0.10294324f, -2.3022082f); return x * __builtin_amdgcn_rcpf(1.f + __builtin_amdgcn_exp2f(a)); }
__device__ __forceinline__ float wave_sum(float v) {
#pragma unroll
    for (int o = 1; o < 64; o <<= 1) v += __shfl_xor(v, o);
    return v;
}

namespace pg8 {
#define PG8_LAS __attribute__((address_space(3)))
typedef short bf16x8 __attribute__((ext_vector_type(8)));
typedef float f32x4 __attribute__((ext_vector_type(4)));
typedef unsigned u32x4 __attribute__((ext_vector_type(4)));
constexpr int BM = 256, BK = 64, HALF = 128, HTB = HALF * BK * 2, STAGE_BYTES = 8 * HTB, NXCD = 8, WGM = 4;
__host__ __device__ __forceinline__ int lds_byte(int r, int c) { const int st = (r >> 4) * 2 + (c >> 5), rr = r & 15, cc = c & 31, ob = rr * 64 + cc * 2; return st * 1024 + (ob ^ (((ob >> 9) & 1) << 5)); }
__host__ __device__ __forceinline__ void stage_rc(int b, int& R, int& C) { const int st = b / 1024, sb = b % 1024, swz = sb ^ (((sb >> 9) & 1) << 5); R = (st >> 1) * 16 + swz / 64; C = (st & 1) * 32 + (swz % 64) / 2; }
__host__ __device__ __forceinline__ int perm32(int rho) { const int n = rho >> 4, i = rho & 15; return 8 * (i >> 2) + 4 * n + (i & 3); }
struct Unit { int pm, pn, tag; const bf16_t* A; const bf16_t* B; };
__host__ __device__ __forceinline__ bool tile_local(int L, int nPl, int nN, int& lp, int& pn) {
    if (L >= nPl * nN) return false;
    const int nig = WGM * nN, gid = L / nig, fm = gid * WGM, gsz = (nPl - fm) < WGM ? (nPl - fm) : WGM, rem = L - gid * nig;
    lp = fm + rem % gsz; pn = rem / gsz; return true;
}
struct SchedPlain {
    const bf16_t* A; const bf16_t* Bt; int nPl, nN, K, x, r, pad;
    __device__ __forceinline__ bool next(int i, Unit& u) const { int lp; if (!tile_local(i * 32 + r, nPl, nN, lp, u.pn)) return false; u.pm = lp < 16 ? 16 * x + lp : 128 + 2 * x + (lp - 16); u.tag = 1;
        u.A = A + (size_t)u.pm * BM * K; u.B = Bt + (size_t)u.pn * BM * K; return true; }
};
struct SchedAB {
    const bf16_t* A; const bf16_t* Bt; int K, x, r, pad;
    __device__ __forceinline__ bool next(int i, Unit& u) const { const int L = i * 32 + r; int lp, pn;
        if (L < 320) { (void)tile_local(L, 16, 20, lp, pn); }
        else if (L < 348) { const int q = L - 320, cp = q / 14, idx = q - cp * 14; lp = 16 + cp; pn = idx < 8 ? 4 + idx : 6 + idx; }
        else return false;
        u.pn = pn; u.pm = lp < 16 ? 16 * x + lp : 128 + 2 * x + (lp - 16); u.tag = 1;
        u.A = A + (size_t)u.pm * BM * K; u.B = Bt + (size_t)(pn < 12 ? pn : pn + 1) * BM * K; return true; }
};
struct SchedDual {
    const bf16_t* A0; const bf16_t* B0; const bf16_t* A1; const bf16_t* B1; int nPl, nN, K, x, r, pad;
    __device__ __forceinline__ bool next(int i, Unit& u) const { int lp; if (!tile_local((i >> 1) * 32 + r, nPl, nN, lp, u.pn)) return false; u.pm = 16 * x + lp; u.tag = i & 1;
        u.A = ((i & 1) ? A1 : A0) + (size_t)u.pm * BM * K; u.B = ((i & 1) ? B1 : B0) + (size_t)u.pn * BM * K; return true; }
};
__device__ __forceinline__ unsigned cvt_pk_bf16(float lo, float hi) { unsigned r; asm volatile("v_cvt_pk_bf16_f32 %0, %1, %2" : "=v"(r) : "v"(lo), "v"(hi)); return r; }
__device__ __forceinline__ u32x4 pack8(f32x4 v0, f32x4 v1) { u32x4 w; w.x = cvt_pk_bf16(v0[0], v0[1]); w.y = cvt_pk_bf16(v0[2], v0[3]); w.z = cvt_pk_bf16(v1[0], v1[1]); w.w = cvt_pk_bf16(v1[2], v1[3]); return w; }
__device__ __forceinline__ void unpack8(u32x4 w, f32x4& v0, f32x4& v1) {
    v0[0] = __uint_as_float(w.x << 16); v0[1] = __uint_as_float(w.x & 0xffff0000u); v0[2] = __uint_as_float(w.y << 16); v0[3] = __uint_as_float(w.y & 0xffff0000u);
    v1[0] = __uint_as_float(w.z << 16); v1[1] = __uint_as_float(w.z & 0xffff0000u); v1[2] = __uint_as_float(w.w << 16); v1[3] = __uint_as_float(w.w & 0xffff0000u); }

template <class Epi, class Sched>
__device__ __forceinline__ void gemm_phase(PG8_LAS unsigned char* lds, const int K, const Sched& S, const Epi& E) {
    int tid_ = threadIdx.x; asm volatile("" : "+v"(tid_));
    const int tid = tid_, wid = __builtin_amdgcn_readfirstlane(tid >> 6), lane = tid & 63, wr = wid >> 2, wc = wid & 3, fr = lane & 15, fq = lane >> 4;
    const int nt = K / BK;
    unsigned voffA[2], voffB[2];
#pragma unroll
    for (int i = 0; i < 2; ++i) { int R, C; stage_rc(tid * 16 + i * 8192, R, C); const int Rb = (R & ~31) + perm32(R & 31);
        voffA[i] = (unsigned)(R * K + C) * 2u; voffB[i] = (unsigned)(Rb * K + C) * 2u; }
    const size_t kstep = (size_t)(BK * 2);
    const size_t hstep = (size_t)HALF * K * 2;
    const unsigned ldsw = (unsigned)wid * 1024u;
    const int aoff = lds_byte(wr * 64 + fr, fq * 8), boff = lds_byte(wc * 32 + fr, fq * 8);
#define PG8_SA(b, h) (((b) * 2 + (h)) * HTB)
#define PG8_SB(b, h) ((4 + (b) * 2 + (h)) * HTB)
#define PG8_STAGE(bufoff, gbase, voff) do { _Pragma("unroll") for (int _i = 0; _i < 2; ++_i) \
        __builtin_amdgcn_global_load_lds((const unsigned*)((const char*)(gbase) + (voff)[_i]), (PG8_LAS unsigned*)(lds + (bufoff) + ldsw + _i * 8192), 16, 0, 0); } while (0)
#define PG8_LDA(dst, b, h) do { _Pragma("unroll") for (int m = 0; m < 4; ++m) _Pragma("unroll") for (int k = 0; k < 2; ++k) dst[m][k] = *(const PG8_LAS bf16x8*)(lds + PG8_SA(b, h) + aoff + m * 2048 + k * 1024); } while (0)
#define PG8_LDB(dst, b, h) do { _Pragma("unroll") for (int n = 0; n < 2; ++n) _Pragma("unroll") for (int k = 0; k < 2; ++k) dst[n][k] = *(const PG8_LAS bf16x8*)(lds + PG8_SB(b, h) + boff + n * 2048 + k * 1024); } while (0)
#define PG8_MMA(ai, bj, At, Bt) do { __builtin_amdgcn_s_setprio(1); _Pragma("unroll") for (int m = 0; m < 4; ++m) _Pragma("unroll") for (int n = 0; n < 2; ++n) _Pragma("unroll") for (int k = 0; k < 2; ++k) \
        acc[ai][bj][m][n] = __builtin_amdgcn_mfma_f32_16x16x32_bf16(Bt[n][k], At[m][k], acc[ai][bj][m][n], 0, 0, 0); __builtin_amdgcn_s_setprio(0); } while (0)
#define PG8_WAIT_V_(n) asm volatile("s_waitcnt vmcnt(" #n ")" ::: "memory")
#define PG8_WAIT_V(n) PG8_WAIT_V_(n)
#define PG8_WAIT_L(n) asm volatile("s_waitcnt lgkmcnt(" #n ")" ::: "memory")
#define PG8_BAR __builtin_amdgcn_s_barrier()
#define PG8_SCHED __builtin_amdgcn_sched_barrier(0)
    Unit cur, nxt; int ui = 0;
    if (!S.next(0, cur)) return;
    f32x4 acc[2][2][4][2];
#pragma unroll
    for (int a = 0; a < 2; ++a)
#pragma unroll
        for (int b = 0; b < 2; ++b)
#pragma unroll
            for (int m = 0; m < 4; ++m)
#pragma unroll
                for (int n = 0; n < 2; ++n) acc[a][b][m][n] = (f32x4){0.f, 0.f, 0.f, 0.f};
    bf16x8 At[4][2], B0[2][2], B1[2][2];
    const char* cA = (const char*)cur.A; const char* cB = (const char*)cur.B;
    PG8_STAGE(PG8_SB(0, 0), cB, voffB); PG8_STAGE(PG8_SB(0, 1), cB + hstep, voffB); PG8_STAGE(PG8_SA(0, 0), cA, voffA); PG8_STAGE(PG8_SA(0, 1), cA + hstep, voffA);
    if (wr == 1) PG8_BAR;
    PG8_WAIT_V(2); PG8_BAR;
    PG8_STAGE(PG8_SB(1, 0), cB + kstep, voffB); PG8_STAGE(PG8_SA(1, 0), cA + kstep, voffA); PG8_STAGE(PG8_SB(1, 1), cB + hstep + kstep, voffB);
    PG8_WAIT_V(6); PG8_BAR;
    for (;;) {
        const bool has_next = S.next(ui + 1, nxt);
        const char* nA = has_next ? (const char*)nxt.A : cA; const char* nB = has_next ? (const char*)nxt.B : cB;
#define PG8_ITER(T_, W1, W2) do { const int t_ = (T_); const bool last = (t_ == nt - 2); \
            const char* a1 = cA + (size_t)(t_ + 1) * kstep; \
            const char* a2 = last ? nA : cA + (size_t)(t_ + 2) * kstep; const char* b2 = last ? nB : cB + (size_t)(t_ + 2) * kstep; \
            const char* a3 = a2 + kstep; const char* b3 = b2 + kstep; \
            PG8_LDB(B0, 0, 0); PG8_LDB(B1, 0, 1); PG8_SCHED; PG8_LDA(At, 0, 0); PG8_STAGE(PG8_SA(1, 1), a1 + hstep, voffA); \
            PG8_WAIT_V(W1); PG8_WAIT_L(0); PG8_BAR; PG8_MMA(0, 0, At, B0); PG8_MMA(0, 1, At, B1); PG8_BAR; PG8_SCHED; \
            PG8_LDA(At, 0, 1); PG8_STAGE(PG8_SB(0, 0), b2, voffB); PG8_STAGE(PG8_SB(0, 1), b2 + hstep, voffB); PG8_STAGE(PG8_SA(0, 0), a2, voffA); \
            PG8_WAIT_V(W2); PG8_WAIT_L(0); PG8_BAR; PG8_MMA(1, 0, At, B0); PG8_MMA(1, 1, At, B1); PG8_BAR; PG8_SCHED; \
            PG8_LDB(B0, 1, 0); PG8_LDB(B1, 1, 1); PG8_SCHED; PG8_LDA(At, 1, 0); PG8_STAGE(PG8_SA(0, 1), a2 + hstep, voffA); \
            PG8_WAIT_V(8); PG8_WAIT_L(0); PG8_BAR; PG8_MMA(0, 0, At, B0); PG8_MMA(0, 1, At, B1); PG8_BAR; PG8_SCHED; \
            PG8_LDA(At, 1, 1); PG8_STAGE(PG8_SB(1, 0), b3, voffB); PG8_STAGE(PG8_SB(1, 1), b3 + hstep, voffB); PG8_STAGE(PG8_SA(1, 0), a3, voffA); \
            PG8_WAIT_V(8); PG8_WAIT_L(0); PG8_BAR; PG8_MMA(1, 0, At, B0); PG8_MMA(1, 1, At, B1); PG8_BAR; PG8_SCHED; } while (0)
        int t0 = 0;
        if (Epi::NST == 16 && ui > 0) { PG8_ITER(0, 24, 24); t0 = 2; }
        for (int t = t0; t < nt; t += 2) PG8_ITER(t, 8, 8);
#undef PG8_ITER
        if (wr == 0) PG8_BAR;
        const bool keep = E(acc, cur, wr, wc, fr, fq);
        if (!has_next) break;
        if (!keep) {
#pragma unroll
            for (int a = 0; a < 2; ++a)
#pragma unroll
                for (int b = 0; b < 2; ++b)
#pragma unroll
                    for (int m = 0; m < 4; ++m)
#pragma unroll
                        for (int n = 0; n < 2; ++n) acc[a][b][m][n] = (f32x4){0.f, 0.f, 0.f, 0.f};
        }
        cur = nxt; cA = nA; cB = nB; ++ui;
        if (wr == 1) PG8_BAR;
    }
    PG8_WAIT_V(0);
    PG8_BAR;
#undef PG8_SA
#undef PG8_SB
#undef PG8_STAGE
#undef PG8_LDA
#undef PG8_LDB
#undef PG8_MMA
#undef PG8_WAIT_V
#undef PG8_WAIT_V_
#undef PG8_WAIT_L
#undef PG8_BAR
#undef PG8_SCHED
}

#define PG8_FRAG_LOOP for (int ai = 0; ai < 2; ++ai) _Pragma("unroll") for (int m = 0; m < 4; ++m) _Pragma("unroll") for (int bj = 0; bj < 2; ++bj)
struct FEpiAB { static constexpr int NST = 16; bf16_t* Pm; bf16_t* Pg; const float* bias;
    __device__ __forceinline__ bool operator()(const f32x4 (&acc)[2][2][4][2], const Unit& u, int wr, int wc, int fr, int fq) const {
        asm volatile("" : "+v"(fr), "+v"(fq)); const int row0 = u.pm * BM + wr * 64 + fr, ct = u.pn, cin = wc * 32 + 8 * fq, bt = ct < 12 ? ct : ct + 1;
        f32x4 bv[2][2];
#pragma unroll
        for (int bj = 0; bj < 2; ++bj)
#pragma unroll
            for (int n = 0; n < 2; ++n) bv[bj][n] = *(const f32x4*)(bias + bt * BM + cin + bj * HALF + 4 * n);
        bf16_t* base; int ld;
        if (ct < 12) { base = Pm + ct * BM; ld = 3072; } else { base = Pg + (ct - 12) * BM; ld = 2048; }
#pragma unroll
        PG8_FRAG_LOOP { *(u32x4*)(base + (size_t)(row0 + ai * HALF + m * 16) * ld + cin + bj * HALF) = pack8(acc[ai][bj][m][0] + bv[bj][0], acc[ai][bj][m][1] + bv[bj][1]); }
        return false;
    }
};
struct FEpiBias { static constexpr int NST = 16; bf16_t* O; const float* bias; int ld, pad;
    __device__ __forceinline__ bool operator()(const f32x4 (&acc)[2][2][4][2], const Unit& u, int wr, int wc, int fr, int fq) const {
        const int row0 = u.pm * BM + wr * 64 + fr, col0 = u.pn * BM + wc * 32 + 8 * fq;
        f32x4 bv[2][2];
#pragma unroll
        for (int bj = 0; bj < 2; ++bj)
#pragma unroll
            for (int n = 0; n < 2; ++n) bv[bj][n] = *(const f32x4*)(bias + col0 + bj * HALF + 4 * n);
#pragma unroll
        PG8_FRAG_LOOP { *(u32x4*)(O + (size_t)(row0 + ai * HALF + m * 16) * ld + col0 + bj * HALF) = pack8(acc[ai][bj][m][0] + bv[bj][0], acc[ai][bj][m][1] + bv[bj][1]); }
        return false;
    }
};
struct FEpiUp { static constexpr int NST = 0;      bf16_t* gate; bf16_t* val; const float* bias;
    __device__ __forceinline__ bool operator()(const f32x4 (&acc)[2][2][4][2], const Unit& u, int wr, int wc, int fr, int fq) const {
        asm volatile("" : "+v"(fr), "+v"(fq));
        const int row0 = u.pm * BM + wr * 64 + fr, cin = wc * 32 + 8 * fq;
        const unsigned tb = u.pn < 11 ? (unsigned)(u.pn * BM) * 2u : (unsigned)(176u << 20) + (unsigned)((u.pn - 11) * BM) * 2u;
        const unsigned ob = tb + (unsigned)(row0 * DFF + cin) * 2u; char* gb = (char*)gate;
        f32x4 bv[2][2];
#pragma unroll
        for (int bj = 0; bj < 2; ++bj)
#pragma unroll
            for (int n = 0; n < 2; ++n) bv[bj][n] = *(const f32x4*)(bias + u.pn * BM + cin + bj * HALF + 4 * n);
#pragma unroll
        PG8_FRAG_LOOP { *(u32x4*)(gb + (ob + (unsigned)(((ai * HALF + m * 16) * DFF + bj * HALF) * 2))) = pack8(acc[ai][bj][m][0] + bv[bj][0], acc[ai][bj][m][1] + bv[bj][1]); }
        return false;
    }
};
__device__ __forceinline__ float fsig(float x) { return __builtin_amdgcn_rcpf(1.f + __expf(-x)); }
struct FEpiMerge { static constexpr int NST = 0; bf16_t* Z; const bf16_t* side;
    __device__ __forceinline__ bool operator()(f32x4 (&acc)[2][2][4][2], const Unit& u, int wr, int wc, int fr, int fq) const {
        const int row0 = u.pm * BM + wr * 64 + fr, col0 = u.pn * BM + wc * 32 + 8 * fq;
        if (u.tag == 0) {
#pragma unroll
            PG8_FRAG_LOOP { const bf16_t* sp = side + (size_t)(row0 + ai * HALF + m * 16) * 4096 + col0 + bj * HALF;
                f32x4 a0, a1, b0, b1; unpack8(*(const u32x4*)(sp + 2048), a0, a1); unpack8(*(const u32x4*)(sp + 3072), b0, b1);
#pragma unroll
                for (int j = 0; j < 4; ++j) { acc[ai][bj][m][0][j] *= (1.f + __expf(-b0[j])) * fsig(a0[j]); acc[ai][bj][m][1][j] *= (1.f + __expf(-b1[j])) * fsig(a1[j]); } }
            return true;
        }
#pragma unroll
        PG8_FRAG_LOOP { const bf16_t* sp = side + (size_t)(row0 + ai * HALF + m * 16) * 4096 + col0 + bj * HALF;
            f32x4 b0, b1; unpack8(*(const u32x4*)(sp + 3072), b0, b1); f32x4 v0 = acc[ai][bj][m][0], v1 = acc[ai][bj][m][1];
#pragma unroll
            for (int j = 0; j < 4; ++j) { v0[j] *= fsig(b0[j]); v1[j] *= fsig(b1[j]); }
            *(u32x4*)(Z + (size_t)(row0 + ai * HALF + m * 16) * DM + col0 + bj * HALF) = pack8(v0, v1); }
        return false;
    }
};
struct FEpiOut { static constexpr int NST = 0; const float* x; const float* modv; float* r1;
    __device__ __forceinline__ bool operator()(const f32x4 (&acc)[2][2][4][2], const Unit& u, int wr, int wc, int fr, int fq) const {
        const int row0 = u.pm * BM + wr * 64 + fr, col0 = u.pn * BM + wc * 32 + 8 * fq;
        const float* g = modv + (u.pm * BM / SEQ) * 6144 + 2048 + col0;
        f32x4 gv[2][2];
#pragma unroll
        for (int bj = 0; bj < 2; ++bj)
#pragma unroll
            for (int n = 0; n < 2; ++n) gv[bj][n] = *(const f32x4*)(g + bj * HALF + 4 * n);
#pragma unroll
        PG8_FRAG_LOOP { const size_t o = (size_t)(row0 + ai * HALF + m * 16) * DM + col0 + bj * HALF;
            const f32x4 x0 = *(const f32x4*)(x + o), x1 = *(const f32x4*)(x + o + 4);
            *(f32x4*)(r1 + o) = x0 * ALPHA + gv[bj][0] * acc[ai][bj][m][0]; *(f32x4*)(r1 + o + 4) = x1 * ALPHA + gv[bj][1] * acc[ai][bj][m][1]; }
        return false;
    }
};
struct FEpiDown { static constexpr int NST = 0; float* h; const float* modv; const float* b_down;
    __device__ __forceinline__ bool operator()(const f32x4 (&acc)[2][2][4][2], const Unit& u, int wr, int wc, int fr, int fq) const {
        const int row0 = u.pm * BM + wr * 64 + fr, col0 = u.pn * BM + wc * 32 + 8 * fq;
        const float* g = modv + (u.pm * BM / SEQ) * 6144 + 5120 + col0;
#pragma unroll
        for (int bj = 0; bj < 2; ++bj) {
            const f32x4 g0 = *(const f32x4*)(g + bj * HALF), g1 = *(const f32x4*)(g + bj * HALF + 4);
            const f32x4 c0 = g0 * *(const f32x4*)(b_down + col0 + bj * HALF), c1 = g1 * *(const f32x4*)(b_down + col0 + bj * HALF + 4);
#pragma unroll
            for (int ai = 0; ai < 2; ++ai)
#pragma unroll
                for (int m = 0; m < 4; ++m) { float* p = h + (size_t)(row0 + ai * HALF + m * 16) * DM + col0 + bj * HALF;
                    const f32x4 h0 = *(const f32x4*)p, h1 = *(const f32x4*)(p + 4);
                    *(f32x4*)p = h0 * ALPHA + (g0 * acc[ai][bj][m][0] + c0); *(f32x4*)(p + 4) = h1 * ALPHA + (g1 * acc[ai][bj][m][1] + c1);
                    if (m & 1) asm volatile("" ::: "memory"); }
        }
        return false;
    }
};

typedef unsigned u32x2p __attribute__((ext_vector_type(2)));
__device__ __forceinline__ float sum_rows4(float x) {
    const u32x2p a = __builtin_amdgcn_permlane32_swap(__float_as_uint(x), __float_as_uint(x), false, false); const float y = __uint_as_float(a[0]) + __uint_as_float(a[1]);
    const u32x2p b = __builtin_amdgcn_permlane16_swap(__float_as_uint(y), __float_as_uint(y), false, false); return __uint_as_float(b[0]) + __uint_as_float(b[1]); }
struct LnX { float* stats; unsigned* cnt; PG8_LAS float* sx; int x, pad; };
__device__ __forceinline__ void ln_exchange(const float (&ps)[2][4], const float (&pq)[2][4], const Unit& u, const LnX& L, int wr, int wc, int fr, int fq) {
    int tid = threadIdx.x; asm volatile("" : "+v"(tid)); const int lp = u.pm & 15;
#pragma unroll
    for (int ai = 0; ai < 2; ++ai)
#pragma unroll
        for (int m = 0; m < 4; ++m) { float s = ps[ai][m], q = pq[ai][m];
            s = sum_rows4(s); q = sum_rows4(q);
            if (fq == 0) { const int row = 128 * ai + 64 * wr + 16 * m + fr; L.sx[(wc * 256 + row) * 2] = s; L.sx[(wc * 256 + row) * 2 + 1] = q; } }
    __syncthreads();
    float* sb = L.stats + (size_t)((L.x * 16 + lp) * 4) * 512;
    float s_own = 0.f, q_own = 0.f;
    if (tid < 256) {
#pragma unroll
        for (int w = 0; w < 4; ++w) { s_own += L.sx[(w * 256 + tid) * 2]; q_own += L.sx[(w * 256 + tid) * 2 + 1]; }
        float2 o; o.x = s_own; o.y = q_own; *(float2*)(sb + (size_t)u.pn * 512 + tid * 2) = o; }
    asm volatile("s_waitcnt vmcnt(0)" ::: "memory");
    __syncthreads();
    if (tid == 0) { unsigned* cw = L.cnt + (L.x * 16 + lp) * 64;
        (void)__hip_atomic_fetch_add(cw, 1u, __ATOMIC_RELAXED, __HIP_MEMORY_SCOPE_AGENT);
        unsigned sp = 0; while (__hip_atomic_load(cw, __ATOMIC_RELAXED, __HIP_MEMORY_SCOPE_AGENT) < 4u) { __builtin_amdgcn_s_sleep(1); if (++sp > (1u << 22)) break; } }
    __syncthreads();
    if (tid < 256) {
#pragma unroll
        for (int o = 1; o < 4; ++o) { const int pn2 = (u.pn + o) & 3; const float* pp = sb + (size_t)pn2 * 512 + tid * 2;
            s_own += __hip_atomic_load(pp, __ATOMIC_RELAXED, __HIP_MEMORY_SCOPE_AGENT); q_own += __hip_atomic_load(pp + 1, __ATOMIC_RELAXED, __HIP_MEMORY_SCOPE_AGENT); }
        const float mean = s_own * (1.f / DM); const float var = fmaxf(q_own * (1.f / DM) - mean * mean, 0.f);
        L.sx[(4 * 256 + tid) * 2] = mean; L.sx[(4 * 256 + tid) * 2 + 1] = rsqrtf(var + EPS); }
    __syncthreads();
}
struct FEpiOutLN { static constexpr int NST = 0; const float* x; const float* modv; float* h1; bf16_t* u2; const float* gam; const float* bet; LnX L;
    __device__ __forceinline__ bool operator()(f32x4 (&acc)[2][2][4][2], const Unit& u, int wr, int wc, int fr, int fq) const {
        asm volatile("" : "+v"(fr), "+v"(fq));
        const int row0 = u.pm * BM + wr * 64 + fr, col0 = u.pn * BM + wc * 32 + 8 * fq;
        const float* mv = modv + (u.pm * BM / SEQ) * 6144;
        const unsigned ob = (unsigned)(row0 * DM + col0) * 4u;
        const char* xb = (const char*)x; char* hb = (char*)h1; char* ub = (char*)u2;
        float ps[2][4], pq[2][4];
#pragma unroll
        for (int ai = 0; ai < 2; ++ai)
#pragma unroll
            for (int m = 0; m < 4; ++m) { ps[ai][m] = 0.f; pq[ai][m] = 0.f; }
        unsigned obd = ob;
#pragma unroll
        for (int bj = 0; bj < 2; ++bj) { const f32x4 g0 = *(const f32x4*)(mv + 2048 + col0 + bj * HALF), g1 = *(const f32x4*)(mv + 2048 + col0 + bj * HALF + 4);
#pragma unroll
            for (int ai = 0; ai < 2; ++ai) {
#pragma unroll
                for (int m = 0; m < 4; ++m) { const unsigned o = obd + (unsigned)(((ai * HALF + m * 16) * DM + bj * HALF) * 4);
                    const f32x4 v0 = *(const f32x4*)(xb + o) * ALPHA + g0 * acc[ai][bj][m][0], v1 = *(const f32x4*)(xb + o + 16) * ALPHA + g1 * acc[ai][bj][m][1];
                    acc[ai][bj][m][0] = v0; acc[ai][bj][m][1] = v1;
                    ps[ai][m] += ((v0[0] + v0[1]) + (v0[2] + v0[3])) + ((v1[0] + v1[1]) + (v1[2] + v1[3]));
                    pq[ai][m] += ((v0[0] * v0[0] + v0[1] * v0[1]) + (v0[2] * v0[2] + v0[3] * v0[3])) + ((v1[0] * v1[0] + v1[1] * v1[1]) + (v1[2] * v1[2] + v1[3] * v1[3])); }
                asm volatile("" : "+v"(obd) : "v"(pq[ai][3]), "v"(pq[ai][0]), "v"(pq[ai][1]), "v"(pq[ai][2])); } }
        ln_exchange(ps, pq, u, L, wr, wc, fr, fq);
#pragma unroll
        for (int bj = 0; bj < 2; ++bj) { const int cc = col0 + bj * HALF;
            const f32x4 ga0 = *(const f32x4*)(gam + cc), ga1 = *(const f32x4*)(gam + cc + 4), be0 = *(const f32x4*)(bet + cc), be1 = *(const f32x4*)(bet + cc + 4);
#pragma unroll
            for (int ai = 0; ai < 2; ++ai)
#pragma unroll
                for (int m = 0; m < 4; ++m) { const int rl = 128 * ai + 64 * wr + 16 * m + fr; const float mean = L.sx[(4 * 256 + rl) * 2], rstd = L.sx[(4 * 256 + rl) * 2 + 1];
                    const unsigned o = ob + (unsigned)(((ai * HALF + m * 16) * DM + bj * HALF) * 4);
                    acc[ai][bj][m][0] = (acc[ai][bj][m][0] - mean) * rstd * ga0 + be0; acc[ai][bj][m][1] = (acc[ai][bj][m][1] - mean) * rstd * ga1 + be1;
                    *(f32x4*)(hb + o) = acc[ai][bj][m][0]; *(f32x4*)(hb + o + 16) = acc[ai][bj][m][1];
                    asm volatile("" ::: "memory"); } }
#pragma unroll
        for (int bj = 0; bj < 2; ++bj) { const int cc = col0 + bj * HALF;
            const f32x4 sh0 = *(const f32x4*)(mv + 3072 + cc), sh1 = *(const f32x4*)(mv + 3072 + cc + 4), sc0 = *(const f32x4*)(mv + 4096 + cc) + 1.f, sc1 = *(const f32x4*)(mv + 4096 + cc + 4) + 1.f;
#pragma unroll
            for (int ai = 0; ai < 2; ++ai)
#pragma unroll
                for (int m = 0; m < 4; ++m) { const unsigned o = ob + (unsigned)(((ai * HALF + m * 16) * DM + bj * HALF) * 4);
                    *(u32x4*)(ub + (o >> 1)) = pack8(acc[ai][bj][m][0] * sc0 + sh0, acc[ai][bj][m][1] * sc1 + sh1);
                    asm volatile("" ::: "memory"); } }
        return false;
    }
};
struct FEpiDownLN { static constexpr int NST = 0; float* h; const float* modv; const float* b_down; const float* gam; const float* bet; LnX L;
    __device__ __forceinline__ bool operator()(f32x4 (&acc)[2][2][4][2], const Unit& u, int wr, int wc, int fr, int fq) const {
        asm volatile("" : "+v"(fr), "+v"(fq));
        const int row0 = u.pm * BM + wr * 64 + fr, col0 = u.pn * BM + wc * 32 + 8 * fq;
        const float* mv = modv + (u.pm * BM / SEQ) * 6144;
        const unsigned ob = (unsigned)(row0 * DM + col0) * 4u;
        char* hb = (char*)h;
        float ps[2][4], pq[2][4];
#pragma unroll
        for (int ai = 0; ai < 2; ++ai)
#pragma unroll
            for (int m = 0; m < 4; ++m) { ps[ai][m] = 0.f; pq[ai][m] = 0.f; }
        unsigned obd = ob;
#pragma unroll
        for (int bj = 0; bj < 2; ++bj) { const f32x4 g0 = *(const f32x4*)(mv + 5120 + col0 + bj * HALF), g1 = *(const f32x4*)(mv + 5120 + col0 + bj * HALF + 4);
            const f32x4 c0 = g0 * *(const f32x4*)(b_down + col0 + bj * HALF), c1 = g1 * *(const f32x4*)(b_down + col0 + bj * HALF + 4);
#pragma unroll
            for (int ai = 0; ai < 2; ++ai) {
#pragma unroll
                for (int m = 0; m < 4; ++m) { const unsigned o = obd + (unsigned)(((ai * HALF + m * 16) * DM + bj * HALF) * 4);
                    const f32x4 v0 = *(const f32x4*)(hb + o) * ALPHA + (g0 * acc[ai][bj][m][0] + c0), v1 = *(const f32x4*)(hb + o + 16) * ALPHA + (g1 * acc[ai][bj][m][1] + c1);
                    acc[ai][bj][m][0] = v0; acc[ai][bj][m][1] = v1;
                    ps[ai][m] += ((v0[0] + v0[1]) + (v0[2] + v0[3])) + ((v1[0] + v1[1]) + (v1[2] + v1[3]));
                    pq[ai][m] += ((v0[0] * v0[0] + v0[1] * v0[1]) + (v0[2] * v0[2] + v0[3] * v0[3])) + ((v1[0] * v1[0] + v1[1] * v1[1]) + (v1[2] * v1[2] + v1[3] * v1[3]));
                    }
                asm volatile("" : "+v"(obd) : "v"(pq[ai][3]), "v"(pq[ai][0]), "v"(pq[ai][1]), "v"(pq[ai][2])); } }
        ln_exchange(ps, pq, u, L, wr, wc, fr, fq);
#pragma unroll
        for (int bj = 0; bj < 2; ++bj) { const int cc = col0 + bj * HALF;
            const f32x4 ga0 = *(const f32x4*)(gam + cc), ga1 = *(const f32x4*)(gam + cc + 4), be0 = *(const f32x4*)(bet + cc), be1 = *(const f32x4*)(bet + cc + 4);
#pragma unroll
            for (int ai = 0; ai < 2; ++ai)
#pragma unroll
                for (int m = 0; m < 4; ++m) { const int rl = 128 * ai + 64 * wr + 16 * m + fr; const float mean = L.sx[(4 * 256 + rl) * 2], rstd = L.sx[(4 * 256 + rl) * 2 + 1];
                    const unsigned o = ob + (unsigned)(((ai * HALF + m * 16) * DM + bj * HALF) * 4);
                    *(f32x4*)(hb + o) = (acc[ai][bj][m][0] - mean) * rstd * ga0 + be0; *(f32x4*)(hb + o + 16) = (acc[ai][bj][m][1] - mean) * rstd * ga1 + be1;
                    asm volatile("" ::: "memory"); } }
        return false;
    }
};
struct FEpiSideF { static constexpr int NST = 0; bf16_t* side; const float* bias; bf16_t* hm; bf16_t* hg; const float* gm; const float* gg; PG8_LAS float* sx;
    __device__ __forceinline__ bool operator()(f32x4 (&acc)[2][2][4][2], const Unit& u, int wr, int wc, int fr, int fq) const {
        asm volatile("" : "+v"(fr), "+v"(fq));
        const int row0 = u.pm * BM + wr * 64 + fr, cin = wc * 32 + 8 * fq;
        if (u.pn >= 8) {
            f32x4 bv[2][2];
#pragma unroll
            for (int bj = 0; bj < 2; ++bj)
#pragma unroll
                for (int n = 0; n < 2; ++n) bv[bj][n] = *(const f32x4*)(bias + u.pn * BM + cin + bj * HALF + 4 * n);
#pragma unroll
            PG8_FRAG_LOOP { *(u32x4*)(side + (size_t)(row0 + ai * HALF + m * 16) * 4096 + u.pn * BM + cin + bj * HALF) = pack8(acc[ai][bj][m][0] + bv[bj][0], acc[ai][bj][m][1] + bv[bj][1]); }
            return false;
        }
        const bool isg = u.pn >= 4;
        char* hb = (char*)(isg ? hg : hm); const int hc0 = (u.pn & 3) * BM + cin;
        const unsigned ob = (unsigned)(row0 * DM + hc0) * 2u;
        const unsigned OB = (unsigned)ML * DM * 2u;
        int tid = threadIdx.x; asm volatile("" : "+v"(tid));
        unsigned obd = ob;
#pragma unroll
        for (int bj = 0; bj < 2; ++bj)
            {
                float ps[2][4], pq[2][4];
#pragma unroll
                for (int ai = 0; ai < 2; ++ai)
#pragma unroll
                for (int m = 0; m < 4; ++m) { const unsigned o = obd + (unsigned)(((ai * HALF + m * 16) * DM + bj * HALF) * 2);
                    f32x4 f0, f1, b0, b1; unpack8(*(const u32x4*)(hb + o), f0, f1); unpack8(*(const u32x4*)(hb + o + OB), b0, b1);
                    const f32x4 v0 = f0 + b0, v1 = f1 + b1;
                    ps[ai][m] = ((v0[0] + v0[1]) + (v0[2] + v0[3])) + ((v1[0] + v1[1]) + (v1[2] + v1[3]));
                    pq[ai][m] = ((v0[0] * v0[0] + v0[1] * v0[1]) + (v0[2] * v0[2] + v0[3] * v0[3])) + ((v1[0] * v1[0] + v1[1] * v1[1]) + (v1[2] * v1[2] + v1[3] * v1[3])); }
                asm volatile("" : "+v"(obd) : "v"(pq[0][0]), "v"(pq[0][3]), "v"(pq[1][0]), "v"(pq[1][3]));
#pragma unroll
                for (int ai = 0; ai < 2; ++ai)
#pragma unroll
                for (int m = 0; m < 4; ++m) { const float s = sum_rows4(ps[ai][m]), q = sum_rows4(pq[ai][m]);
                    if (fq == 0) { const int row = 128 * ai + 64 * wr + 16 * m + fr; sx[((wc * 2 + bj) * 256 + row) * 2] = s; sx[((wc * 2 + bj) * 256 + row) * 2 + 1] = q; } } }
        __syncthreads();
        { const int rr = tid & 255, bb = tid >> 8; float s = 0.f, q = 0.f, q2 = 0.f;
#pragma unroll
          for (int w = 0; w < 4; ++w) { s += sx[((w * 2 + bb) * 256 + rr) * 2]; q += sx[((w * 2 + bb) * 256 + rr) * 2 + 1]; q2 += sx[((w * 2 + (bb ^ 1)) * 256 + rr) * 2 + 1]; }
          float mean, rstd;
          if (isg) { mean = 0.f; rstd = rsqrtf((q + q2) * (1.f / 256.f) + EPS); }
          else { mean = s * (1.f / 128.f); rstd = rsqrtf(fmaxf(q * (1.f / 128.f) - mean * mean, 0.f) + EPS); }
          __syncthreads();
          sx[(bb * 256 + rr) * 2] = mean; sx[(bb * 256 + rr) * 2 + 1] = rstd; }
        __syncthreads();
        obd = ob;
#pragma unroll
        for (int bj = 0; bj < 2; ++bj) { const float* bp = bias + u.pn * BM + cin + bj * HALF;
            const f32x4 gma0 = *(const f32x4*)(gm + hc0 + bj * HALF), gma1 = *(const f32x4*)(gm + hc0 + bj * HALF + 4), gga0 = *(const f32x4*)(gg + hc0 + bj * HALF), gga1 = *(const f32x4*)(gg + hc0 + bj * HALF + 4);
            const f32x4 ga0 = isg ? gga0 : gma0, ga1 = isg ? gga1 : gma1, bi0 = *(const f32x4*)bp, bi1 = *(const f32x4*)(bp + 4);
            float dep = 0.f;
#pragma unroll
            for (int ai = 0; ai < 2; ++ai) {
#pragma unroll
                for (int m = 0; m < 4; ++m) { const int rl = 128 * ai + 64 * wr + 16 * m + fr; const float mean = sx[(bj * 256 + rl) * 2], rstd = sx[(bj * 256 + rl) * 2 + 1];
                    const unsigned o = obd + (unsigned)(((ai * HALF + m * 16) * DM + bj * HALF) * 2);
                    f32x4 f0, f1, b0, b1; unpack8(*(const u32x4*)(hb + o), f0, f1); unpack8(*(const u32x4*)(hb + o + OB), b0, b1);
                    const f32x4 g0 = acc[ai][bj][m][0] + bi0, g1 = acc[ai][bj][m][1] + bi1;
                    f32x4 o0 = (f0 + b0 - mean) * rstd * ga0, o1 = (f1 + b1 - mean) * rstd * ga1;
#pragma unroll
                    for (int j = 0; j < 4; ++j) { const float s0 = fsig(g0[j]), s1 = fsig(g1[j]); o0[j] *= isg ? g0[j] * s0 : s0; o1[j] *= isg ? g1[j] * s1 : s1; }
                    *(u32x4*)(hb + o) = pack8(o0, o1); dep = o1[3]; } }
            asm volatile("" : "+v"(obd) : "v"(dep)); }
        return false;
    }
};
}

namespace scan {
#define LAS __attribute__((address_space(3)))
typedef short bf16x8 __attribute__((ext_vector_type(8)));
typedef short s16x4 __attribute__((ext_vector_type(4)));
typedef float f32x4 __attribute__((ext_vector_type(4)));
typedef unsigned u32x4 __attribute__((ext_vector_type(4)));
typedef unsigned u32x2 __attribute__((ext_vector_type(2)));
constexpr int RS = 288, RSP = 144, RSG = 80;
constexpr int TILE = 64 * RS;
constexpr int L_T = 0;
constexpr int L_P = 6 * TILE;
constexpr int L_SC = L_P + 64 * RSP;
constexpr int SC_F = 0, SC_QN = 768  , SC_RS = 832  , SC_N = 896  , SC_DEC = 1152  , SC_GB = 1408  ,
              SC_CW = 1536  , SC_END = 2304;
constexpr int L_GW = L_SC + SC_END * 4;
constexpr int L_R = L_GW + 128 * RSG;
constexpr int LDS_BYTES = L_R + 2 * 64 * RSG;
constexpr int XSLOT = 16640;
static_assert(LDS_BYTES <= 160 * 1024 && L_SC % 16 == 0 && L_GW % 16 == 0 && L_R % 16 == 0, "scan LDS");

typedef float f32x2_t __attribute__((ext_vector_type(2))); typedef __bf16 bf16x2_t __attribute__((ext_vector_type(2)));
__device__ __forceinline__ unsigned cvt_pk(float lo, float hi) { f32x2_t v = {lo, hi}; bf16x2_t b = __builtin_convertvector(v, bf16x2_t); return __builtin_bit_cast(unsigned, b); }
__device__ __forceinline__ s16x4 tr16(const LAS unsigned char* p) { return __builtin_bit_cast(s16x4, __builtin_amdgcn_ds_read_tr16_b64_v4i16((LAS s16x4*)p)); }
__device__ __forceinline__ bf16x8 cat4(s16x4 a, s16x4 b) { return (bf16x8){a[0], a[1], a[2], a[3], b[0], b[1], b[2], b[3]}; }
__device__ __forceinline__ void unpack8f(u32x4 w, float* v) {
    v[0] = __uint_as_float(w.x << 16); v[1] = __uint_as_float(w.x & 0xffff0000u); v[2] = __uint_as_float(w.y << 16); v[3] = __uint_as_float(w.y & 0xffff0000u);
    v[4] = __uint_as_float(w.z << 16); v[5] = __uint_as_float(w.z & 0xffff0000u); v[6] = __uint_as_float(w.w << 16); v[7] = __uint_as_float(w.w & 0xffff0000u); }
__device__ __forceinline__ float fsilu(float x) { return x * __builtin_amdgcn_rcpf(1.f + __expf(-x)); }
template <int CTRL, int RMASK> __device__ __forceinline__ float dpp_f(float old, float x) { return __int_as_float(__builtin_amdgcn_update_dpp(__float_as_int(old), __float_as_int(x), CTRL, RMASK, 0xf, false)); }
__device__ __forceinline__ float scan_sum64(float x) {
    x += dpp_f<0x111, 0xf>(0.f, x); x += dpp_f<0x112, 0xf>(0.f, x); x += dpp_f<0x114, 0xf>(0.f, x); x += dpp_f<0x118, 0xf>(0.f, x);
    x += dpp_f<0x142, 0xa>(0.f, x); x += dpp_f<0x143, 0xc>(0.f, x); return x; }
__device__ __forceinline__ float scan_max64(float x) {
    const float NI = -__builtin_inff();
    x = fmaxf(x, dpp_f<0x111, 0xf>(NI, x)); x = fmaxf(x, dpp_f<0x112, 0xf>(NI, x)); x = fmaxf(x, dpp_f<0x114, 0xf>(NI, x)); x = fmaxf(x, dpp_f<0x118, 0xf>(NI, x));
    x = fmaxf(x, dpp_f<0x142, 0xa>(NI, x)); x = fmaxf(x, dpp_f<0x143, 0xc>(NI, x)); return x; }
__device__ __forceinline__ float lane63(float x) { return __int_as_float(__builtin_amdgcn_readlane(__float_as_int(x), 63)); }

template <int V> struct IC { static constexpr int value = V; };
struct Args {
    const bf16_t* P; int ld, pad;
    const float* small;
    const float* conv_qk;
    const float* gw_f; const float* gb_f; const float* gw_b; const float* gb_b;
    bf16_t* hout;
    unsigned char* xbuf; unsigned* xflag;
};

template <bool GLA>
__device__ __forceinline__ void scan_item(LAS unsigned char* lds, const Args& a, const int item) {
    int tid_ = threadIdx.x; asm volatile("" : "+v"(tid_));
    const int tid = tid_, lane = tid & 63, wid = __builtin_amdgcn_readfirstlane(tid >> 6), c = lane & 15, g = lane >> 4;
    LAS float* sc = (LAS float*)(lds + L_SC);
    int b, h, dir, half = 0;
    if (GLA) { half = item & 1; dir = (item >> 1) & 1; h = (item >> 2) & 3; b = item >> 4; } else { dir = item & 1; h = (item >> 1) & 7; b = item >> 4; }
    const int colq = h * 128, colk = GLA ? 512 + h * 128 : 1024 + h * 128, colv = GLA ? 1024 + h * 256 + half * 128 : 2048 + h * 128;
    const int ocol = GLA ? h * 256 + half * 128 : h * 128;
    bf16_t* hout = a.hout + (size_t)dir * ML * DM;
    const float* gw = dir ? a.gw_b : a.gw_f; const float* gbp = dir ? a.gb_b : a.gb_f;

    for (int i = tid; i < 256; i += 512) sc[SC_N + i] = 0.f;
    if (GLA) {
        for (int i = tid; i < 2048; i += 512) { const int d = i >> 4, k = i & 15; const float v = gw[k * 512 + h * 128 + d] * 1.4426950408889634f; const bf16_t hv = f2bf(v), lv = f2bf(v - bf2f(hv));
            *(LAS bf16_t*)(lds + L_GW + d * RSG + k * 2) = hv; *(LAS bf16_t*)(lds + L_GW + d * RSG + 32 + k * 2) = lv; }
        if (tid < 128) sc[SC_GB + tid] = gbp[h * 128 + tid] * 1.4426950408889634f;
    } else if (tid < 256) { const int e = tid & 127, isk = tid >> 7; const int ch = (isk ? 1024 : 0) + h * 128 + e;
        const float w0 = a.conv_qk[ch] * 1.4426950408889634f, w1 = a.conv_qk[2048 + ch] * 1.4426950408889634f, w2 = a.conv_qk[4096 + ch] * 1.4426950408889634f;
        sc[SC_CW + (isk * 3 + 0) * 128 + e] = dir ? w2 : w0; sc[SC_CW + (isk * 3 + 1) * 128 + e] = w1; sc[SC_CW + (isk * 3 + 2) * 128 + e] = dir ? w0 : w2; }

#define SCAN_ROW(cc_, p_, rowv) do { const int seg_ = (cc_) < 4 ? 0 : 1; const int T_ = seg_ ? SEQ : CTX; const int row0_ = seg_ ? b * SEQ : ML + b * CTX; \
        int pp_ = (p_); pp_ = pp_ < 0 ? 0 : (pp_ > T_ - 1 ? T_ - 1 : pp_); const int t_ = dir ? (T_ - 1 - pp_) : pp_; rowv = row0_ + t_; } while (0)
#define SCAN_CI(cc_) ((cc_) < 4 ? (cc_) : (cc_) - 4)

    if (wid >= 4) {
        const int ptid = tid - 256, pw = wid - 4, cg = ptid & 15;
        __builtin_amdgcn_s_setprio(1);
        u32x4 rawvS[2][4];
        u32x4 rawmS[2][10]; u32x2 rawqS[2][8], rawkS[2][8];
        float m_run = 0.f, pre_liS[2] = {0.f, 0.f}, pre_lfS[2] = {0.f, 0.f};
        f32x4 pre_rS[2][4];
#pragma unroll
        for (int i = 0; i < 4; ++i) { pre_rS[0][i] = (f32x4){0.f, 0.f, 0.f, 0.f}; pre_rS[1][i] = (f32x4){0.f, 0.f, 0.f, 0.f}; }
        const int which = pw >> 1, rg = (ptid >> 4) & 7;
        if (GLA) {
            u32x4 vr[2][4]; u32x2 qr[2][4], kr[2][4]; f32x4 prr[4];
#pragma unroll
            for (int i = 0; i < 4; ++i) prr[i] = (f32x4){0.f, 0.f, 0.f, 0.f};
            const char* pbG = (const char*)a.P; const unsigned ldbG = (unsigned)a.ld * 2u;
#define GLA_GV(S_, cc_) do { const int ci_ = SCAN_CI(cc_); _Pragma("unroll") for (int k_ = 0; k_ < 4; ++k_) { int row; SCAN_ROW(cc_, ci_ * 64 + (ptid >> 4) + 16 * k_, row); \
                vr[S_][k_] = *(const u32x4*)(pbG + ((unsigned)row * ldbG + (unsigned)(colv + cg * 8) * 2u)); } } while (0)
#define GLA_GQK(S_, cc_) do { const int ci_ = SCAN_CI(cc_); const bool sq_ = (cc_) >= 4; _Pragma("unroll") for (int tl_ = 0; tl_ < 4; ++tl_) { int row; SCAN_ROW(cc_, ci_ * 64 + 16 * tl_ + c, row); \
                const unsigned ro_ = (unsigned)row * ldbG + (unsigned)(16 * (4 * half + pw) + 4 * g) * 2u; \
                if (sq_) qr[S_][tl_] = *(const u32x2*)(pbG + (ro_ + (unsigned)colq * 2u)); kr[S_][tl_] = *(const u32x2*)(pbG + (ro_ + (unsigned)colk * 2u)); } } while (0)
#define GLA_GR(cc_) do { if (pw == 0) { const int ci_ = SCAN_CI(cc_); int row; SCAN_ROW(cc_, ci_ * 64 + lane, row); const char* sb_ = (const char*)a.small; const unsigned so_ = (unsigned)row * 256u; \
                _Pragma("unroll") for (int i_ = 0; i_ < 4; ++i_) prr[i_] = *(const f32x4*)(sb_ + (so_ + (unsigned)(32 + dir * 16 + 4 * i_) * 4u)); } } while (0)
            auto grw = [&](const int buf) __attribute__((always_inline)) {
                if (pw == 0) {
                    unsigned hi[8], lo[8];
#pragma unroll
                    for (int i = 0; i < 4; ++i) { const f32x4 v = prr[i]; const unsigned h0 = cvt_pk(v[0], v[1]), h1 = cvt_pk(v[2], v[3]);
                        hi[2 * i] = h0; hi[2 * i + 1] = h1;
                        lo[2 * i] = cvt_pk(v[0] - __uint_as_float(h0 << 16), v[1] - __uint_as_float(h0 & 0xffff0000u)); lo[2 * i + 1] = cvt_pk(v[2] - __uint_as_float(h1 << 16), v[3] - __uint_as_float(h1 & 0xffff0000u)); }
                    LAS unsigned char* rp = lds + L_R + buf * (64 * RSG) + lane * RSG;
                    *(LAS u32x4*)rp = (u32x4){hi[0], hi[1], hi[2], hi[3]}; *(LAS u32x4*)(rp + 16) = (u32x4){hi[4], hi[5], hi[6], hi[7]};
                    *(LAS u32x4*)(rp + 32) = (u32x4){lo[0], lo[1], lo[2], lo[3]}; *(LAS u32x4*)(rp + 48) = (u32x4){lo[4], lo[5], lo[6], lo[7]}; }
            };
            auto produce = [&](auto setc, const int cn) __attribute__((always_inline)) {
                constexpr int S = decltype(setc)::value;
                const bool sq = cn >= 4; const int pn = cn & 1, dt = 4 * half + pw;
                unsigned char* xo = a.xbuf + (size_t)(((item * 8) + (cn & 7)) * XSLOT);
                const LAS unsigned char* gwb = lds + L_GW + (16 * dt + c) * RSG + 16 * (g & 1);
                const bf16x8 A1 = *(const LAS bf16x8*)gwb, A2 = *(const LAS bf16x8*)(gwb + 32);
                const f32x4 gbv = *(const LAS f32x4*)(sc + SC_GB + 16 * dt + 4 * g);
                const LAS unsigned char* rb = lds + L_R + pn * (64 * RSG) + c * RSG + 16 * g;
                f32x4 x[4];
#pragma unroll
                for (int tl = 0; tl < 4; ++tl) {
                    const bf16x8 B = *(const LAS bf16x8*)(rb + tl * 16 * RSG);
                    f32x4 acc = __builtin_amdgcn_mfma_f32_16x16x32_bf16(A1, B, gbv, 0, 0, 0);
                    acc = __builtin_amdgcn_mfma_f32_16x16x32_bf16(A2, B, acc, 0, 0, 0);
#pragma unroll
                    for (int i = 0; i < 4; ++i) { float v = __builtin_amdgcn_logf(1.f + __builtin_amdgcn_exp2f(-fmaxf(acc[i], -115.f))) * -0.0625f;
                        v += dpp_f<0x111, 0xf>(0.f, v); v += dpp_f<0x112, 0xf>(0.f, v); v += dpp_f<0x114, 0xf>(0.f, v); v += dpp_f<0x118, 0xf>(0.f, v);
                        acc[i] = v; }
                    x[tl] = acc;
                }
                f32x4 off = (f32x4){0.f, 0.f, 0.f, 0.f};
#pragma unroll
                for (int tl = 0; tl < 4; ++tl) { f32x4 tot;
#pragma unroll
                    for (int i = 0; i < 4; ++i) tot[i] = dpp_f<0x15F, 0xf>(0.f, x[tl][i]);
                    x[tl] += off; off += tot; }
                if (c == 0) { f32x4 dec;
#pragma unroll
                    for (int i = 0; i < 4; ++i) dec[i] = __builtin_amdgcn_exp2f(off[i]);
                    *(f32x4*)(xo + 16384 + (16 * pw + 4 * g) * 4) = dec; }
                const f32x4 offq = off + 3.5f;
#pragma unroll
                for (int tl = 0; tl < 4; ++tl) {
                    const int t = 16 * tl + c;
                    if (sq) { const u32x2 qw = qr[S][tl]; const f32x4 eq = x[tl] - offq;
                        const float q0 = __uint_as_float(qw.x << 16), q1 = __uint_as_float(qw.x & 0xffff0000u), q2 = __uint_as_float(qw.y << 16), q3 = __uint_as_float(qw.y & 0xffff0000u);
                        u32x2 w; w.x = cvt_pk(q0 * __builtin_amdgcn_exp2f(fminf(eq[0], 110.f)), q1 * __builtin_amdgcn_exp2f(fminf(eq[1], 110.f)));
                        w.y = cvt_pk(q2 * __builtin_amdgcn_exp2f(fminf(eq[2], 110.f)), q3 * __builtin_amdgcn_exp2f(fminf(eq[3], 110.f)));
                        *(u32x2*)(xo + t * 128 + (16 * pw + 4 * g) * 2) = w; }
                    { const u32x2 kw = kr[S][tl]; const f32x4 ek = off - x[tl];
                        const float k0 = __uint_as_float(kw.x << 16), k1 = __uint_as_float(kw.x & 0xffff0000u), k2 = __uint_as_float(kw.y << 16), k3 = __uint_as_float(kw.y & 0xffff0000u);
                        u32x2 w; w.x = cvt_pk(k0 * __builtin_amdgcn_exp2f(ek[0]), k1 * __builtin_amdgcn_exp2f(ek[1])); w.y = cvt_pk(k2 * __builtin_amdgcn_exp2f(ek[2]), k3 * __builtin_amdgcn_exp2f(ek[3]));
                        *(u32x2*)(xo + 8192 + t * 128 + (16 * pw + 4 * g) * 2) = w; }
                }
            };
            u32x4 cq[4], ck[4]; f32x4 cd = (f32x4){0.f, 0.f, 0.f, 0.f};
            const int crow = ptid >> 2, cpc = ptid & 3;
            auto cload = [&](const int cn) __attribute__((always_inline)) {
                const unsigned char* xi = a.xbuf + (size_t)(((((item & ~1) | (cpc >> 1)) * 8) + (cn & 7)) * XSLOT) + crow * 128 + (cpc & 1) * 64;
                if (cn >= 4) {
#pragma unroll
                    for (int k = 0; k < 4; ++k) cq[k] = *(const u32x4*)(xi + 16 * k); }
#pragma unroll
                for (int k = 0; k < 4; ++k) ck[k] = *(const u32x4*)(xi + 8192 + 16 * k);
                if (ptid < 32) cd = *(const f32x4*)(a.xbuf + (size_t)(((((item & ~1) | (ptid >> 4)) * 8) + (cn & 7)) * XSLOT) + 16384 + (ptid & 15) * 16);
            };
            auto cstore = [&](auto setc, const int cn) __attribute__((always_inline)) {
                constexpr int S = decltype(setc)::value; const int pn = cn & 1;
                LAS unsigned char* tq = lds + L_T + pn * 3 * TILE; LAS unsigned char* tk = tq + TILE; LAS unsigned char* tv = tq + 2 * TILE;
                if (cn >= 4) {
#pragma unroll
                    for (int k = 0; k < 4; ++k) *(LAS u32x4*)(tq + crow * RS + cpc * 64 + 16 * k) = cq[k]; }
#pragma unroll
                for (int k = 0; k < 4; ++k) *(LAS u32x4*)(tk + crow * RS + cpc * 64 + 16 * k) = ck[k];
#pragma unroll
                for (int k = 0; k < 4; ++k) *(LAS u32x4*)(tv + ((ptid >> 4) + 16 * k) * RS + cg * 16) = vr[S][k];
                if (ptid < 32) *(LAS f32x4*)(sc + SC_DEC + pn * 128 + 64 * (ptid >> 4) + 4 * (ptid & 15)) = cd;
            };
            unsigned flv = 0u;
            auto xpub = [&](const unsigned pubv, const unsigned target, const bool inval) __attribute__((always_inline)) {
                if (ptid == 0) { __hip_atomic_store(a.xflag + item * 64, pubv, __ATOMIC_RELAXED, __HIP_MEMORY_SCOPE_AGENT);
                    if (flv < target) { unsigned sp = 0; while (__hip_atomic_load(a.xflag + (item ^ 1) * 64, __ATOMIC_RELAXED, __HIP_MEMORY_SCOPE_AGENT) < target) { __builtin_amdgcn_s_sleep(1); if (++sp > (1u << 22)) break; } }
                    if (inval) { __builtin_amdgcn_fence(__ATOMIC_ACQUIRE, "agent"); asm volatile("s_waitcnt vmcnt(0)" ::: "memory"); } }
            };
            GLA_GV(0, 0); GLA_GQK(0, 0); GLA_GR(0); GLA_GV(1, 1); GLA_GQK(1, 1);
            grw(0); GLA_GR(1);
            __syncthreads();
            produce(IC<0>{}, 0); GLA_GQK(0, 2);
            grw(1); GLA_GR(2);
            __syncthreads();
            produce(IC<1>{}, 1); GLA_GQK(1, 3);
            grw(0); GLA_GR(3);
            __syncthreads();
            produce(IC<0>{}, 2); GLA_GQK(0, 4);
            grw(1); GLA_GR(4);
            asm volatile("s_waitcnt vmcnt(0)" ::: "memory");
            __syncthreads();
            flv = 0u; xpub(3u, 3u, true);
            __syncthreads();
            cload(0); asm volatile("s_waitcnt vmcnt(0)" ::: "memory"); cstore(IC<0>{}, 0); GLA_GV(0, 2);
            auto gstep = [&](auto setc, const int cn) __attribute__((always_inline)) {
                constexpr int S = decltype(setc)::value;
                if (ptid == 0) flv = __hip_atomic_load(a.xflag + (item ^ 1) * 64, __ATOMIC_RELAXED, __HIP_MEMORY_SCOPE_AGENT);
                if (cn + 1 < 36) cload(cn + 1);
                if (cn + 3 < 36) produce(IC<S ^ 1>{}, cn + 3);
                asm volatile("s_waitcnt vmcnt(0)" ::: "memory");
                if (cn + 1 < 36) cstore(IC<S ^ 1>{}, cn + 1);
            };
            auto gpre = [&](auto setc, const int cn) __attribute__((always_inline)) {
                constexpr int S = decltype(setc)::value;
                GLA_GQK(S ^ 1, cn + 5); GLA_GV(S ^ 1, cn + 3);
                grw(S); GLA_GR(cn + 5);
            };
            for (int cc = 0; cc < 36; cc += 2) {
                __syncthreads();
                gstep(IC<0>{}, cc);
                __syncthreads();
                xpub((unsigned)(cc + 4 < 36 ? cc + 4 : 36), (unsigned)(cc + 3 < 36 ? cc + 3 : 36), (cc % 6) == 0);
                gpre(IC<0>{}, cc);
                __syncthreads();
                gstep(IC<1>{}, cc + 1);
                __syncthreads();
                xpub((unsigned)(cc + 5 < 36 ? cc + 5 : 36), (unsigned)(cc + 4 < 36 ? cc + 4 : 36), ((cc + 1) % 6) == 0);
                gpre(IC<1>{}, cc + 1);
            }
#undef GLA_GV
#undef GLA_GQK
#undef GLA_GR
        } else {
#define SCAN_ISSUE(S_, cc_) do { const int ci_ = SCAN_CI(cc_); const bool sq_ = (cc_) >= 4; const char* pb_ = (const char*)a.P; const unsigned ldb_ = (unsigned)a.ld * 2u; \
        _Pragma("unroll") for (int k_ = 0; k_ < 4; ++k_) { int row; SCAN_ROW(cc_, ci_ * 64 + (ptid >> 4) + 16 * k_, row); rawvS[S_][k_] = *(const u32x4*)(pb_ + ((unsigned)row * ldb_ + (unsigned)(colv + cg * 8) * 2u)); } \
        if (!GLA) { if (which || sq_) { _Pragma("unroll") for (int j_ = 0; j_ < 10; ++j_) { int row; SCAN_ROW(cc_, ci_ * 64 + 8 * rg - 1 + j_, row); \
                rawmS[S_][j_] = *(const u32x4*)(pb_ + ((unsigned)row * ldb_ + (unsigned)((which ? colk : colq) + cg * 8) * 2u)); } } } \
        else { _Pragma("unroll") for (int tl_ = 0; tl_ < 4; ++tl_) { int row; SCAN_ROW(cc_, ci_ * 64 + 16 * tl_ + c, row); const unsigned ro_ = (unsigned)row * ldb_ + (unsigned)(32 * pw + 4 * g) * 2u; \
                _Pragma("unroll") for (int d2_ = 0; d2_ < 2; ++d2_) { if (sq_) rawqS[S_][tl_ * 2 + d2_] = *(const u32x2*)(pb_ + (ro_ + (unsigned)(colq + 16 * d2_) * 2u)); rawkS[S_][tl_ * 2 + d2_] = *(const u32x2*)(pb_ + (ro_ + (unsigned)(colk + 16 * d2_) * 2u)); } } } } while (0)
#define SCAN_GATES(S_, cc_) do { if (pw == 0) { const int ci_ = SCAN_CI(cc_); int row; SCAN_ROW(cc_, ci_ * 64 + lane, row); \
        const char* sb_ = (const char*)a.small; const unsigned so_ = (unsigned)row * 256u; \
        if (!GLA) { pre_liS[S_] = *(const float*)(sb_ + (so_ + (unsigned)(dir * 8 + h) * 4u)); pre_lfS[S_] = *(const float*)(sb_ + (so_ + (unsigned)(16 + dir * 8 + h) * 4u)); } \
        else { _Pragma("unroll") for (int i_ = 0; i_ < 4; ++i_) pre_rS[S_][i_] = *(const f32x4*)(sb_ + (so_ + (unsigned)(32 + dir * 16 + 4 * i_) * 4u)); } } } while (0)
        auto mprepass = [&](auto setc, const int fs) __attribute__((always_inline)) {
            constexpr int S = decltype(setc)::value; const float pre_li = pre_liS[S], pre_lf = pre_lfS[S];
            if (pw == 0) {
                LAS float* f = sc + SC_F + fs * 256;
                const float li = pre_li, lf = logsigmoidf_(pre_lf);
                const float bs = scan_sum64(lf);
                const float gg = li - bs; const float cm = scan_max64(gg);
                const float M = fmaxf(m_run, cm), M63 = lane63(M), b63 = lane63(bs);
                f[lane] = __expf(fminf(M63 - M, 80.f)) * 0.08838834764831845f;
                f[64 + lane] = __expf(gg - M63);
                f[128 + lane] = __expf(-(bs + M));
                if (lane == 0) f[192] = __expf(m_run - M63);
                m_run = b63 + M63;
            }
        };
        auto rwrite = [&](auto setc, const int buf) __attribute__((always_inline)) {
            constexpr int S = decltype(setc)::value;
            if (pw == 0) {
                unsigned hi[8], lo[8];
#pragma unroll
                for (int i = 0; i < 4; ++i) { const f32x4 v = pre_rS[S][i]; const unsigned h0 = cvt_pk(v[0], v[1]), h1 = cvt_pk(v[2], v[3]);
                    hi[2 * i] = h0; hi[2 * i + 1] = h1;
                    lo[2 * i] = cvt_pk(v[0] - __uint_as_float(h0 << 16), v[1] - __uint_as_float(h0 & 0xffff0000u)); lo[2 * i + 1] = cvt_pk(v[2] - __uint_as_float(h1 << 16), v[3] - __uint_as_float(h1 & 0xffff0000u)); }
                LAS unsigned char* rp = lds + L_R + buf * (64 * RSG) + lane * RSG;
                *(LAS u32x4*)rp = (u32x4){hi[0], hi[1], hi[2], hi[3]}; *(LAS u32x4*)(rp + 16) = (u32x4){hi[4], hi[5], hi[6], hi[7]};
                *(LAS u32x4*)(rp + 32) = (u32x4){lo[0], lo[1], lo[2], lo[3]}; *(LAS u32x4*)(rp + 48) = (u32x4){lo[4], lo[5], lo[6], lo[7]}; }
        };
        auto stage = [&](auto setc, const int cn) __attribute__((always_inline)) {
            constexpr int S = decltype(setc)::value;
            const bool sq = cn >= 4; const int ci = SCAN_CI(cn), T = sq ? SEQ : CTX;
            LAS unsigned char* tq = lds + L_T + (cn & 1) * 3 * TILE; LAS unsigned char* tk = tq + TILE; LAS unsigned char* tv = tq + 2 * TILE;
#pragma unroll
            for (int k = 0; k < 4; ++k) *(LAS u32x4*)(tv + ((ptid >> 4) + 16 * k) * RS + cg * 16) = rawvS[S][k];
            if (!GLA) {
                if (which || sq) {
                    const LAS float* f = sc + SC_F + (cn % 3) * 256 + (which ? 64 : 0);
                    float w0[8], w1[8], w2[8];
#define SCAN_LDW(dst, tap) do { const f32x4 x0_ = *(const LAS f32x4*)(sc + SC_CW + (tap) * 128 + cg * 8), x1_ = *(const LAS f32x4*)(sc + SC_CW + (tap) * 128 + cg * 8 + 4); \
                        dst[0] = x0_[0]; dst[1] = x0_[1]; dst[2] = x0_[2]; dst[3] = x0_[3]; dst[4] = x1_[0]; dst[5] = x1_[1]; dst[6] = x1_[2]; dst[7] = x1_[3]; } while (0)
                    SCAN_LDW(w0, which * 3 + 0); SCAN_LDW(w1, which * 3 + 1); SCAN_LDW(w2, which * 3 + 2);
#undef SCAN_LDW
                    u32x4 r0 = rawmS[S][0], r9 = rawmS[S][9];
                    if (ci * 64 + 8 * rg == 0) r0 = (u32x4){0u, 0u, 0u, 0u};
                    if (ci * 64 + 8 * rg + 8 > T - 1) r9 = (u32x4){0u, 0u, 0u, 0u};
                    float pv[8], cu[8], nx[8];
                    unpack8f(r0, pv); unpack8f(rawmS[S][1], cu);
#pragma unroll
                    for (int j = 0; j < 8; ++j) {
                        unpack8f(j == 7 ? r9 : rawmS[S][j + 2], nx);
                        const int t = 8 * rg + j;
                        const float es = f[t] * 0.6931471805599453f;
                        float x[8];
#pragma unroll
                        for (int e = 0; e < 8; ++e) { const float yl = w1[e] * cu[e] + w0[e] * pv[e] + w2[e] * nx[e];
                            x[e] = (yl * es) * __builtin_amdgcn_rcpf(1.f + __builtin_amdgcn_exp2f(-yl)); }
                        u32x4 w; w.x = cvt_pk(x[0], x[1]); w.y = cvt_pk(x[2], x[3]); w.z = cvt_pk(x[4], x[5]); w.w = cvt_pk(x[6], x[7]);
                        *(LAS u32x4*)((which ? tk : tq) + t * RS + cg * 16) = w;
#pragma unroll
                        for (int e = 0; e < 8; ++e) { pv[e] = cu[e]; cu[e] = nx[e]; }
                    }
                }
            } else {
                const int pn = cn & 1;
#pragma unroll
                for (int d2 = 0; d2 < 2; ++d2) {
                    const int dt = 2 * pw + d2;
                    const LAS unsigned char* gwb = lds + L_GW + (16 * dt + c) * RSG + 16 * (g & 1);
                    const bf16x8 A1 = *(const LAS bf16x8*)gwb, A2 = *(const LAS bf16x8*)(gwb + 32);
                    const f32x4 gbv = *(const LAS f32x4*)(sc + SC_GB + 16 * dt + 4 * g);
                    const LAS unsigned char* rb = lds + L_R + pn * (64 * RSG) + c * RSG + 16 * g;
                    f32x4 x[4];
#pragma unroll
                    for (int tl = 0; tl < 4; ++tl) {
                        const bf16x8 B = *(const LAS bf16x8*)(rb + tl * 16 * RSG);
                        f32x4 acc = __builtin_amdgcn_mfma_f32_16x16x32_bf16(A1, B, gbv, 0, 0, 0);
                        acc = __builtin_amdgcn_mfma_f32_16x16x32_bf16(A2, B, acc, 0, 0, 0);
#pragma unroll
                        for (int i = 0; i < 4; ++i) { float v = __builtin_amdgcn_logf(1.f + __builtin_amdgcn_exp2f(-fmaxf(acc[i], -115.f))) * -0.0625f;
                            v += dpp_f<0x111, 0xf>(0.f, v); v += dpp_f<0x112, 0xf>(0.f, v); v += dpp_f<0x114, 0xf>(0.f, v); v += dpp_f<0x118, 0xf>(0.f, v);
                            acc[i] = v; }
                        x[tl] = acc;
                    }
                    f32x4 off = (f32x4){0.f, 0.f, 0.f, 0.f};
#pragma unroll
                    for (int tl = 0; tl < 4; ++tl) { f32x4 tot;
#pragma unroll
                        for (int i = 0; i < 4; ++i) tot[i] = dpp_f<0x15F, 0xf>(0.f, x[tl][i]);
                        x[tl] += off; off += tot; }
                    if (c == 0) { f32x4 dec;
#pragma unroll
                        for (int i = 0; i < 4; ++i) dec[i] = __builtin_amdgcn_exp2f(off[i]);
                        *(LAS f32x4*)(sc + SC_DEC + pn * 128 + 16 * dt + 4 * g) = dec; }
                    const f32x4 offq = off + 3.5f;
#pragma unroll
                    for (int tl = 0; tl < 4; ++tl) {
                        const int t = 16 * tl + c;
                        if (sq) { const u32x2 qw = rawqS[S][tl * 2 + d2]; const f32x4 eq = x[tl] - offq;
                            const float q0 = __uint_as_float(qw.x << 16), q1 = __uint_as_float(qw.x & 0xffff0000u), q2 = __uint_as_float(qw.y << 16), q3 = __uint_as_float(qw.y & 0xffff0000u);
                            u32x2 w; w.x = cvt_pk(q0 * __builtin_amdgcn_exp2f(fminf(eq[0], 110.f)), q1 * __builtin_amdgcn_exp2f(fminf(eq[1], 110.f)));
                            w.y = cvt_pk(q2 * __builtin_amdgcn_exp2f(fminf(eq[2], 110.f)), q3 * __builtin_amdgcn_exp2f(fminf(eq[3], 110.f)));
                            *(LAS u32x2*)(tq + t * RS + (16 * dt + 4 * g) * 2) = w; }
                        { const u32x2 kw = rawkS[S][tl * 2 + d2]; const f32x4 ek = off - x[tl];
                            const float k0 = __uint_as_float(kw.x << 16), k1 = __uint_as_float(kw.x & 0xffff0000u), k2 = __uint_as_float(kw.y << 16), k3 = __uint_as_float(kw.y & 0xffff0000u);
                            u32x2 w; w.x = cvt_pk(k0 * __builtin_amdgcn_exp2f(ek[0]), k1 * __builtin_amdgcn_exp2f(ek[1])); w.y = cvt_pk(k2 * __builtin_amdgcn_exp2f(ek[2]), k3 * __builtin_amdgcn_exp2f(ek[3]));
                            *(LAS u32x2*)(tk + t * RS + (16 * dt + 4 * g) * 2) = w; }
                    }
                }
            }
        };
        auto pstep = [&](auto setc, const int cn) __attribute__((always_inline)) {
            constexpr int S = decltype(setc)::value;
            if (GLA) { rwrite(IC<S ^ 1>{}, (cn + 1) & 1); SCAN_GATES(S ^ 1, cn + 3); }
            else { mprepass(IC<S ^ 1>{}, (cn + 1) % 3); SCAN_GATES(S ^ 1, cn + 3); }
            stage(setc, cn);
            SCAN_ISSUE(S, cn + 2);
        };
        SCAN_ISSUE(0, 0); SCAN_GATES(0, 0); SCAN_ISSUE(1, 1);
        if (GLA) rwrite(IC<0>{}, 0); else mprepass(IC<0>{}, 0);
        SCAN_GATES(1, 1); SCAN_GATES(0, 2);
        __syncthreads();
        pstep(IC<0>{}, 0);
        for (int cc = 0; cc < 36; cc += 2) {
            __syncthreads();
            pstep(IC<1>{}, cc + 1);
            __syncthreads();
            __syncthreads();
            if (cc + 2 < 36) pstep(IC<0>{}, cc + 2);
            __syncthreads();
        }
        }
        __builtin_amdgcn_s_setprio(0);
#undef SCAN_ISSUE
#undef SCAN_GATES
    } else {
        f32x4 Cst[2][8]; f32x4 nst[2];
#pragma unroll
        for (int hv = 0; hv < 2; ++hv)
#pragma unroll
            for (int j = 0; j < 8; ++j) Cst[hv][j] = (f32x4){0.f, 0.f, 0.f, 0.f};
        nst[0] = (f32x4){0.f, 0.f, 0.f, 0.f}; nst[1] = (f32x4){0.f, 0.f, 0.f, 0.f};
        const int q4 = c >> 2, p4 = c & 3;
        __syncthreads();
        if (GLA) { __syncthreads(); __syncthreads(); __syncthreads(); __syncthreads(); }
        auto cchunk = [&](auto segc, const int cc) __attribute__((always_inline)) {
            constexpr int seg = decltype(segc)::value;
            const int ci = seg ? cc - 4 : cc, T = seg ? SEQ : CTX, par = cc & 1;
            const LAS unsigned char* tq = lds + L_T + par * 3 * TILE; const LAS unsigned char* tk = tq + TILE; const LAS unsigned char* tv = tq + 2 * TILE;
            const LAS float* fset = sc + SC_F + (cc % 3) * 256;
            __syncthreads();
            float dsc = 1.f;
            if (!GLA) { dsc = fset[192];
#pragma unroll
                for (int hv = 0; hv < 2; ++hv)
#pragma unroll
                    for (int j = 0; j < 8; ++j) Cst[hv][j] *= dsc;
                nst[0] *= dsc; nst[1] *= dsc;
            } else {
#pragma unroll
                for (int j = 0; j < 8; ++j) { const f32x4 dv = *(const LAS f32x4*)(sc + SC_DEC + par * 128 + 32 * (j >> 1) + 8 * g + 4 * (j & 1)); Cst[0][j] *= dv; Cst[1][j] *= dv; }
            }
            f32x4 O[2][4];
#pragma unroll
            for (int hv = 0; hv < 2; ++hv)
#pragma unroll
                for (int i = 0; i < 4; ++i) O[hv][i] = (f32x4){0.f, 0.f, 0.f, 0.f};
            bf16x8 vf[2][2], fa[4], fb[4];
#define SCAN_QFRAG(l4_, kk_) (*(const LAS bf16x8*)(tq + (16 * (l4_) + c) * RS + (32 * (kk_) + 8 * g) * 2))
#define SCAN_KROW(st_, kk_) (*(const LAS bf16x8*)(tk + (16 * (st_) + c) * RS + (32 * (kk_) + 8 * g) * 2))
#define SCAN_KT(dst, j_, tt_) do { const LAS unsigned char* kp_ = tk + (32 * (tt_) + 8 * g + q4) * RS + (32 * ((j_) >> 1) + 8 * p4 + 4 * ((j_) & 1)) * 2; dst = cat4(tr16(kp_), tr16(kp_ + 4 * RS)); } while (0)
#define SCAN_SB() __builtin_amdgcn_sched_barrier(0)
#define SCAN_VF() do { _Pragma("unroll") for (int hv = 0; hv < 2; ++hv) _Pragma("unroll") for (int tt = 0; tt < 2; ++tt) { \
                const LAS unsigned char* vp = tv + (32 * tt + 8 * g + q4) * RS + (32 * wid + 16 * hv + 4 * p4) * 2; vf[hv][tt] = cat4(tr16(vp), tr16(vp + 4 * RS)); } } while (0)
            if constexpr (seg != 0) {
                if (!GLA) {
                    const int l = tid >> 2, part = tid & 3; const LAS unsigned char* qp = tq + l * RS + part * 64; const LAS float* np = sc + SC_N + par * 128 + part * 32;
                    float s = 0.f;
#pragma unroll
                    for (int hq = 0; hq < 2; ++hq) { float q[16]; unpack8f(*(const LAS u32x4*)(qp + 32 * hq), q); unpack8f(*(const LAS u32x4*)(qp + 32 * hq + 16), q + 8);
#pragma unroll
                        for (int i = 0; i < 4; ++i) { const f32x4 nv = *(const LAS f32x4*)(np + 16 * hq + 4 * i); s += q[4 * i] * nv[0] + q[4 * i + 1] * nv[1] + q[4 * i + 2] * nv[2] + q[4 * i + 3] * nv[3]; } }
                    s += __shfl_xor(s, 1); s += __shfl_xor(s, 2);
                    if (part == 0) sc[SC_QN + l] = s * dsc;
                }
                const int lt = wid;
                bf16x8 qf[4];
#pragma unroll
                for (int kk = 0; kk < 4; ++kk) qf[kk] = SCAN_QFRAG(lt, kk);
#pragma unroll
                for (int kk = 0; kk < 4; ++kk) fa[kk] = SCAN_KROW(0, kk);
#pragma unroll
                for (int kk = 0; kk < 4; ++kk) fb[kk] = SCAN_KROW(1, kk);
                SCAN_SB();
                f32x4 accs[4];
#pragma unroll
                for (int i = 0; i < 4; ++i) accs[i] = (f32x4){0.f, 0.f, 0.f, 0.f};
#pragma unroll
                for (int kk = 0; kk < 4; ++kk) accs[0] = __builtin_amdgcn_mfma_f32_16x16x32_bf16(fa[kk], qf[kk], accs[0], 0, 0, 0);
                SCAN_SB();
#pragma unroll
                for (int kk = 0; kk < 4; ++kk) fa[kk] = SCAN_KROW(2, kk);
#pragma unroll
                for (int kk = 0; kk < 4; ++kk) accs[1] = __builtin_amdgcn_mfma_f32_16x16x32_bf16(fb[kk], qf[kk], accs[1], 0, 0, 0);
                SCAN_SB();
#pragma unroll
                for (int kk = 0; kk < 4; ++kk) fb[kk] = SCAN_KROW(3, kk);
#pragma unroll
                for (int kk = 0; kk < 4; ++kk) accs[2] = __builtin_amdgcn_mfma_f32_16x16x32_bf16(fa[kk], qf[kk], accs[2], 0, 0, 0);
                SCAN_SB();
#pragma unroll
                for (int i = 0; i < 4; ++i) fa[i] = SCAN_QFRAG(i, 0);
#pragma unroll
                for (int kk = 0; kk < 4; ++kk) accs[3] = __builtin_amdgcn_mfma_f32_16x16x32_bf16(fb[kk], qf[kk], accs[3], 0, 0, 0);
                SCAN_SB();
#pragma unroll
                for (int i = 0; i < 4; ++i) fb[i] = SCAN_QFRAG(i, 1);
                float rs = 0.f;
#pragma unroll
                for (int st = 0; st < 4; ++st) { f32x4 acc = accs[st];
                    int lim = st < lt ? 64 : (st == lt ? c : -1); asm volatile("" : "+v"(lim));
#pragma unroll
                    for (int i = 0; i < 4; ++i) acc[i] = (4 * g + i > lim) ? 0.f : acc[i];
                    rs += (acc[0] + acc[1]) + (acc[2] + acc[3]);
                    u32x2 w; w.x = cvt_pk(acc[0], acc[1]); w.y = cvt_pk(acc[2], acc[3]);
                    *(LAS u32x2*)(lds + L_P + (16 * lt + c) * RSP + (16 * st + 4 * g) * 2) = w;
                }
                if (!GLA) { rs += __shfl_xor(rs, 16); rs += __shfl_xor(rs, 32); if (g == 0) sc[SC_RS + 16 * lt + c] = rs; }
#define SCAN_CF(dst, hv_, kk_) do { u32x4 bw_; bw_.x = cvt_pk(Cst[hv_][2 * (kk_)][0], Cst[hv_][2 * (kk_)][1]); bw_.y = cvt_pk(Cst[hv_][2 * (kk_)][2], Cst[hv_][2 * (kk_)][3]); \
                    bw_.z = cvt_pk(Cst[hv_][2 * (kk_) + 1][0], Cst[hv_][2 * (kk_) + 1][1]); bw_.w = cvt_pk(Cst[hv_][2 * (kk_) + 1][2], Cst[hv_][2 * (kk_) + 1][3]); dst = __builtin_bit_cast(bf16x8, bw_); } while (0)
#define SCAN_2B(fr, kk_) do { bf16x8 c0_, c1_; SCAN_CF(c0_, 0, kk_); SCAN_CF(c1_, 1, kk_); \
                    _Pragma("unroll") for (int i = 0; i < 4; ++i) { O[0][i] = __builtin_amdgcn_mfma_f32_16x16x32_bf16(c0_, fr[i], O[0][i], 0, 0, 0); O[1][i] = __builtin_amdgcn_mfma_f32_16x16x32_bf16(c1_, fr[i], O[1][i], 0, 0, 0); } } while (0)
                SCAN_SB();
                SCAN_2B(fa, 0);
#pragma unroll
                for (int i = 0; i < 4; ++i) fa[i] = SCAN_QFRAG(i, 2);
                SCAN_SB();
                SCAN_2B(fb, 1);
#pragma unroll
                for (int i = 0; i < 4; ++i) fb[i] = SCAN_QFRAG(i, 3);
                SCAN_SB();
                SCAN_2B(fa, 2);
                SCAN_VF();
#pragma unroll
                for (int i = 0; i < 4; ++i) SCAN_KT(fa[i], i >> 1, i & 1);
                SCAN_SB();
                SCAN_2B(fb, 3);
#undef SCAN_2B
#undef SCAN_CF
            } else {
                SCAN_VF();
#pragma unroll
                for (int i = 0; i < 4; ++i) SCAN_KT(fa[i], i >> 1, i & 1);
            }
#define SCAN_3(fr, j0_) do { _Pragma("unroll") for (int i = 0; i < 4; ++i) { Cst[0][(j0_) + (i >> 1)] = __builtin_amdgcn_mfma_f32_16x16x32_bf16(fr[i], vf[0][i & 1], Cst[0][(j0_) + (i >> 1)], 0, 0, 0); \
                Cst[1][(j0_) + (i >> 1)] = __builtin_amdgcn_mfma_f32_16x16x32_bf16(fr[i], vf[1][i & 1], Cst[1][(j0_) + (i >> 1)], 0, 0, 0); } } while (0)
#pragma unroll
            for (int i = 0; i < 4; ++i) SCAN_KT(fb[i], 2 + (i >> 1), i & 1);
            SCAN_SB();
            SCAN_3(fa, 0);
#pragma unroll
            for (int i = 0; i < 4; ++i) SCAN_KT(fa[i], 4 + (i >> 1), i & 1);
            SCAN_SB();
            SCAN_3(fb, 2);
#pragma unroll
            for (int i = 0; i < 4; ++i) SCAN_KT(fb[i], 6 + (i >> 1), i & 1);
            SCAN_SB();
            SCAN_3(fa, 4);
            if (!GLA) {
#pragma unroll
                for (int i = 0; i < 4; ++i) SCAN_KT(fa[i], 2 * wid + (i >> 1), i & 1);
            }
            SCAN_SB();
            SCAN_3(fb, 6);
#undef SCAN_3
            if (!GLA) {
                const bf16x8 ones = (bf16x8){0x3F80, 0x3F80, 0x3F80, 0x3F80, 0x3F80, 0x3F80, 0x3F80, 0x3F80};
#pragma unroll
                for (int i = 0; i < 4; ++i) nst[i >> 1] = __builtin_amdgcn_mfma_f32_16x16x32_bf16(fa[i], ones, nst[i >> 1], 0, 0, 0);
                if (c == 0) {
#pragma unroll
                    for (int j2 = 0; j2 < 2; ++j2) *(LAS f32x4*)(sc + SC_N + (par ^ 1) * 128 + 32 * wid + 8 * g + 4 * j2) = nst[j2]; }
            }
            __syncthreads();
            if constexpr (seg != 0) {
#pragma unroll
                for (int i = 0; i < 4; ++i) fa[i] = *(const LAS bf16x8*)(lds + L_P + (16 * (i >> 1) + c) * RSP + (32 * (i & 1) + 8 * g) * 2);
#pragma unroll
                for (int i = 0; i < 4; ++i) fb[i] = *(const LAS bf16x8*)(lds + L_P + (16 * (2 + (i >> 1)) + c) * RSP + (32 * (i & 1) + 8 * g) * 2);
                SCAN_SB();
#pragma unroll
                for (int i = 0; i < 4; ++i) { O[0][i >> 1] = __builtin_amdgcn_mfma_f32_16x16x32_bf16(vf[0][i & 1], fa[i], O[0][i >> 1], 0, 0, 0); O[1][i >> 1] = __builtin_amdgcn_mfma_f32_16x16x32_bf16(vf[1][i & 1], fa[i], O[1][i >> 1], 0, 0, 0); }
#pragma unroll
                for (int i = 0; i < 4; ++i) { O[0][2 + (i >> 1)] = __builtin_amdgcn_mfma_f32_16x16x32_bf16(vf[0][i & 1], fb[i], O[0][2 + (i >> 1)], 0, 0, 0); O[1][2 + (i >> 1)] = __builtin_amdgcn_mfma_f32_16x16x32_bf16(vf[1][i & 1], fb[i], O[1][2 + (i >> 1)], 0, 0, 0); }
#pragma unroll
                for (int l4 = 0; l4 < 4; ++l4) {
                    const int l = 16 * l4 + c; float rc = 1.f; asm volatile("" : "+v"(rc));
                    if (!GLA) { const float den = fmaxf(fabsf(sc[SC_QN + l] + sc[SC_RS + l]), fset[128 + l]); rc = __builtin_amdgcn_rcpf(den); }
                    const int pp = ci * 64 + l; const int t = dir ? (T - 1 - pp) : pp;
                    const f32x4 oa = O[0][l4] * rc, ob = O[1][l4] * rc;
                    const unsigned a0 = cvt_pk(oa[0], oa[1]), a1 = cvt_pk(oa[2], oa[3]), b0 = cvt_pk(ob[0], ob[1]), b1 = cvt_pk(ob[2], ob[3]);
                    const u32x2 s0 = __builtin_amdgcn_permlane16_swap(a0, b0, false, false), s1 = __builtin_amdgcn_permlane16_swap(a1, b1, false, false);
                    *(u32x4*)((char*)hout + ((unsigned)((b * SEQ + t) * DM + ocol + 32 * wid + 16 * (g & 1) + 8 * (g >> 1)) * 2u)) = (u32x4){s0[0], s1[0], s0[1], s1[1]};
                }
            }
#undef SCAN_QFRAG
#undef SCAN_KROW
#undef SCAN_KT
#undef SCAN_SB
#undef SCAN_VF
        };
        for (int cc = 0; cc < 4; ++cc) cchunk(IC<0>{}, cc);
        for (int cc = 4; cc < 36; ++cc) cchunk(IC<1>{}, cc);
    }
#undef SCAN_ROW
#undef SCAN_CI
}
#undef LAS
}

#include <hip/hip_cooperative_groups.h>
namespace cg = cooperative_groups;
#define LAS __attribute__((address_space(3)))
constexpr int NBLK = 256, NTHR = 512;
constexpr int MISC_OFF = scan::LDS_BYTES > pg8::STAGE_BYTES ? scan::LDS_BYTES : pg8::STAGE_BYTES;
constexpr int MEGA_LDS = MISC_OFF + 64;
constexpr int CW_LN = 16384;
constexpr size_t WS_LNX = 2 * MiB;
constexpr int CW_GX = 32768;
constexpr size_t BIG_GX = 130 * MiB;
constexpr int CW_RANK = 8192;
constexpr int CW_BAR = 4096;
constexpr size_t WS_MODP = 502 * MiB;
struct Params { const float* in[28]; float* out; unsigned char* ws; };
typedef float f32x4v __attribute__((ext_vector_type(4)));
typedef unsigned u32x4v __attribute__((ext_vector_type(4)));

__device__ __forceinline__ void ph_prologue(const Params& p, LAS unsigned char* lds, int c) {
    int tid = threadIdx.x; asm volatile("" : "+v"(tid));
    unsigned char* ws = p.ws;
    LAS float* t = (LAS float*)lds;
    auto wdec = [&](const int it, const float*& s0, const float*& s1, bf16_t*& dp) __attribute__((always_inline)) {
        const float* W; bf16_t* Wt; int ldw, K, srcA, srcB, dst, kb, tl = it;
        if (tl < 2320) { W = p.in[6]; Wt = (bf16_t*)(ws + WS_WIN); ldw = NIN; K = DM; kb = tl / 145; const int nt = tl - kb * 145; int jn;
            if (nt < 48) { srcA = 64 * nt; dst = 64 * nt; }
            else if (nt == 48) { srcA = 4096; dst = 3072; }
            else if ((jn = nt - 49) < 8) { srcA = 4128 + 64 * jn; dst = 3328 + 64 * jn; }
            else if ((jn = nt - 57) < 8) { srcA = 4640 + 64 * jn; dst = 3840 + 64 * jn; }
            else if ((jn = nt - 65) < 16) { srcA = 5152 + 64 * jn; dst = 4352 + 64 * jn; }
            else if ((jn = nt - 81) < 16) { srcA = 3072 + 64 * jn; dst = 5376 + 64 * jn; }
            else if ((jn = nt - 97) < 16) { srcA = 6176 + 64 * jn; dst = 6400 + 64 * jn; }
            else if ((jn = nt - 113) < 16) { srcA = 7232 + 64 * jn; dst = 7424 + 64 * jn; }
            else { jn = nt - 129; srcA = 8256 + 64 * jn; dst = 8448 + 64 * jn; }
            srcB = nt == 48 ? 7200 : srcA + 32; }
        else { int ntn;
            if ((tl -= 2320) < 256) { W = p.in[15]; Wt = (bf16_t*)(ws + WS_WBM); ldw = DM; K = DM; ntn = 16; }
            else if ((tl -= 256) < 256) { W = p.in[16]; Wt = (bf16_t*)(ws + WS_WBG); ldw = DM; K = DM; ntn = 16; }
            else if ((tl -= 256) < 256) { W = p.in[17]; Wt = (bf16_t*)(ws + WS_WOUT); ldw = DM; K = DM; ntn = 16; }
            else if ((tl -= 256) < 1408) { W = p.in[20]; Wt = (bf16_t*)(ws + WS_WUP); ldw = 2 * DFF; K = DM; ntn = 88; }
            else { tl -= 1408; W = p.in[24]; Wt = (bf16_t*)(ws + WS_WDN); ldw = DM; K = DFF; ntn = 16; }
            kb = tl / ntn; srcA = 64 * (tl - kb * ntn); srcB = srcA + 32; dst = srcA; }
        const int k0 = kb * 64, n = 4 * (tid & 15), kk = tid >> 4;
        const float* sp = W + (size_t)(k0 + kk) * ldw + (n < 32 ? srcA + n : srcB + n - 32);
        s0 = sp; s1 = sp + (size_t)32 * ldw;
        dp = Wt + (size_t)(dst + (tid >> 3)) * K + k0 + 8 * (tid & 7);
    };
    { const float* s0; const float* s1; bf16_t* dp; f32x4v pv0 = (f32x4v){0.f, 0.f, 0.f, 0.f}, pv1 = pv0;
      if (c < 5200) { wdec(c, s0, s1, dp); pv0 = *(const f32x4v*)s0; pv1 = *(const f32x4v*)s1; }
      int ib = 0;
      for (int it = c; it < 5200; it += NBLK, ++ib) {
        bf16_t* dcur = dp; const f32x4v v0 = pv0, v1 = pv1; LAS float* tb = t + (ib & 1) * (64 * 65);
        if (it + NBLK < 5200) { wdec(it + NBLK, s0, s1, dp); pv0 = *(const f32x4v*)s0; pv1 = *(const f32x4v*)s1; }
        { const int k = tid >> 4, n = 4 * (tid & 15);
          tb[k * 65 + n] = v0[0]; tb[k * 65 + n + 1] = v0[1]; tb[k * 65 + n + 2] = v0[2]; tb[k * 65 + n + 3] = v0[3];
          tb[(k + 32) * 65 + n] = v1[0]; tb[(k + 32) * 65 + n + 1] = v1[1]; tb[(k + 32) * 65 + n + 2] = v1[2]; tb[(k + 32) * 65 + n + 3] = v1[3]; }
        __syncthreads();
        { const int n = tid >> 3, kq = tid & 7; const LAS float* tp = tb + (8 * kq) * 65 + n;
          u32x4v o; o.x = scan::cvt_pk(tp[0], tp[65]); o.y = scan::cvt_pk(tp[130], tp[195]); o.z = scan::cvt_pk(tp[260], tp[325]); o.w = scan::cvt_pk(tp[390], tp[455]);
          *(u32x4v*)dcur = o; }
      }
      __syncthreads(); }
    { u32x4v* z = (u32x4v*)((bf16_t*)(ws + WS_WIN) + (size_t)3136 * DM);
      for (int i = c * NTHR + tid; i < 24576; i += NBLK * NTHR) z[i] = (u32x4v){0u, 0u, 0u, 0u}; }
    { float* bp = (float*)(ws + WS_BIN); const float* b_in = p.in[7];
      for (int j = c * NTHR + tid; j < NINP; j += NBLK * NTHR) { int s;
        if (j < 3072) s = j; else if (j < 3104) s = 4096 + (j - 3072); else if (j < 3136) s = 7200 + (j - 3104); else if (j < 3328) s = -1;
        else if (j < 3840) s = 4128 + (j - 3328); else if (j < 4352) s = 4640 + (j - 3840); else if (j < 5376) s = 5152 + (j - 4352);
        else if (j < 6400) s = 3072 + (j - 5376); else if (j < 7424) s = 6176 + (j - 6400); else if (j < 8448) s = 7232 + (j - 7424); else s = 8256 + (j - 8448);
        bp[j] = s >= 0 ? b_in[s] : 0.f; } }
    for (int item = c; item < 192; item += NBLK) {
        const int cb = item % 12, ks = item / 12; LAS float* sl = (LAS float*)lds;
        for (int i = tid; i < 17 * 64; i += NTHR) { const int r = i >> 6, k = i & 63; const float cv = r < 16 ? p.in[1][r * DM + ks * 64 + k] : p.in[3][ks * 64 + k]; sl[i] = siluf_(cv); }
        __syncthreads();
        const int col = cb * 512 + tid; float acc[17];
#pragma unroll
        for (int r = 0; r < 17; ++r) acc[r] = 0.f;
        const float* wm = p.in[4] + (size_t)(ks * 64) * 6144 + col;
        for (int k = 0; k < 64; ++k) { const float w = wm[(size_t)k * 6144];
#pragma unroll
            for (int r = 0; r < 17; ++r) acc[r] += sl[r * 64 + k] * w; }
        float* mp = (float*)(ws + WS_MODP) + (size_t)ks * 17 * 6144 + col;
#pragma unroll
        for (int r = 0; r < 17; ++r) mp[(size_t)r * 6144] = acc[r];
        __syncthreads();
    }
}
__device__ __forceinline__ void ph_modulate(const Params& p, LAS unsigned char* lds, int c) {
    int tid = threadIdx.x; asm volatile("" : "+v"(tid)); const int lane = tid & 63, wid = tid >> 6;
    const float* modp = (const float*)(p.ws + WS_MODP); const float* b_mod = p.in[5];
    float* modv = (float*)(p.ws + WS_MOD);
    { const bf16_t* Ws = (const bf16_t*)(p.ws + WS_WIN) + (size_t)3072 * DM; LAS unsigned char* wl = lds + 8192;
#pragma unroll
      for (int h2 = 0; h2 < 2; ++h2) { u32x4v wv[8];
#pragma unroll
          for (int k = 0; k < 8; ++k) { const int i = tid + NTHR * (8 * h2 + k), r = i >> 7, pc = i & 127; wv[k] = *(const u32x4v*)(Ws + (size_t)r * DM + pc * 8); }
#pragma unroll
          for (int k = 0; k < 8; ++k) { const int i = tid + NTHR * (8 * h2 + k), r = i >> 7, pc = i & 127; *(LAS u32x4v*)(wl + r * 2064 + pc * 16) = wv[k]; } } }
    for (int e = tid; e < 408; e += NTHR) { const int idx = c * 408 + e, r = idx / 6144, j = idx - r * 6144; float s = b_mod[j];
#pragma unroll
        for (int ks = 0; ks < 16; ++ks) s += modp[((size_t)ks * 17 + r) * 6144 + j];
        modv[idx] = s; }
    LAS float* mv = (LAS float*)lds;
    bf16_t* U = (bf16_t*)(p.ws + WS_U) ;
    for (int pass = 0; pass < 2; ++pass) {
        const int b = pass ? 16 : c >> 4;
        __syncthreads();
        for (int j = tid; j < 2048; j += NTHR) { float s = b_mod[j];
#pragma unroll
            for (int ks = 0; ks < 16; ++ks) s += modp[((size_t)ks * 17 + b) * 6144 + j];
            mv[j] = s; }
        __syncthreads();
        f32x4v shv[4], scv[4];
#pragma unroll
        for (int i = 0; i < 4; ++i) { const int d = i * 256 + lane * 4; shv[i] = *(const LAS f32x4v*)(mv + d); scv[i] = *(const LAS f32x4v*)(mv + 1024 + d) + 1.f; }
        const int nrow = pass ? 16 : 128;
        for (int r0 = wid; r0 < nrow; r0 += 32) {
            f32x4v v[4][4];
#pragma unroll
            for (int k = 0; k < 4; ++k) { const int rr = r0 + 8 * k; if (rr < nrow) { const float* src = pass ? p.in[2] + (size_t)(16 * c + rr) * DM : p.in[0] + (size_t)(128 * c + rr) * DM;
#pragma unroll
                for (int i = 0; i < 4; ++i) v[k][i] = *(const f32x4v*)(src + i * 256 + lane * 4); } }
#pragma unroll
            for (int k = 0; k < 4; ++k) { const int rr = r0 + 8 * k; if (rr < nrow) { const int row = pass ? ML + 16 * c + rr : 128 * c + rr;
#pragma unroll
                for (int i = 0; i < 4; ++i) { const f32x4v w = v[k][i] * scv[i] + shv[i];
                    uint2 o; o.x = scan::cvt_pk(w[0], w[1]); o.y = scan::cvt_pk(w[2], w[3]);
                    *(uint2*)(U + (size_t)row * DM + i * 256 + lane * 4) = o; } } }
        }
    }
    asm volatile("s_waitcnt vmcnt(0)" ::: "memory");
    __syncthreads();
    { LAS unsigned char* wl = lds + 8192;
      int c16 = lane & 15, g4 = lane >> 4; asm volatile("" : "+v"(c16), "+v"(g4));
      const float* bsm = (const float*)(p.ws + WS_BIN) + 3072; char* smb = (char*)(p.ws + WS_BIG + BIG_SMALL); const char* ub = (const char*)U;
      const LAS unsigned char* wlb = wl + c16 * 2064 + g4 * 16;
      const unsigned ao = (unsigned)((128 * c + 16 * wid + c16) * DM + 8 * g4) * 2u, aoc = (unsigned)((ML + 16 * c + c16) * DM + 8 * g4) * 2u + (unsigned)(256 * wid);
      scan::bf16x8 fa[32], fc[4];
#pragma unroll
      for (int u = 0; u < 32; ++u) fa[u] = *(const scan::bf16x8*)(ub + (ao + (unsigned)(64 * u)));
#pragma unroll
      for (int u = 0; u < 4; ++u) fc[u] = *(const scan::bf16x8*)(ub + (aoc + (unsigned)(64 * u)));
      f32x4v acc[4], accc[4];
#pragma unroll
      for (int nt = 0; nt < 4; ++nt) { const float bz = bsm[16 * nt + c16]; acc[nt] = (f32x4v){bz, bz, bz, bz}; accc[nt] = (f32x4v){0.f, 0.f, 0.f, 0.f}; }
#pragma unroll
      for (int u = 0; u < 32; ++u)
#pragma unroll
          for (int nt = 0; nt < 4; ++nt) { const scan::bf16x8 bf = *(const LAS scan::bf16x8*)(wlb + nt * 16 * 2064 + 64 * u);
              acc[nt] = __builtin_amdgcn_mfma_f32_16x16x32_bf16(fa[u], bf, acc[nt], 0, 0, 0); }
#pragma unroll
      for (int u = 0; u < 4; ++u)
#pragma unroll
          for (int nt = 0; nt < 4; ++nt) { const scan::bf16x8 bf = *(const LAS scan::bf16x8*)(wlb + nt * 16 * 2064 + 64 * (4 * wid + u));
              accc[nt] = __builtin_amdgcn_mfma_f32_16x16x32_bf16(fc[u], bf, accc[nt], 0, 0, 0); }
      { const unsigned so = (unsigned)((128 * c + 16 * wid + 4 * g4) * 64 + c16) * 4u;
#pragma unroll
        for (int nt = 0; nt < 4; ++nt)
#pragma unroll
            for (int i = 0; i < 4; ++i) *(float*)(smb + (so + (unsigned)((i * 64 + 16 * nt) * 4))) = acc[nt][i]; }
      __syncthreads();
      LAS float* part = (LAS float*)wl;
#pragma unroll
      for (int nt = 0; nt < 4; ++nt)
#pragma unroll
          for (int i = 0; i < 4; ++i) part[(wid * 16 + 4 * g4 + i) * 64 + 16 * nt + c16] = accc[nt][i];
      __syncthreads();
#pragma unroll
      for (int o2 = 0; o2 < 2; ++o2) { const int o = tid + 512 * o2, row = o >> 6, col = o & 63; float sacc = bsm[col];
#pragma unroll
          for (int w = 0; w < 8; ++w) sacc += part[(w * 16 + row) * 64 + col];
          *(float*)(smb + (unsigned)((ML + 16 * c + row) * 64 + col) * 4u) = sacc; }
    }
}
__device__ __forceinline__ void aprep_unpack16(u32x4v a, u32x4v b, float* v) {
    v[0] = __uint_as_float(a.x << 16); v[1] = __uint_as_float(a.x & 0xffff0000u); v[2] = __uint_as_float(a.y << 16); v[3] = __uint_as_float(a.y & 0xffff0000u);
    v[4] = __uint_as_float(a.z << 16); v[5] = __uint_as_float(a.z & 0xffff0000u); v[6] = __uint_as_float(a.w << 16); v[7] = __uint_as_float(a.w & 0xffff0000u);
    v[8] = __uint_as_float(b.x << 16); v[9] = __uint_as_float(b.x & 0xffff0000u); v[10] = __uint_as_float(b.y << 16); v[11] = __uint_as_float(b.y & 0xffff0000u);
    v[12] = __uint_as_float(b.z << 16); v[13] = __uint_as_float(b.z & 0xffff0000u); v[14] = __uint_as_float(b.w << 16); v[15] = __uint_as_float(b.w & 0xffff0000u); }
__device__ __forceinline__ void ph_aprep(const Params& p, int c) {
    int tid = threadIdx.x; asm volatile("" : "+v"(tid)); const int lane = tid & 63, wid = tid >> 6;
    bf16_t* hm = (bf16_t*)p.out; bf16_t* hg = (bf16_t*)(p.ws + WS_BIG + BIG_HG); const bf16_t* side = (const bf16_t*)(p.ws + WS_BIG + BIG_SIDE);
    float gmv[16], ggv[16];
#pragma unroll
    for (int i = 0; i < 4; ++i) { const f32x4v a = *(const f32x4v*)(p.in[13] + lane * 16 + 4 * i), b = *(const f32x4v*)(p.in[14] + lane * 16 + 4 * i);
        gmv[4 * i] = a[0]; gmv[4 * i + 1] = a[1]; gmv[4 * i + 2] = a[2]; gmv[4 * i + 3] = a[3]; ggv[4 * i] = b[0]; ggv[4 * i + 1] = b[1]; ggv[4 * i + 2] = b[2]; ggv[4 * i + 3] = b[3]; }
    u32x4v raw[2][12];
#define APREP_LD(buf, rq_) do { const int row_ = c * 128 + 8 * (rq_) + wid; const size_t o_ = (size_t)row_ * DM + lane * 16; const bf16_t* sp_ = side + (size_t)row_ * 4096 + lane * 16; \
        raw[buf][0] = *(const u32x4v*)(hm + o_); raw[buf][1] = *(const u32x4v*)(hm + o_ + 8); raw[buf][2] = *(const u32x4v*)(hm + o_ + (size_t)ML * DM); raw[buf][3] = *(const u32x4v*)(hm + o_ + (size_t)ML * DM + 8); \
        raw[buf][4] = *(const u32x4v*)sp_; raw[buf][5] = *(const u32x4v*)(sp_ + 8); \
        raw[buf][6] = *(const u32x4v*)(hg + o_); raw[buf][7] = *(const u32x4v*)(hg + o_ + 8); raw[buf][8] = *(const u32x4v*)(hg + o_ + (size_t)ML * DM); raw[buf][9] = *(const u32x4v*)(hg + o_ + (size_t)ML * DM + 8); \
        raw[buf][10] = *(const u32x4v*)(sp_ + 1024); raw[buf][11] = *(const u32x4v*)(sp_ + 1024 + 8); } while (0)
    APREP_LD(0, 0);
    for (int rq2 = 0; rq2 < 16; rq2 += 2) {
#pragma unroll
        for (int u = 0; u < 2; ++u) {
            const int rq = rq2 + u; const int row = c * 128 + 8 * rq + wid; const size_t o = (size_t)row * DM + lane * 16;
            if (rq + 1 < 16) APREP_LD(u ^ 1, rq + 1);
            float v[16], w[16], g[16];
            { aprep_unpack16(raw[u][0], raw[u][1], v); aprep_unpack16(raw[u][2], raw[u][3], w); aprep_unpack16(raw[u][4], raw[u][5], g);
              float s = 0.f;
#pragma unroll
              for (int i = 0; i < 16; ++i) { v[i] += w[i]; s += v[i]; }
              s += __shfl_xor(s, 1); s += __shfl_xor(s, 2); s += __shfl_xor(s, 4);
              const float mean = s * (1.f / 128.f); float q = 0.f;
#pragma unroll
              for (int i = 0; i < 16; ++i) { v[i] -= mean; q += v[i] * v[i]; }
              q += __shfl_xor(q, 1); q += __shfl_xor(q, 2); q += __shfl_xor(q, 4);
              const float rstd = rsqrtf(q * (1.f / 128.f) + EPS);
              unsigned ow[8];
#pragma unroll
              for (int e = 0; e < 16; e += 2) ow[e >> 1] = scan::cvt_pk(v[e] * rstd * gmv[e] * sigmoidf_(g[e]), v[e + 1] * rstd * gmv[e + 1] * sigmoidf_(g[e + 1]));
              *(u32x4v*)(hm + o) = (u32x4v){ow[0], ow[1], ow[2], ow[3]}; *(u32x4v*)(hm + o + 8) = (u32x4v){ow[4], ow[5], ow[6], ow[7]}; }
            { aprep_unpack16(raw[u][6], raw[u][7], v); aprep_unpack16(raw[u][8], raw[u][9], w); aprep_unpack16(raw[u][10], raw[u][11], g);
              float q = 0.f;
#pragma unroll
              for (int i = 0; i < 16; ++i) { v[i] += w[i]; q += v[i] * v[i]; }
              q += __shfl_xor(q, 1); q += __shfl_xor(q, 2); q += __shfl_xor(q, 4); q += __shfl_xor(q, 8);
              const float rstd = rsqrtf(q * (1.f / 256.f) + EPS);
              unsigned ow[8];
#pragma unroll
              for (int e = 0; e < 16; e += 2) ow[e >> 1] = scan::cvt_pk(v[e] * rstd * ggv[e] * siluf_(g[e]), v[e + 1] * rstd * ggv[e + 1] * siluf_(g[e + 1]));
              *(u32x4v*)(hg + o) = (u32x4v){ow[0], ow[1], ow[2], ow[3]}; *(u32x4v*)(hg + o + 8) = (u32x4v){ow[4], ow[5], ow[6], ow[7]}; }
        }
    }
#undef APREP_LD
}
template <int MODE>
__device__ __forceinline__ void ph_ln(const Params& p, int c) {
    int tid = threadIdx.x; asm volatile("" : "+v"(tid)); const int lane = tid & 63, wid = tid >> 6;
    const float* g = MODE == 1 ? p.in[18] : p.in[26]; const float* bta = MODE == 1 ? p.in[19] : p.in[27];
    const float* mv = (const float*)(p.ws + WS_MOD) + (c * 128 / SEQ) * 6144; bf16_t* u2 = (bf16_t*)(p.ws + WS_U);
    f32x4v vn[4];
#pragma unroll
    for (int j = 0; j < 4; ++j) vn[j] = *(const f32x4v*)(p.out + (size_t)(c * 128 + wid) * DM + j * 256 + lane * 4);
    for (int rr = wid; rr < 128; rr += 8) {
        const int row = c * 128 + rr; float* ptr = p.out + (size_t)row * DM;
        f32x4v v[4]; float s = 0.f;
#pragma unroll
        for (int j = 0; j < 4; ++j) { v[j] = vn[j]; s += (v[j][0] + v[j][1]) + (v[j][2] + v[j][3]); }
        if (rr + 8 < 128) {
#pragma unroll
            for (int j = 0; j < 4; ++j) vn[j] = *(const f32x4v*)(ptr + (size_t)8 * DM + j * 256 + lane * 4); }
        const float mean = wave_sum(s) * (1.f / DM); float q = 0.f;
#pragma unroll
        for (int j = 0; j < 4; ++j) { v[j] = v[j] - mean; q += (v[j][0] * v[j][0] + v[j][1] * v[j][1]) + (v[j][2] * v[j][2] + v[j][3] * v[j][3]); }
        const float rstd = rsqrtf(wave_sum(q) * (1.f / DM) + EPS);
#pragma unroll
        for (int j = 0; j < 4; ++j) { const int cc = j * 256 + lane * 4; const f32x4v o = v[j] * rstd * *(const f32x4v*)(g + cc) + *(const f32x4v*)(bta + cc);
            *(f32x4v*)(ptr + cc) = o;
            if (MODE == 1) { const f32x4v sh = *(const f32x4v*)(mv + 3072 + cc), sc = *(const f32x4v*)(mv + 4096 + cc); const f32x4v w = o * (sc + 1.f) + sh;
                uint2 ww; ww.x = scan::cvt_pk(w[0], w[1]); ww.y = scan::cvt_pk(w[2], w[3]); *(uint2*)(u2 + (size_t)row * DM + cc) = ww; } }
    }
}
__device__ __forceinline__ void ph_convglu(const Params& p, LAS unsigned char* lds, int c) {
    int tid = threadIdx.x; asm volatile("" : "+v"(tid));
    const bf16_t* gate = (const bf16_t*)(p.ws + WS_BIG + BIG_GATE); bf16_t* val = (bf16_t*)(p.ws + WS_BIG + BIG_VAL);
    LAS float* cw = (LAS float*)lds;
    for (int i = tid; i < 9 * DFF; i += NTHR) cw[i] = p.in[22][i];
    for (int i = tid; i < DFF; i += NTHR) cw[9 * DFF + i] = p.in[23][i];
    __syncthreads();
    const int b = c >> 4, rimg0 = (c & 15) * 2;
    for (int wi = (tid >> 6); wi < 44; wi += 8) {
        const int cs = wi / 11, grp = wi - cs * 11, rsel = (tid >> 5) & 1, cgp = 32 * grp + (tid & 31), ch = cgp * 8;
        const int r = rimg0 + rsel, col0 = 16 * cs;
        const bool up = r > 0, dn = r < SEQ / GW - 1;
        const bf16_t* g0 = gate + ((size_t)b * SEQ + r * GW) * DFF + ch;
        const bf16_t* gu = up ? g0 - (size_t)GW * DFF : g0; const bf16_t* gd = dn ? g0 + (size_t)GW * DFF : g0;
        bf16_t* v0 = val + ((size_t)c * 128 + rsel * 64 + col0) * DFF + ch;
        float w[9][8];
#pragma unroll
        for (int k = 0; k < 9; ++k) { const f32x4v a0 = *(const LAS f32x4v*)(cw + k * DFF + ch), a1 = *(const LAS f32x4v*)(cw + k * DFF + ch + 4);
            const bool ok = k < 3 ? up : (k >= 6 ? dn : true);
#pragma unroll
            for (int e = 0; e < 4; ++e) { w[k][e] = ok ? a0[e] : 0.f; w[k][4 + e] = ok ? a1[e] : 0.f; } }
        float win[4][3][8];
#define CONV_LD(dst, col_) do { const int cc_ = (col_) < 0 ? 0 : ((col_) > GW - 1 ? GW - 1 : (col_)); dst[0] = *(const u32x4v*)(gu + (size_t)cc_ * DFF); dst[1] = *(const u32x4v*)(g0 + (size_t)cc_ * DFF); dst[2] = *(const u32x4v*)(gd + (size_t)cc_ * DFF); } while (0)
#define CONV_UNP(slot_, src, okc) do { _Pragma("unroll") for (int di_ = 0; di_ < 3; ++di_) { u32x4v q_ = src[di_]; if (!(okc)) q_ = (u32x4v){0u, 0u, 0u, 0u}; \
            win[slot_][di_][0] = __uint_as_float(q_.x << 16); win[slot_][di_][1] = __uint_as_float(q_.x & 0xffff0000u); win[slot_][di_][2] = __uint_as_float(q_.y << 16); win[slot_][di_][3] = __uint_as_float(q_.y & 0xffff0000u); \
            win[slot_][di_][4] = __uint_as_float(q_.z << 16); win[slot_][di_][5] = __uint_as_float(q_.z & 0xffff0000u); win[slot_][di_][6] = __uint_as_float(q_.w << 16); win[slot_][di_][7] = __uint_as_float(q_.w & 0xffff0000u); } } while (0)
        u32x4v rawn[3];
        { u32x4v ra[3], rb[3]; CONV_LD(ra, col0 - 1); CONV_LD(rb, col0); CONV_LD(rawn, col0 + 1);
          CONV_UNP(3, ra, col0 > 0); CONV_UNP(0, rb, true); }
        for (int q = 0; q < 4; ++q) {
#pragma unroll
            for (int u = 0; u < 4; ++u) {
                const int px = 4 * q + u, col = col0 + px;
                const int sl = (u + 3) & 3, sm = u, sr = (u + 1) & 3;
                CONV_UNP(sr, rawn, col + 1 < GW);
                const u32x4v vv = *(const u32x4v*)(v0 + (size_t)px * DFF);
                CONV_LD(rawn, col + 2);
                float acc[8];
                { const LAS float* bp = cw + 9 * DFF + ch; asm volatile("" : "+v"(bp));
                  const f32x4v a0 = *(const LAS f32x4v*)bp, a1 = *(const LAS f32x4v*)(bp + 4);
#pragma unroll
                  for (int e = 0; e < 4; ++e) { acc[e] = a0[e]; acc[4 + e] = a1[e]; } }
#pragma unroll
                for (int di = 0; di < 3; ++di)
#pragma unroll
                    for (int e = 0; e < 8; ++e) acc[e] += w[di * 3][e] * win[sl][di][e] + w[di * 3 + 1][e] * win[sm][di][e] + w[di * 3 + 2][e] * win[sr][di][e];
                const float vf[8] = {__uint_as_float(vv.x << 16), __uint_as_float(vv.x & 0xffff0000u), __uint_as_float(vv.y << 16), __uint_as_float(vv.y & 0xffff0000u),
                                     __uint_as_float(vv.z << 16), __uint_as_float(vv.z & 0xffff0000u), __uint_as_float(vv.w << 16), __uint_as_float(vv.w & 0xffff0000u)};
                u32x4v o; o.x = scan::cvt_pk(gelu_tanh(acc[0]) * vf[0], gelu_tanh(acc[1]) * vf[1]); o.y = scan::cvt_pk(gelu_tanh(acc[2]) * vf[2], gelu_tanh(acc[3]) * vf[3]);
                o.z = scan::cvt_pk(gelu_tanh(acc[4]) * vf[4], gelu_tanh(acc[5]) * vf[5]); o.w = scan::cvt_pk(gelu_tanh(acc[6]) * vf[6], gelu_tanh(acc[7]) * vf[7]);
                *(u32x4v*)(v0 + (size_t)px * DFF) = o;
            }
        }
#undef CONV_LD
#undef CONV_UNP
    }
}


#define GAS __attribute__((address_space(1)))
typedef GAS unsigned gu32;
#define RLX_AGENT __ATOMIC_RELAXED, __HIP_MEMORY_SCOPE_AGENT
#define XB_TMO      128
#define XB_XCNT(j)  (256  + 64 * (j))
#define XB_XSUB(j)  (1280 + 64 * (j))
#define XB_XGEN(j)  (2304 + 64 * (j))
#define XB_TOP      3328
#define XB_TOPGEN   3392
#define XCD_BAR_WORDS 3456
#define XB_SPIN_CAP (1u << 18)

__device__ __forceinline__ unsigned xb_ld(unsigned* p)              { return __hip_atomic_load(p, __ATOMIC_RELAXED, __HIP_MEMORY_SCOPE_AGENT); }
__device__ __forceinline__ unsigned xb_add(unsigned* p, unsigned v) { return __hip_atomic_fetch_add(p, v, __ATOMIC_RELAXED, __HIP_MEMORY_SCOPE_AGENT); }
__device__ __forceinline__ unsigned xb_xcc_id() { return (unsigned)__builtin_amdgcn_s_getreg((3 << 11) | 20) & 0xFu; }
#define XB_SPIN(cond, bar) do { unsigned _sp = 0; while (cond) { __builtin_amdgcn_s_sleep(1); \
    if ((++_sp & 255u) == 0u) { if (xb_ld(&(bar)[XB_TMO])) break; if (_sp > XB_SPIN_CAP) { atomicAdd(&(bar)[XB_TMO], 1u); break; } } } } while (0)

struct XcdBarrier {
    unsigned* bar; unsigned x;
    volatile LAS unsigned* st;
};

__device__ __forceinline__ XcdBarrier xcd_barrier_post(unsigned* bar, volatile LAS unsigned* st) {
    XcdBarrier b; b.bar = bar; b.x = xb_xcc_id(); b.st = st;
    if (threadIdx.x == 0) (void)xb_add(&bar[XB_XCNT(b.x)], 1u);
    return b;
}
__device__ __forceinline__ void xcd_barrier_complete(unsigned* bar, unsigned x, unsigned& nloc, unsigned& nx) {
    const unsigned G = gridDim.x * gridDim.y * gridDim.z;
    unsigned sum, cnt, mine, sp = 0u;
    for (;;) {
        sum = 0u; cnt = 0u; mine = 0u;
#pragma unroll
        for (unsigned j = 0; j < 16; ++j) { const unsigned c = xb_ld(&bar[XB_XCNT(j)]); sum += c; cnt += (c > 0u) ? 1u : 0u; mine = (j == x) ? c : mine; }
        if (sum == G) break;
        __builtin_amdgcn_s_sleep(1);
        if ((++sp & 255u) == 0u) { if (xb_ld(&bar[XB_TMO])) break; if (sp > XB_SPIN_CAP) { atomicAdd(&bar[XB_TMO], 1u); break; } }
    }
    nloc = mine > 0u ? mine : 1u; nx = cnt > 0u ? cnt : 1u;
}

template <bool LOCAL>
__device__ __forceinline__ void xcd_barrier(const XcdBarrier& b) {
    asm volatile("s_waitcnt vmcnt(0)" ::: "memory");
    __syncthreads();
    if (threadIdx.x == 0) {
        unsigned* bar = b.bar;
        __builtin_amdgcn_s_waitcnt(0);
        unsigned nloc = b.st[0], nx = b.st[1];
        if (nloc == 0u) { xcd_barrier_complete(bar, b.x, nloc, nx); b.st[0] = nloc; b.st[1] = nx; }
        const unsigned old = xb_add(&bar[XB_XSUB(b.x)], 1u);
        const unsigned gen = old / nloc;
        if (LOCAL) {
            if (old + 1u == (gen + 1u) * nloc) xb_add(&bar[XB_XGEN(b.x)], 1u);
            else XB_SPIN(xb_ld(&bar[XB_XGEN(b.x)]) == gen, bar);
            __builtin_amdgcn_fence(__ATOMIC_ACQUIRE, "agent");
            asm volatile("s_waitcnt vmcnt(0)" ::: "memory");
        } else if (old + 1u == (gen + 1u) * nloc) {
            __builtin_amdgcn_fence(__ATOMIC_RELEASE, "agent");
            asm volatile("s_waitcnt vmcnt(0)" ::: "memory");
            const unsigned og = xb_add(&bar[XB_TOP], 1u);
            const unsigned tg = og / nx;
            if (og + 1u == (tg + 1u) * nx) xb_add(&bar[XB_TOPGEN], 1u);
            else XB_SPIN(xb_ld(&bar[XB_TOPGEN]) == tg, bar);
            __builtin_amdgcn_fence(__ATOMIC_ACQUIRE, "agent");
            xb_add(&bar[XB_XGEN(b.x)], 1u);
            asm volatile("s_waitcnt vmcnt(0)" ::: "memory");
        } else {
            XB_SPIN(xb_ld(&bar[XB_XGEN(b.x)]) == gen, bar);
            __builtin_amdgcn_fence(__ATOMIC_ACQUIRE, "agent");
            asm volatile("s_waitcnt vmcnt(0)" ::: "memory");
        }
    }
    __syncthreads();
}


__global__ void __launch_bounds__(NTHR, 2) mega_fwd(Params p) {
    extern __shared__ __attribute__((aligned(16))) unsigned char lds_dyn[];
    LAS unsigned char* lds = (LAS unsigned char*)lds_dyn;
    cg::grid_group grid = cg::this_grid();
    const int c = blockIdx.x;
    unsigned char* ws = p.ws; unsigned char* big = ws + WS_BIG;
    float* modv = (float*)(ws + WS_MOD); float* binp = (float*)(ws + WS_BIN);
    bf16_t* Wt_in = (bf16_t*)(ws + WS_WIN); bf16_t* U = (bf16_t*)(ws + WS_U);
    bf16_t* Pm = (bf16_t*)(big + BIG_PM); bf16_t* Pg = (bf16_t*)(big + BIG_PG); float* small = (float*)(big + BIG_SMALL);
    bf16_t* hm = (bf16_t*)p.out; bf16_t* hg = (bf16_t*)(big + BIG_HG); bf16_t* side = (bf16_t*)(big + BIG_SIDE);
    bf16_t* gate = (bf16_t*)(big + BIG_GATE); bf16_t* val = (bf16_t*)(big + BIG_VAL);
    if (threadIdx.x < 16) ((LAS unsigned*)(lds + MISC_OFF))[threadIdx.x] = 0u;
    __syncthreads();
#define GRID_SYNC() xcd_barrier<false>(bar)
#define XCD_SYNC() xcd_barrier<true>(bar)
    if (c == 0) { for (int i = threadIdx.x; i < XCD_BAR_WORDS; i += NTHR) __hip_atomic_store((unsigned*)(ws + WS_CTL) + CW_BAR + i, 0u, __ATOMIC_RELAXED, __HIP_MEMORY_SCOPE_AGENT);
                  if (threadIdx.x < 16) __hip_atomic_store((unsigned*)(ws + WS_CTL) + CW_RANK + 64 * threadIdx.x, 0u, __ATOMIC_RELAXED, __HIP_MEMORY_SCOPE_AGENT);
                  if (threadIdx.x < 256) { __hip_atomic_store((unsigned*)(ws + WS_CTL) + CW_LN + 64 * threadIdx.x, 0u, __ATOMIC_RELAXED, __HIP_MEMORY_SCOPE_AGENT);
                                           __hip_atomic_store((unsigned*)(ws + WS_CTL) + CW_GX + 64 * threadIdx.x, 0u, __ATOMIC_RELAXED, __HIP_MEMORY_SCOPE_AGENT); } }
    asm volatile("s_waitcnt vmcnt(0)" ::: "memory");
    grid.sync();
    XcdBarrier bar = xcd_barrier_post((unsigned*)(ws + WS_CTL) + CW_BAR, (volatile LAS unsigned*)(lds + MISC_OFF));
    if (threadIdx.x == 0) ((volatile LAS unsigned*)(lds + MISC_OFF))[4] = xb_add((unsigned*)(ws + WS_CTL) + CW_RANK + 64 * bar.x, 1u);
    __syncthreads();
    const int xr = __builtin_amdgcn_readfirstlane((int)((volatile LAS unsigned*)(lds + MISC_OFF))[4]);
    const int xx = __builtin_amdgcn_readfirstlane((int)bar.x & 7), v = 32 * xx + (xr & 31);
    ph_prologue(p, lds, c);
    GRID_SYNC();
    ph_modulate(p, lds, v);
    GRID_SYNC();
    { pg8::SchedAB S{U, Wt_in, DM, xx, xr & 31, 0}; pg8::FEpiAB E{Pm, Pg, binp}; pg8::gemm_phase(lds, DM, S, E); }
    XCD_SYNC();
    { scan::Args a{Pm, 3072, 0, small, p.in[8], p.in[9], p.in[10], p.in[11], p.in[12], hm, nullptr, nullptr}; scan::scan_item<false>(lds, a, v); }
    GRID_SYNC();
    { scan::Args a{Pg, 2048, 0, small, p.in[8], p.in[9], p.in[10], p.in[11], p.in[12], hg, big + BIG_GX, (unsigned*)(ws + WS_CTL) + CW_GX}; scan::scan_item<true>(lds, a, v); }
    GRID_SYNC();
    { pg8::SchedPlain S{U, Wt_in + (size_t)PC_SIDE * DM, 16, N_SIDE / 256, DM, xx, xr & 31, 0};
      pg8::FEpiSideF E{side, binp + PC_SIDE, hm, hg, p.in[13], p.in[14], (LAS float*)(lds + pg8::STAGE_BYTES)}; pg8::gemm_phase(lds, DM, S, E); }
    XCD_SYNC();
    { pg8::SchedDual S{hm, (const bf16_t*)(ws + WS_WBM), hg, (const bf16_t*)(ws + WS_WBG), 16, DM / 256, DM, xx, xr & 31, 0}; pg8::FEpiMerge E{U, side}; pg8::gemm_phase(lds, DM, S, E); }
    GRID_SYNC();
    { pg8::SchedPlain S{U, (const bf16_t*)(ws + WS_WOUT), 16, DM / 256, DM, xx, xr & 31, 0};
      pg8::FEpiOutLN E{p.in[0], modv, p.out, U, p.in[18], p.in[19], pg8::LnX{(float*)(ws + WS_LNX), (unsigned*)(ws + WS_CTL) + CW_LN, (LAS float*)(lds + pg8::STAGE_BYTES), xx, 0}}; pg8::gemm_phase(lds, DM, S, E); }
    XCD_SYNC();
    { pg8::SchedPlain S{U, (const bf16_t*)(ws + WS_WUP), 16, 2 * DFF / 256, DM, xx, xr & 31, 0}; pg8::FEpiUp E{gate, val, p.in[21]}; pg8::gemm_phase(lds, DM, S, E); }
    XCD_SYNC();
    ph_convglu(p, lds, v);
    XCD_SYNC();
    { pg8::SchedPlain S{val, (const bf16_t*)(ws + WS_WDN), 16, DM / 256, DFF, xx, xr & 31, 0};
      pg8::FEpiDownLN E{p.out, modv, p.in[25], p.in[26], p.in[27], pg8::LnX{(float*)(ws + WS_LNX + MiB), (unsigned*)(ws + WS_CTL) + CW_LN + 128 * 64, (LAS float*)(lds + pg8::STAGE_BYTES), xx, 0}}; pg8::gemm_phase(lds, DFF, S, E); }
    if (xb_ld(&bar.bar[XB_TMO]) != 0u || xr >= 32 || bar.x >= 8u) { __syncthreads(); if (threadIdx.x == 0) p.out[(size_t)v * 128 * DM] = __builtin_nanf(""); }
}

extern "C" void kernel_launch(void* const* d_in, const int* in_sizes, int n_in, void* d_out, int out_size, void* d_ws, size_t ws_size, hipStream_t stream) {
    if (n_in != 28 || out_size != ML * DM || ws_size < WS_END) { fprintf(stderr, "kernel_launch: unexpected shapes n_in %d out %d ws %zu\n", n_in, out_size, ws_size); return; }
    static bool attr_set = false;
    if (!attr_set) { (void)hipFuncSetAttribute((const void*)mega_fwd, hipFuncAttributeMaxDynamicSharedMemorySize, MEGA_LDS); attr_set = true; }
    Params p{};
    for (int i = 0; i < 28; ++i) p.in[i] = (const float*)d_in[i];
    p.out = (float*)d_out; p.ws = (unsigned char*)d_ws;
    void* args[] = {&p};
    hipError_t e = hipLaunchCooperativeKernel((const void*)mega_fwd, dim3(NBLK), dim3(NTHR), args, MEGA_LDS, stream);
    if (e != hipSuccess) fprintf(stderr, "cooperative launch failed: %s\n", hipGetErrorString(e));
}
```

```cpp
#include <hip/hip_runtime.h>
#include <cstdio>
#include <cstdint>

typedef unsigned short bf16_t;

constexpr int DM = 1024, NB = 16, SEQ = 2048, CTX = 256, GW = 64;
constexpr int ML = NB * SEQ;
constexpr int MC = NB * CTX;
constexpr int MT = ML + MC;
constexpr int NIN = 9280, NINP = 9472;
constexpr int DFF = 2816;
constexpr float ALPHA = 1.189207115002721f;
constexpr float EPS = 1e-5f;
constexpr int PC_QM = 0, PC_KM = 1024, PC_VM = 2048, PC_SMALL = 3072, PC_QG = 3328, PC_KG = 3840, PC_VG = 4352, PC_SIDE = 5376;
constexpr int N_AB = 5376;
constexpr int N_SIDE = 4096;

constexpr size_t MiB = 1u << 20;
constexpr size_t WS_CTL = 0;
constexpr size_t WS_MOD = 1 * MiB;
constexpr size_t WS_BIN = WS_MOD + 512 * 1024;
constexpr size_t WS_WIN = 4 * MiB;
constexpr size_t WS_WBM = WS_WIN + (size_t)NINP * DM * 2;
constexpr size_t WS_WBG = WS_WBM + 2 * MiB;
constexpr size_t WS_WOUT = WS_WBG + 2 * MiB;
constexpr size_t WS_WUP = WS_WOUT + 2 * MiB;
constexpr size_t WS_WDN = WS_WUP + 11 * MiB;
constexpr size_t WS_U = 46 * MiB;
constexpr size_t WS_BIG = 118 * MiB;
constexpr size_t WS_END = 509 * MiB;
static_assert(WS_WDN + (size_t)DM * DFF * 2 <= WS_U, "weights fit");
constexpr size_t BIG_PM = 0;
constexpr size_t BIG_PG = 216 * MiB;
constexpr size_t BIG_SMALL = 360 * MiB;
constexpr size_t BIG_HG = 0;
constexpr size_t BIG_SIDE = 128 * MiB;
constexpr size_t BIG_GATE = 0;
constexpr size_t BIG_VAL = 176 * MiB;

__device__ __forceinline__ float bf2f(bf16_t v) { return __uint_as_float(((unsigned)v) << 16); }
__device__ __forceinline__ bf16_t f2bf(float f) { unsigned u = __float_as_uint(f); return (bf16_t)((u + 0x7fffu + ((u >> 16) & 1u)) >> 16); }
__device__ __forceinline__ float sigmoidf_(float x) { return __builtin_amdgcn_rcpf(1.f + __expf(-x)); }
__device__ __forceinline__ float siluf_(float x) { return x * sigmoidf_(x); }
__device__ __forceinline__ float logsigmoidf_(float x) { return fminf(x, 0.f) - __logf(1.f + __expf(-fabsf(x))); }
__device__ __forceinline__ float gelu_tanh(float x) { const float a = x * __builtin_fmaf(x * x, -0.10294324f, -2.3022082f); return x * __builtin_amdgcn_rcpf(1.f + __builtin_amdgcn_exp2f(a)); }
__device__ __forceinline__ float wave_sum(float v) {
#pragma unroll
    for (int o = 1; o < 64; o <<= 1) v += __shfl_xor(v, o);
    return v;
}

namespace pg8 {
#define PG8_LAS __attribute__((address_space(3)))
typedef short bf16x8 __attribute__((ext_vector_type(8)));
typedef float f32x4 __attribute__((ext_vector_type(4)));
typedef unsigned u32x4 __attribute__((ext_vector_type(4)));
constexpr int BM = 256, BK = 64, HALF = 128, HTB = HALF * BK * 2, STAGE_BYTES = 8 * HTB, NXCD = 8, WGM = 4;
__host__ __device__ __forceinline__ int lds_byte(int r, int c) { const int st = (r >> 4) * 2 + (c >> 5), rr = r & 15, cc = c & 31, ob = rr * 64 + cc * 2; return st * 1024 + (ob ^ (((ob >> 9) & 1) << 5)); }
__host__ __device__ __forceinline__ void stage_rc(int b, int& R, int& C) { const int st = b / 1024, sb = b % 1024, swz = sb ^ (((sb >> 9) & 1) << 5); R = (st >> 1) * 16 + swz / 64; C = (st & 1) * 32 + (swz % 64) / 2; }
__host__ __device__ __forceinline__ int perm32(int rho) { const int n = rho >> 4, i = rho & 15; return 8 * (i >> 2) + 4 * n + (i & 3); }
struct Unit { int pm, pn, tag; const bf16_t* A; const bf16_t* B; };
__host__ __device__ __forceinline__ bool tile_local(int L, int nPl, int nN, int& lp, int& pn) {
    if (L >= nPl * nN) return false;
    const int nig = WGM * nN, gid = L / nig, fm = gid * WGM, gsz = (nPl - fm) < WGM ? (nPl - fm) : WGM, rem = L - gid * nig;
    lp = fm + rem % gsz; pn = rem / gsz; return true;
}
struct SchedPlain {
    const bf16_t* A; const bf16_t* Bt; int nPl, nN, K, x, r, pad;
    __device__ __forceinline__ bool next(int i, Unit& u) const { int lp; if (!tile_local(i * 32 + r, nPl, nN, lp, u.pn)) return false; u.pm = lp < 16 ? 16 * x + lp : 128 + 2 * x + (lp - 16); u.tag = 1;
        u.A = A + (size_t)u.pm * BM * K; u.B = Bt + (size_t)u.pn * BM * K; return true; }
};
struct SchedAB {
    const bf16_t* A; const bf16_t* Bt; int K, x, r, pad;
    __device__ __forceinline__ bool next(int i, Unit& u) const { const int L = i * 32 + r; int lp, pn;
        if (L < 320) { (void)tile_local(L, 16, 20, lp, pn); }
        else if (L < 348) { const int q = L - 320, cp = q / 14, idx = q - cp * 14; lp = 16 + cp; pn = idx < 8 ? 4 + idx : 6 + idx; }
        else return false;
        u.pn = pn; u.pm = lp < 16 ? 16 * x + lp : 128 + 2 * x + (lp - 16); u.tag = 1;
        u.A = A + (size_t)u.pm * BM * K; u.B = Bt + (size_t)(pn < 12 ? pn : pn + 1) * BM * K; return true; }
};
struct SchedDual {
    const bf16_t* A0; const bf16_t* B0; const bf16_t* A1; const bf16_t* B1; int nPl, nN, K, x, r, pad;
    __device__ __forceinline__ bool next(int i, Unit& u) const { int lp; if (!tile_local((i >> 1) * 32 + r, nPl, nN, lp, u.pn)) return false; u.pm = 16 * x + lp; u.tag = i & 1;
        u.A = ((i & 1) ? A1 : A0) + (size_t)u.pm * BM * K; u.B = ((i & 1) ? B1 : B0) + (size_t)u.pn * BM * K; return true; }
};
__device__ __forceinline__ unsigned cvt_pk_bf16(float lo, float hi) { unsigned r; asm volatile("v_cvt_pk_bf16_f32 %0, %1, %2" : "=v"(r) : "v"(lo), "v"(hi)); return r; }
__device__ __forceinline__ u32x4 pack8(f32x4 v0, f32x4 v1) { u32x4 w; w.x = cvt_pk_bf16(v0[0], v0[1]); w.y = cvt_pk_bf16(v0[2], v0[3]); w.z = cvt_pk_bf16(v1[0], v1[1]); w.w = cvt_pk_bf16(v1[2], v1[3]); return w; }
__device__ __forceinline__ void unpack8(u32x4 w, f32x4& v0, f32x4& v1) {
    v0[0] = __uint_as_float(w.x << 16); v0[1] = __uint_as_float(w.x & 0xffff0000u); v0[2] = __uint_as_float(w.y << 16); v0[3] = __uint_as_float(w.y & 0xffff0000u);
    v1[0] = __uint_as_float(w.z << 16); v1[1] = __uint_as_float(w.z & 0xffff0000u); v1[2] = __uint_as_float(w.w << 16); v1[3] = __uint_as_float(w.w & 0xffff0000u); }

template <class Epi, class Sched>
__device__ __forceinline__ void gemm_phase(PG8_LAS unsigned char* lds, const int K, const Sched& S, const Epi& E) {
    int tid_ = threadIdx.x; asm volatile("" : "+v"(tid_));
    const int tid = tid_, wid = __builtin_amdgcn_readfirstlane(tid >> 6), lane = tid & 63, wr = wid >> 2, wc = wid & 3, fr = lane & 15, fq = lane >> 4;
    const int nt = K / BK;
    unsigned voffA[2], voffB[2];
#pragma unroll
    for (int i = 0; i < 2; ++i) { int R, C; stage_rc(tid * 16 + i * 8192, R, C); const int Rb = (R & ~31) + perm32(R & 31);
        voffA[i] = (unsigned)(R * K + C) * 2u; voffB[i] = (unsigned)(Rb * K + C) * 2u; }
    const size_t kstep = (size_t)(BK * 2);
    const size_t hstep = (size_t)HALF * K * 2;
    const unsigned ldsw = (unsigned)wid * 1024u;
    const int aoff = lds_byte(wr * 64 + fr, fq * 8), boff = lds_byte(wc * 32 + fr, fq * 8);
#define PG8_SA(b, h) (((b) * 2 + (h)) * HTB)
#define PG8_SB(b, h) ((4 + (b) * 2 + (h)) * HTB)
#define PG8_STAGE(bufoff, gbase, voff) do { _Pragma("unroll") for (int _i = 0; _i < 2; ++_i) \
        __builtin_amdgcn_global_load_lds((const unsigned*)((const char*)(gbase) + (voff)[_i]), (PG8_LAS unsigned*)(lds + (bufoff) + ldsw + _i * 8192), 16, 0, 0); } while (0)
#define PG8_LDA(dst, b, h) do { _Pragma("unroll") for (int m = 0; m < 4; ++m) _Pragma("unroll") for (int k = 0; k < 2; ++k) dst[m][k] = *(const PG8_LAS bf16x8*)(lds + PG8_SA(b, h) + aoff + m * 2048 + k * 1024); } while (0)
#define PG8_LDB(dst, b, h) do { _Pragma("unroll") for (int n = 0; n < 2; ++n) _Pragma("unroll") for (int k = 0; k < 2; ++k) dst[n][k] = *(const PG8_LAS bf16x8*)(lds + PG8_SB(b, h) + boff + n * 2048 + k * 1024); } while (0)
#define PG8_MMA(ai, bj, At, Bt) do { __builtin_amdgcn_s_setprio(1); _Pragma("unroll") for (int m = 0; m < 4; ++m) _Pragma("unroll") for (int n = 0; n < 2; ++n) _Pragma("unroll") for (int k = 0; k < 2; ++k) \
        acc[ai][bj][m][n] = __builtin_amdgcn_mfma_f32_16x16x32_bf16(Bt[n][k], At[m][k], acc[ai][bj][m][n], 0, 0, 0); __builtin_amdgcn_s_setprio(0); } while (0)
#define PG8_WAIT_V_(n) asm volatile("s_waitcnt vmcnt(" #n ")" ::: "memory")
#define PG8_WAIT_V(n) PG8_WAIT_V_(n)
#define PG8_WAIT_L(n) asm volatile("s_waitcnt lgkmcnt(" #n ")" ::: "memory")
#define PG8_BAR __builtin_amdgcn_s_barrier()
#define PG8_SCHED __builtin_amdgcn_sched_barrier(0)
    Unit cur, nxt; int ui = 0;
    if (!S.next(0, cur)) return;
    f32x4 acc[2][2][4][2];
#pragma unroll
    for (int a = 0; a < 2; ++a)
#pragma unroll
        for (int b = 0; b < 2; ++b)
#pragma unroll
            for (int m = 0; m < 4; ++m)
#pragma unroll
                for (int n = 0; n < 2; ++n) acc[a][b][m][n] = (f32x4){0.f, 0.f, 0.f, 0.f};
    bf16x8 At[4][2], B0[2][2], B1[2][2];
    const char* cA = (const char*)cur.A; const char* cB = (const char*)cur.B;
    PG8_STAGE(PG8_SB(0, 0), cB, voffB); PG8_STAGE(PG8_SB(0, 1), cB + hstep, voffB); PG8_STAGE(PG8_SA(0, 0), cA, voffA); PG8_STAGE(PG8_SA(0, 1), cA + hstep, voffA);
    if (wr == 1) PG8_BAR;
    PG8_WAIT_V(2); PG8_BAR;
    PG8_STAGE(PG8_SB(1, 0), cB + kstep, voffB); PG8_STAGE(PG8_SA(1, 0), cA + kstep, voffA); PG8_STAGE(PG8_SB(1, 1), cB + hstep + kstep, voffB);
    PG8_WAIT_V(6); PG8_BAR;
    for (;;) {
        const bool has_next = S.next(ui + 1, nxt);
        const char* nA = has_next ? (const char*)nxt.A : cA; const char* nB = has_next ? (const char*)nxt.B : cB;
#define PG8_ITER(T_, W1, W2) do { const int t_ = (T_); const bool last = (t_ == nt - 2); \
            const char* a1 = cA + (size_t)(t_ + 1) * kstep; \
            const char* a2 = last ? nA : cA + (size_t)(t_ + 2) * kstep; const char* b2 = last ? nB : cB + (size_t)(t_ + 2) * kstep; \
            const char* a3 = a2 + kstep; const char* b3 = b2 + kstep; \
            PG8_LDB(B0, 0, 0); PG8_LDB(B1, 0, 1); PG8_SCHED; PG8_LDA(At, 0, 0); PG8_STAGE(PG8_SA(1, 1), a1 + hstep, voffA); \
            PG8_WAIT_V(W1); PG8_WAIT_L(0); PG8_BAR; PG8_MMA(0, 0, At, B0); PG8_MMA(0, 1, At, B1); PG8_BAR; PG8_SCHED; \
            PG8_LDA(At, 0, 1); PG8_STAGE(PG8_SB(0, 0), b2, voffB); PG8_STAGE(PG8_SB(0, 1), b2 + hstep, voffB); PG8_STAGE(PG8_SA(0, 0), a2, voffA); \
            PG8_WAIT_V(W2); PG8_WAIT_L(0); PG8_BAR; PG8_MMA(1, 0, At, B0); PG8_MMA(1, 1, At, B1); PG8_BAR; PG8_SCHED; \
            PG8_LDB(B0, 1, 0); PG8_LDB(B1, 1, 1); PG8_SCHED; PG8_LDA(At, 1, 0); PG8_STAGE(PG8_SA(0, 1), a2 + hstep, voffA); \
            PG8_WAIT_V(8); PG8_WAIT_L(0); PG8_BAR; PG8_MMA(0, 0, At, B0); PG8_MMA(0, 1, At, B1); PG8_BAR; PG8_SCHED; \
            PG8_LDA(At, 1, 1); PG8_STAGE(PG8_SB(1, 0), b3, voffB); PG8_STAGE(PG8_SB(1, 1), b3 + hstep, voffB); PG8_STAGE(PG8_SA(1, 0), a3, voffA); \
            PG8_WAIT_V(8); PG8_WAIT_L(0); PG8_BAR; PG8_MMA(1, 0, At, B0); PG8_MMA(1, 1, At, B1); PG8_BAR; PG8_SCHED; } while (0)
        int t0 = 0;
        if (Epi::NST == 16 && ui > 0) { PG8_ITER(0, 24, 24); t0 = 2; }
        for (int t = t0; t < nt; t += 2) PG8_ITER(t, 8, 8);
#undef PG8_ITER
        if (wr == 0) PG8_BAR;
        const bool keep = E(acc, cur, wr, wc, fr, fq);
        if (!has_next) break;
        if (!keep) {
#pragma unroll
            for (int a = 0; a < 2; ++a)
#pragma unroll
                for (int b = 0; b < 2; ++b)
#pragma unroll
                    for (int m = 0; m < 4; ++m)
#pragma unroll
                        for (int n = 0; n < 2; ++n) acc[a][b][m][n] = (f32x4){0.f, 0.f, 0.f, 0.f};
        }
        cur = nxt; cA = nA; cB = nB; ++ui;
        if (wr == 1) PG8_BAR;
    }
    PG8_WAIT_V(0);
    PG8_BAR;
#undef PG8_SA
#undef PG8_SB
#undef PG8_STAGE
#undef PG8_LDA
#undef PG8_LDB
#undef PG8_MMA
#undef PG8_WAIT_V
#undef PG8_WAIT_V_
#undef PG8_WAIT_L
#undef PG8_BAR
#undef PG8_SCHED
}

#define PG8_FRAG_LOOP for (int ai = 0; ai < 2; ++ai) _Pragma("unroll") for (int m = 0; m < 4; ++m) _Pragma("unroll") for (int bj = 0; bj < 2; ++bj)
struct FEpiAB { static constexpr int NST = 16; bf16_t* Pm; bf16_t* Pg; const float* bias;
    __device__ __forceinline__ bool operator()(const f32x4 (&acc)[2][2][4][2], const Unit& u, int wr, int wc, int fr, int fq) const {
        asm volatile("" : "+v"(fr), "+v"(fq)); const int row0 = u.pm * BM + wr * 64 + fr, ct = u.pn, cin = wc * 32 + 8 * fq, bt = ct < 12 ? ct : ct + 1;
        f32x4 bv[2][2];
#pragma unroll
        for (int bj = 0; bj < 2; ++bj)
#pragma unroll
            for (int n = 0; n < 2; ++n) bv[bj][n] = *(const f32x4*)(bias + bt * BM + cin + bj * HALF + 4 * n);
        bf16_t* base; int ld;
        if (ct < 12) { base = Pm + ct * BM; ld = 3072; } else { base = Pg + (ct - 12) * BM; ld = 2048; }
#pragma unroll
        PG8_FRAG_LOOP { *(u32x4*)(base + (size_t)(row0 + ai * HALF + m * 16) * ld + cin + bj * HALF) = pack8(acc[ai][bj][m][0] + bv[bj][0], acc[ai][bj][m][1] + bv[bj][1]); }
        return false;
    }
};
struct FEpiBias { static constexpr int NST = 16; bf16_t* O; const float* bias; int ld, pad;
    __device__ __forceinline__ bool operator()(const f32x4 (&acc)[2][2][4][2], const Unit& u, int wr, int wc, int fr, int fq) const {
        const int row0 = u.pm * BM + wr * 64 + fr, col0 = u.pn * BM + wc * 32 + 8 * fq;
        f32x4 bv[2][2];
#pragma unroll
        for (int bj = 0; bj < 2; ++bj)
#pragma unroll
            for (int n = 0; n < 2; ++n) bv[bj][n] = *(const f32x4*)(bias + col0 + bj * HALF + 4 * n);
#pragma unroll
        PG8_FRAG_LOOP { *(u32x4*)(O + (size_t)(row0 + ai * HALF + m * 16) * ld + col0 + bj * HALF) = pack8(acc[ai][bj][m][0] + bv[bj][0], acc[ai][bj][m][1] + bv[bj][1]); }
        return false;
    }
};
struct FEpiUp { static constexpr int NST = 0;      bf16_t* gate; bf16_t* val; const float* bias;
    __device__ __forceinline__ bool operator()(const f32x4 (&acc)[2][2][4][2], const Unit& u, int wr, int wc, int fr, int fq) const {
        asm volatile("" : "+v"(fr), "+v"(fq));
        const int row0 = u.pm * BM + wr * 64 + fr, cin = wc * 32 + 8 * fq;
        const unsigned tb = u.pn < 11 ? (unsigned)(u.pn * BM) * 2u : (unsigned)(176u << 20) + (unsigned)((u.pn - 11) * BM) * 2u;
        const unsigned ob = tb + (unsigned)(row0 * DFF + cin) * 2u; char* gb = (char*)gate;
        f32x4 bv[2][2];
#pragma unroll
        for (int bj = 0; bj < 2; ++bj)
#pragma unroll
            for (int n = 0; n < 2; ++n) bv[bj][n] = *(const f32x4*)(bias + u.pn * BM + cin + bj * HALF + 4 * n);
#pragma unroll
        PG8_FRAG_LOOP { *(u32x4*)(gb + (ob + (unsigned)(((ai * HALF + m * 16) * DFF + bj * HALF) * 2))) = pack8(acc[ai][bj][m][0] + bv[bj][0], acc[ai][bj][m][1] + bv[bj][1]); }
        return false;
    }
};
__device__ __forceinline__ float fsig(float x) { return __builtin_amdgcn_rcpf(1.f + __expf(-x)); }
struct FEpiMerge { static constexpr int NST = 0; bf16_t* Z; const bf16_t* side;
    __device__ __forceinline__ bool operator()(f32x4 (&acc)[2][2][4][2], const Unit& u, int wr, int wc, int fr, int fq) const {
        const int row0 = u.pm * BM + wr * 64 + fr, col0 = u.pn * BM + wc * 32 + 8 * fq;
        if (u.tag == 0) {
#pragma unroll
            PG8_FRAG_LOOP { const bf16_t* sp = side + (size_t)(row0 + ai * HALF + m * 16) * 4096 + col0 + bj * HALF;
                f32x4 a0, a1, b0, b1; unpack8(*(const u32x4*)(sp + 2048), a0, a1); unpack8(*(const u32x4*)(sp + 3072), b0, b1);
#pragma unroll
                for (int j = 0; j < 4; ++j) { acc[ai][bj][m][0][j] *= (1.f + __expf(-b0[j])) * fsig(a0[j]); acc[ai][bj][m][1][j] *= (1.f + __expf(-b1[j])) * fsig(a1[j]); } }
            return true;
        }
#pragma unroll
        PG8_FRAG_LOOP { const bf16_t* sp = side + (size_t)(row0 + ai * HALF + m * 16) * 4096 + col0 + bj * HALF;
            f32x4 b0, b1; unpack8(*(const u32x4*)(sp + 3072), b0, b1); f32x4 v0 = acc[ai][bj][m][0], v1 = acc[ai][bj][m][1];
#pragma unroll
            for (int j = 0; j < 4; ++j) { v0[j] *= fsig(b0[j]); v1[j] *= fsig(b1[j]); }
            *(u32x4*)(Z + (size_t)(row0 + ai * HALF + m * 16) * DM + col0 + bj * HALF) = pack8(v0, v1); }
        return false;
    }
};
struct FEpiOut { static constexpr int NST = 0; const float* x; const float* modv; float* r1;
    __device__ __forceinline__ bool operator()(const f32x4 (&acc)[2][2][4][2], const Unit& u, int wr, int wc, int fr, int fq) const {
        const int row0 = u.pm * BM + wr * 64 + fr, col0 = u.pn * BM + wc * 32 + 8 * fq;
        const float* g = modv + (u.pm * BM / SEQ) * 6144 + 2048 + col0;
        f32x4 gv[2][2];
#pragma unroll
        for (int bj = 0; bj < 2; ++bj)
#pragma unroll
            for (int n = 0; n < 2; ++n) gv[bj][n] = *(const f32x4*)(g + bj * HALF + 4 * n);
#pragma unroll
        PG8_FRAG_LOOP { const size_t o = (size_t)(row0 + ai * HALF + m * 16) * DM + col0 + bj * HALF;
            const f32x4 x0 = *(const f32x4*)(x + o), x1 = *(const f32x4*)(x + o + 4);
            *(f32x4*)(r1 + o) = x0 * ALPHA + gv[bj][0] * acc[ai][bj][m][0]; *(f32x4*)(r1 + o + 4) = x1 * ALPHA + gv[bj][1] * acc[ai][bj][m][1]; }
        return false;
    }
};
struct FEpiDown { static constexpr int NST = 0; float* h; const float* modv; const float* b_down;
    __device__ __forceinline__ bool operator()(const f32x4 (&acc)[2][2][4][2], const Unit& u, int wr, int wc, int fr, int fq) const {
        const int row0 = u.pm * BM + wr * 64 + fr, col0 = u.pn * BM + wc * 32 + 8 * fq;
        const float* g = modv + (u.pm * BM / SEQ) * 6144 + 5120 + col0;
#pragma unroll
        for (int bj = 0; bj < 2; ++bj) {
            const f32x4 g0 = *(const f32x4*)(g + bj * HALF), g1 = *(const f32x4*)(g + bj * HALF + 4);
            const f32x4 c0 = g0 * *(const f32x4*)(b_down + col0 + bj * HALF), c1 = g1 * *(const f32x4*)(b_down + col0 + bj * HALF + 4);
#pragma unroll
            for (int ai = 0; ai < 2; ++ai)
#pragma unroll
                for (int m = 0; m < 4; ++m) { float* p = h + (size_t)(row0 + ai * HALF + m * 16) * DM + col0 + bj * HALF;
                    const f32x4 h0 = *(const f32x4*)p, h1 = *(const f32x4*)(p + 4);
                    *(f32x4*)p = h0 * ALPHA + (g0 * acc[ai][bj][m][0] + c0); *(f32x4*)(p + 4) = h1 * ALPHA + (g1 * acc[ai][bj][m][1] + c1);
                    if (m & 1) asm volatile("" ::: "memory"); }
        }
        return false;
    }
};

typedef unsigned u32x2p __attribute__((ext_vector_type(2)));
__device__ __forceinline__ float sum_rows4(float x) {
    const u32x2p a = __builtin_amdgcn_permlane32_swap(__float_as_uint(x), __float_as_uint(x), false, false); const float y = __uint_as_float(a[0]) + __uint_as_float(a[1]);
    const u32x2p b = __builtin_amdgcn_permlane16_swap(__float_as_uint(y), __float_as_uint(y), false, false); return __uint_as_float(b[0]) + __uint_as_float(b[1]); }
struct LnX { float* stats; unsigned* cnt; PG8_LAS float* sx; int x, pad; };
__device__ __forceinline__ void ln_exchange(const float (&ps)[2][4], const float (&pq)[2][4], const Unit& u, const LnX& L, int wr, int wc, int fr, int fq) {
    int tid = threadIdx.x; asm volatile("" : "+v"(tid)); const int lp = u.pm & 15;
#pragma unroll
    for (int ai = 0; ai < 2; ++ai)
#pragma unroll
        for (int m = 0; m < 4; ++m) { float s = ps[ai][m], q = pq[ai][m];
            s = sum_rows4(s); q = sum_rows4(q);
            if (fq == 0) { const int row = 128 * ai + 64 * wr + 16 * m + fr; L.sx[(wc * 256 + row) * 2] = s; L.sx[(wc * 256 + row) * 2 + 1] = q; } }
    __syncthreads();
    float* sb = L.stats + (size_t)((L.x * 16 + lp) * 4) * 512;
    float s_own = 0.f, q_own = 0.f;
    if (tid < 256) {
#pragma unroll
        for (int w = 0; w < 4; ++w) { s_own += L.sx[(w * 256 + tid) * 2]; q_own += L.sx[(w * 256 + tid) * 2 + 1]; }
        float2 o; o.x = s_own; o.y = q_own; *(float2*)(sb + (size_t)u.pn * 512 + tid * 2) = o; }
    asm volatile("s_waitcnt vmcnt(0)" ::: "memory");
    __syncthreads();
    if (tid == 0) { unsigned* cw = L.cnt + (L.x * 16 + lp) * 64;
        (void)__hip_atomic_fetch_add(cw, 1u, __ATOMIC_RELAXED, __HIP_MEMORY_SCOPE_AGENT);
        unsigned sp = 0; while (__hip_atomic_load(cw, __ATOMIC_RELAXED, __HIP_MEMORY_SCOPE_AGENT) < 4u) { __builtin_amdgcn_s_sleep(1); if (++sp > (1u << 22)) break; } }
    __syncthreads();
    if (tid < 256) {
#pragma unroll
        for (int o = 1; o < 4; ++o) { const int pn2 = (u.pn + o) & 3; const float* pp = sb + (size_t)pn2 * 512 + tid * 2;
            s_own += __hip_atomic_load(pp, __ATOMIC_RELAXED, __HIP_MEMORY_SCOPE_AGENT); q_own += __hip_atomic_load(pp + 1, __ATOMIC_RELAXED, __HIP_MEMORY_SCOPE_AGENT); }
        const float mean = s_own * (1.f / DM); const float var = fmaxf(q_own * (1.f / DM) - mean * mean, 0.f);
        L.sx[(4 * 256 + tid) * 2] = mean; L.sx[(4 * 256 + tid) * 2 + 1] = rsqrtf(var + EPS); }
    __syncthreads();
}
struct FEpiOutLN { static constexpr int NST = 0; const float* x; const float* modv; float* h1; bf16_t* u2; const float* gam; const float* bet; LnX L;
    __device__ __forceinline__ bool operator()(f32x4 (&acc)[2][2][4][2], const Unit& u, int wr, int wc, int fr, int fq) const {
        asm volatile("" : "+v"(fr), "+v"(fq));
        const int row0 = u.pm * BM + wr * 64 + fr, col0 = u.pn * BM + wc * 32 + 8 * fq;
        const float* mv = modv + (u.pm * BM / SEQ) * 6144;
        const unsigned ob = (unsigned)(row0 * DM + col0) * 4u;
        const char* xb = (const char*)x; char* hb = (char*)h1; char* ub = (char*)u2;
        float ps[2][4], pq[2][4];
#pragma unroll
        for (int ai = 0; ai < 2; ++ai)
#pragma unroll
            for (int m = 0; m < 4; ++m) { ps[ai][m] = 0.f; pq[ai][m] = 0.f; }
        unsigned obd = ob;
#pragma unroll
        for (int bj = 0; bj < 2; ++bj) { const f32x4 g0 = *(const f32x4*)(mv + 2048 + col0 + bj * HALF), g1 = *(const f32x4*)(mv + 2048 + col0 + bj * HALF + 4);
#pragma unroll
            for (int ai = 0; ai < 2; ++ai) {
#pragma unroll
                for (int m = 0; m < 4; ++m) { const unsigned o = obd + (unsigned)(((ai * HALF + m * 16) * DM + bj * HALF) * 4);
                    const f32x4 v0 = *(const f32x4*)(xb + o) * ALPHA + g0 * acc[ai][bj][m][0], v1 = *(const f32x4*)(xb + o + 16) * ALPHA + g1 * acc[ai][bj][m][1];
                    acc[ai][bj][m][0] = v0; acc[ai][bj][m][1] = v1;
                    ps[ai][m] += ((v0[0] + v0[1]) + (v0[2] + v0[3])) + ((v1[0] + v1[1]) + (v1[2] + v1[3]));
                    pq[ai][m] += ((v0[0] * v0[0] + v0[1] * v0[1]) + (v0[2] * v0[2] + v0[3] * v0[3])) + ((v1[0] * v1[0] + v1[1] * v1[1]) + (v1[2] * v1[2] + v1[3] * v1[3])); }
                asm volatile("" : "+v"(obd) : "v"(pq[ai][3]), "v"(pq[ai][0]), "v"(pq[ai][1]), "v"(pq[ai][2])); } }
        ln_exchange(ps, pq, u, L, wr, wc, fr, fq);
#pragma unroll
        for (int bj = 0; bj < 2; ++bj) { const int cc = col0 + bj * HALF;
            const f32x4 ga0 = *(const f32x4*)(gam + cc), ga1 = *(const f32x4*)(gam + cc + 4), be0 = *(const f32x4*)(bet + cc), be1 = *(const f32x4*)(bet + cc + 4);
#pragma unroll
            for (int ai = 0; ai < 2; ++ai)
#pragma unroll
                for (int m = 0; m < 4; ++m) { const int rl = 128 * ai + 64 * wr + 16 * m + fr; const float mean = L.sx[(4 * 256 + rl) * 2], rstd = L.sx[(4 * 256 + rl) * 2 + 1];
                    const unsigned o = ob + (unsigned)(((ai * HALF + m * 16) * DM + bj * HALF) * 4);
                    acc[ai][bj][m][0] = (acc[ai][bj][m][0] - mean) * rstd * ga0 + be0; acc[ai][bj][m][1] = (acc[ai][bj][m][1] - mean) * rstd * ga1 + be1;
                    *(f32x4*)(hb + o) = acc[ai][bj][m][0]; *(f32x4*)(hb + o + 16) = acc[ai][bj][m][1];
                    asm volatile("" ::: "memory"); } }
#pragma unroll
        for (int bj = 0; bj < 2; ++bj) { const int cc = col0 + bj * HALF;
            const f32x4 sh0 = *(const f32x4*)(mv + 3072 + cc), sh1 = *(const f32x4*)(mv + 3072 + cc + 4), sc0 = *(const f32x4*)(mv + 4096 + cc) + 1.f, sc1 = *(const f32x4*)(mv + 4096 + cc + 4) + 1.f;
#pragma unroll
            for (int ai = 0; ai < 2; ++ai)
#pragma unroll
                for (int m = 0; m < 4; ++m) { const unsigned o = ob + (unsigned)(((ai * HALF + m * 16) * DM + bj * HALF) * 4);
                    *(u32x4*)(ub + (o >> 1)) = pack8(acc[ai][bj][m][0] * sc0 + sh0, acc[ai][bj][m][1] * sc1 + sh1);
                    asm volatile("" ::: "memory"); } }
        return false;
    }
};
struct FEpiDownLN { static constexpr int NST = 0; float* h; const float* modv; const float* b_down; const float* gam; const float* bet; LnX L;
    __device__ __forceinline__ bool operator()(f32x4 (&acc)[2][2][4][2], const Unit& u, int wr, int wc, int fr, int fq) const {
        asm volatile("" : "+v"(fr), "+v"(fq));
        const int row0 = u.pm * BM + wr * 64 + fr, col0 = u.pn * BM + wc * 32 + 8 * fq;
        const float* mv = modv + (u.pm * BM / SEQ) * 6144;
        const unsigned ob = (unsigned)(row0 * DM + col0) * 4u;
        char* hb = (char*)h;
        float ps[2][4], pq[2][4];
#pragma unroll
        for (int ai = 0; ai < 2; ++ai)
#pragma unroll
            for (int m = 0; m < 4; ++m) { ps[ai][m] = 0.f; pq[ai][m] = 0.f; }
        unsigned obd = ob;
#pragma unroll
        for (int bj = 0; bj < 2; ++bj) { const f32x4 g0 = *(const f32x4*)(mv + 5120 + col0 + bj * HALF), g1 = *(const f32x4*)(mv + 5120 + col0 + bj * HALF + 4);
            const f32x4 c0 = g0 * *(const f32x4*)(b_down + col0 + bj * HALF), c1 = g1 * *(const f32x4*)(b_down + col0 + bj * HALF + 4);
#pragma unroll
            for (int ai = 0; ai < 2; ++ai) {
#pragma unroll
                for (int m = 0; m < 4; ++m) { const unsigned o = obd + (unsigned)(((ai * HALF + m * 16) * DM + bj * HALF) * 4);
                    const f32x4 v0 = *(const f32x4*)(hb + o) * ALPHA + (g0 * acc[ai][bj][m][0] + c0), v1 = *(const f32x4*)(hb + o + 16) * ALPHA + (g1 * acc[ai][bj][m][1] + c1);
                    acc[ai][bj][m][0] = v0; acc[ai][bj][m][1] = v1;
                    ps[ai][m] += ((v0[0] + v0[1]) + (v0[2] + v0[3])) + ((v1[0] + v1[1]) + (v1[2] + v1[3]));
                    pq[ai][m] += ((v0[0] * v0[0] + v0[1] * v0[1]) + (v0[2] * v0[2] + v0[3] * v0[3])) + ((v1[0] * v1[0] + v1[1] * v1[1]) + (v1[2] * v1[2] + v1[3] * v1[3]));
                    }
                asm volatile("" : "+v"(obd) : "v"(pq[ai][3]), "v"(pq[ai][0]), "v"(pq[ai][1]), "v"(pq[ai][2])); } }
        ln_exchange(ps, pq, u, L, wr, wc, fr, fq);
#pragma unroll
        for (int bj = 0; bj < 2; ++bj) { const int cc = col0 + bj * HALF;
            const f32x4 ga0 = *(const f32x4*)(gam + cc), ga1 = *(const f32x4*)(gam + cc + 4), be0 = *(const f32x4*)(bet + cc), be1 = *(const f32x4*)(bet + cc + 4);
#pragma unroll
            for (int ai = 0; ai < 2; ++ai)
#pragma unroll
                for (int m = 0; m < 4; ++m) { const int rl = 128 * ai + 64 * wr + 16 * m + fr; const float mean = L.sx[(4 * 256 + rl) * 2], rstd = L.sx[(4 * 256 + rl) * 2 + 1];
                    const unsigned o = ob + (unsigned)(((ai * HALF + m * 16) * DM + bj * HALF) * 4);
                    *(f32x4*)(hb + o) = (acc[ai][bj][m][0] - mean) * rstd * ga0 + be0; *(f32x4*)(hb + o + 16) = (acc[ai][bj][m][1] - mean) * rstd * ga1 + be1;
                    asm volatile("" ::: "memory"); } }
        return false;
    }
};
struct FEpiSideF { static constexpr int NST = 0; bf16_t* side; const float* bias; bf16_t* hm; bf16_t* hg; const float* gm; const float* gg; PG8_LAS float* sx;
    __device__ __forceinline__ bool operator()(f32x4 (&acc)[2][2][4][2], const Unit& u, int wr, int wc, int fr, int fq) const {
        asm volatile("" : "+v"(fr), "+v"(fq));
        const int row0 = u.pm * BM + wr * 64 + fr, cin = wc * 32 + 8 * fq;
        if (u.pn >= 8) {
            f32x4 bv[2][2];
#pragma unroll
            for (int bj = 0; bj < 2; ++bj)
#pragma unroll
                for (int n = 0; n < 2; ++n) bv[bj][n] = *(const f32x4*)(bias + u.pn * BM + cin + bj * HALF + 4 * n);
#pragma unroll
            PG8_FRAG_LOOP { *(u32x4*)(side + (size_t)(row0 + ai * HALF + m * 16) * 4096 + u.pn * BM + cin + bj * HALF) = pack8(acc[ai][bj][m][0] + bv[bj][0], acc[ai][bj][m][1] + bv[bj][1]); }
            return false;
        }
        const bool isg = u.pn >= 4;
        char* hb = (char*)(isg ? hg : hm); const int hc0 = (u.pn & 3) * BM + cin;
        const unsigned ob = (unsigned)(row0 * DM + hc0) * 2u;
        const unsigned OB = (unsigned)ML * DM * 2u;
        int tid = threadIdx.x; asm volatile("" : "+v"(tid));
        unsigned obd = ob;
#pragma unroll
        for (int bj = 0; bj < 2; ++bj)
            {
                float ps[2][4], pq[2][4];
#pragma unroll
                for (int ai = 0; ai < 2; ++ai)
#pragma unroll
                for (int m = 0; m < 4; ++m) { const unsigned o = obd + (unsigned)(((ai * HALF + m * 16) * DM + bj * HALF) * 2);
                    f32x4 f0, f1, b0, b1; unpack8(*(const u32x4*)(hb + o), f0, f1); unpack8(*(const u32x4*)(hb + o + OB), b0, b1);
                    const f32x4 v0 = f0 + b0, v1 = f1 + b1;
                    ps[ai][m] = ((v0[0] + v0[1]) + (v0[2] + v0[3])) + ((v1[0] + v1[1]) + (v1[2] + v1[3]));
                    pq[ai][m] = ((v0[0] * v0[0] + v0[1] * v0[1]) + (v0[2] * v0[2] + v0[3] * v0[3])) + ((v1[0] * v1[0] + v1[1] * v1[1]) + (v1[2] * v1[2] + v1[3] * v1[3])); }
                asm volatile("" : "+v"(obd) : "v"(pq[0][0]), "v"(pq[0][3]), "v"(pq[1][0]), "v"(pq[1][3]));
#pragma unroll
                for (int ai = 0; ai < 2; ++ai)
#pragma unroll
                for (int m = 0; m < 4; ++m) { const float s = sum_rows4(ps[ai][m]), q = sum_rows4(pq[ai][m]);
                    if (fq == 0) { const int row = 128 * ai + 64 * wr + 16 * m + fr; sx[((wc * 2 + bj) * 256 + row) * 2] = s; sx[((wc * 2 + bj) * 256 + row) * 2 + 1] = q; } } }
        __syncthreads();
        { const int rr = tid & 255, bb = tid >> 8; float s = 0.f, q = 0.f, q2 = 0.f;
#pragma unroll
          for (int w = 0; w < 4; ++w) { s += sx[((w * 2 + bb) * 256 + rr) * 2]; q += sx[((w * 2 + bb) * 256 + rr) * 2 + 1]; q2 += sx[((w * 2 + (bb ^ 1)) * 256 + rr) * 2 + 1]; }
          float mean, rstd;
          if (isg) { mean = 0.f; rstd = rsqrtf((q + q2) * (1.f / 256.f) + EPS); }
          else { mean = s * (1.f / 128.f); rstd = rsqrtf(fmaxf(q * (1.f / 128.f) - mean * mean, 0.f) + EPS); }
          __syncthreads();
          sx[(bb * 256 + rr) * 2] = mean; sx[(bb * 256 + rr) * 2 + 1] = rstd; }
        __syncthreads();
        obd = ob;
#pragma unroll
        for (int bj = 0; bj < 2; ++bj) { const float* bp = bias + u.pn * BM + cin + bj * HALF;
            const f32x4 gma0 = *(const f32x4*)(gm + hc0 + bj * HALF), gma1 = *(const f32x4*)(gm + hc0 + bj * HALF + 4), gga0 = *(const f32x4*)(gg + hc0 + bj * HALF), gga1 = *(const f32x4*)(gg + hc0 + bj * HALF + 4);
            const f32x4 ga0 = isg ? gga0 : gma0, ga1 = isg ? gga1 : gma1, bi0 = *(const f32x4*)bp, bi1 = *(const f32x4*)(bp + 4);
            float dep = 0.f;
#pragma unroll
            for (int ai = 0; ai < 2; ++ai) {
#pragma unroll
                for (int m = 0; m < 4; ++m) { const int rl = 128 * ai + 64 * wr + 16 * m + fr; const float mean = sx[(bj * 256 + rl) * 2], rstd = sx[(bj * 256 + rl) * 2 + 1];
                    const unsigned o = obd + (unsigned)(((ai * HALF + m * 16) * DM + bj * HALF) * 2);
                    f32x4 f0, f1, b0, b1; unpack8(*(const u32x4*)(hb + o), f0, f1); unpack8(*(const u32x4*)(hb + o + OB), b0, b1);
                    const f32x4 g0 = acc[ai][bj][m][0] + bi0, g1 = acc[ai][bj][m][1] + bi1;
                    f32x4 o0 = (f0 + b0 - mean) * rstd * ga0, o1 = (f1 + b1 - mean) * rstd * ga1;
#pragma unroll
                    for (int j = 0; j < 4; ++j) { const float s0 = fsig(g0[j]), s1 = fsig(g1[j]); o0[j] *= isg ? g0[j] * s0 : s0; o1[j] *= isg ? g1[j] * s1 : s1; }
                    *(u32x4*)(hb + o) = pack8(o0, o1); dep = o1[3]; } }
            asm volatile("" : "+v"(obd) : "v"(dep)); }
        return false;
    }
};
}

namespace scan {
#define LAS __attribute__((address_space(3)))
typedef short bf16x8 __attribute__((ext_vector_type(8)));
typedef short s16x4 __attribute__((ext_vector_type(4)));
typedef float f32x4 __attribute__((ext_vector_type(4)));
typedef unsigned u32x4 __attribute__((ext_vector_type(4)));
typedef unsigned u32x2 __attribute__((ext_vector_type(2)));
constexpr int RS = 288, RSP = 144, RSG = 80;
constexpr int TILE = 64 * RS;
constexpr int L_T = 0;
constexpr int L_P = 6 * TILE;
constexpr int L_SC = L_P + 64 * RSP;
constexpr int SC_F = 0, SC_QN = 768  , SC_RS = 832  , SC_N = 896  , SC_DEC = 1152  , SC_GB = 1408  ,
              SC_CW = 1536  , SC_END = 2304;
constexpr int L_GW = L_SC + SC_END * 4;
constexpr int L_R = L_GW + 128 * RSG;
constexpr int LDS_BYTES = L_R + 2 * 64 * RSG;
constexpr int XSLOT = 16640;
static_assert(LDS_BYTES <= 160 * 1024 && L_SC % 16 == 0 && L_GW % 16 == 0 && L_R % 16 == 0, "scan LDS");

typedef float f32x2_t __attribute__((ext_vector_type(2))); typedef __bf16 bf16x2_t __attribute__((ext_vector_type(2)));
__device__ __forceinline__ unsigned cvt_pk(float lo, float hi) { f32x2_t v = {lo, hi}; bf16x2_t b = __builtin_convertvector(v, bf16x2_t); return __builtin_bit_cast(unsigned, b); }
__device__ __forceinline__ s16x4 tr16(const LAS unsigned char* p) { return __builtin_bit_cast(s16x4, __builtin_amdgcn_ds_read_tr16_b64_v4i16((LAS s16x4*)p)); }
__device__ __forceinline__ bf16x8 cat4(s16x4 a, s16x4 b) { return (bf16x8){a[0], a[1], a[2], a[3], b[0], b[1], b[2], b[3]}; }
__device__ __forceinline__ void unpack8f(u32x4 w, float* v) {
    v[0] = __uint_as_float(w.x << 16); v[1] = __uint_as_float(w.x & 0xffff0000u); v[2] = __uint_as_float(w.y << 16); v[3] = __uint_as_float(w.y & 0xffff0000u);
    v[4] = __uint_as_float(w.z << 16); v[5] = __uint_as_float(w.z & 0xffff0000u); v[6] = __uint_as_float(w.w << 16); v[7] = __uint_as_float(w.w & 0xffff0000u); }
__device__ __forceinline__ float fsilu(float x) { return x * __builtin_amdgcn_rcpf(1.f + __expf(-x)); }
template <int CTRL, int RMASK> __device__ __forceinline__ float dpp_f(float old, float x) { return __int_as_float(__builtin_amdgcn_update_dpp(__float_as_int(old), __float_as_int(x), CTRL, RMASK, 0xf, false)); }
__device__ __forceinline__ float scan_sum64(float x) {
    x += dpp_f<0x111, 0xf>(0.f, x); x += dpp_f<0x112, 0xf>(0.f, x); x += dpp_f<0x114, 0xf>(0.f, x); x += dpp_f<0x118, 0xf>(0.f, x);
    x += dpp_f<0x142, 0xa>(0.f, x); x += dpp_f<0x143, 0xc>(0.f, x); return x; }
__device__ __forceinline__ float scan_max64(float x) {
    const float NI = -__builtin_inff();
    x = fmaxf(x, dpp_f<0x111, 0xf>(NI, x)); x = fmaxf(x, dpp_f<0x112, 0xf>(NI, x)); x = fmaxf(x, dpp_f<0x114, 0xf>(NI, x)); x = fmaxf(x, dpp_f<0x118, 0xf>(NI, x));
    x = fmaxf(x, dpp_f<0x142, 0xa>(NI, x)); x = fmaxf(x, dpp_f<0x143, 0xc>(NI, x)); return x; }
__device__ __forceinline__ float lane63(float x) { return __int_as_float(__builtin_amdgcn_readlane(__float_as_int(x), 63)); }

template <int V> struct IC { static constexpr int value = V; };
struct Args {
    const bf16_t* P; int ld, pad;
    const float* small;
    const float* conv_qk;
    const float* gw_f; const float* gb_f; const float* gw_b; const float* gb_b;
    bf16_t* hout;
    unsigned char* xbuf; unsigned* xflag;
};

template <bool GLA>
__device__ __forceinline__ void scan_item(LAS unsigned char* lds, const Args& a, const int item) {
    int tid_ = threadIdx.x; asm volatile("" : "+v"(tid_));
    const int tid = tid_, lane = tid & 63, wid = __builtin_amdgcn_readfirstlane(tid >> 6), c = lane & 15, g = lane >> 4;
    LAS float* sc = (LAS float*)(lds + L_SC);
    int b, h, dir, half = 0;
    if (GLA) { half = item & 1; dir = (item >> 1) & 1; h = (item >> 2) & 3; b = item >> 4; } else { dir = item & 1; h = (item >> 1) & 7; b = item >> 4; }
    const int colq = h * 128, colk = GLA ? 512 + h * 128 : 1024 + h * 128, colv = GLA ? 1024 + h * 256 + half * 128 : 2048 + h * 128;
    const int ocol = GLA ? h * 256 + half * 128 : h * 128;
    bf16_t* hout = a.hout + (size_t)dir * ML * DM;
    const float* gw = dir ? a.gw_b : a.gw_f; const float* gbp = dir ? a.gb_b : a.gb_f;

    for (int i = tid; i < 256; i += 512) sc[SC_N + i] = 0.f;
    if (GLA) {
        for (int i = tid; i < 2048; i += 512) { const int d = i >> 4, k = i & 15; const float v = gw[k * 512 + h * 128 + d] * 1.4426950408889634f; const bf16_t hv = f2bf(v), lv = f2bf(v - bf2f(hv));
            *(LAS bf16_t*)(lds + L_GW + d * RSG + k * 2) = hv; *(LAS bf16_t*)(lds + L_GW + d * RSG + 32 + k * 2) = lv; }
        if (tid < 128) sc[SC_GB + tid] = gbp[h * 128 + tid] * 1.4426950408889634f;
    } else if (tid < 256) { const int e = tid & 127, isk = tid >> 7; const int ch = (isk ? 1024 : 0) + h * 128 + e;
        const float w0 = a.conv_qk[ch] * 1.4426950408889634f, w1 = a.conv_qk[2048 + ch] * 1.4426950408889634f, w2 = a.conv_qk[4096 + ch] * 1.4426950408889634f;
        sc[SC_CW + (isk * 3 + 0) * 128 + e] = dir ? w2 : w0; sc[SC_CW + (isk * 3 + 1) * 128 + e] = w1; sc[SC_CW + (isk * 3 + 2) * 128 + e] = dir ? w0 : w2; }

#define SCAN_ROW(cc_, p_, rowv) do { const int seg_ = (cc_) < 4 ? 0 : 1; const int T_ = seg_ ? SEQ : CTX; const int row0_ = seg_ ? b * SEQ : ML + b * CTX; \
        int pp_ = (p_); pp_ = pp_ < 0 ? 0 : (pp_ > T_ - 1 ? T_ - 1 : pp_); const int t_ = dir ? (T_ - 1 - pp_) : pp_; rowv = row0_ + t_; } while (0)
#define SCAN_CI(cc_) ((cc_) < 4 ? (cc_) : (cc_) - 4)

    if (wid >= 4) {
        const int ptid = tid - 256, pw = wid - 4, cg = ptid & 15;
        __builtin_amdgcn_s_setprio(1);
        u32x4 rawvS[2][4];
        u32x4 rawmS[2][10]; u32x2 rawqS[2][8], rawkS[2][8];
        float m_run = 0.f, pre_liS[2] = {0.f, 0.f}, pre_lfS[2] = {0.f, 0.f};
        f32x4 pre_rS[2][4];
#pragma unroll
        for (int i = 0; i < 4; ++i) { pre_rS[0][i] = (f32x4){0.f, 0.f, 0.f, 0.f}; pre_rS[1][i] = (f32x4){0.f, 0.f, 0.f, 0.f}; }
        const int which = pw >> 1, rg = (ptid >> 4) & 7;
        if (GLA) {
            u32x4 vr[2][4]; u32x2 qr[2][4], kr[2][4]; f32x4 prr[4];
#pragma unroll
            for (int i = 0; i < 4; ++i) prr[i] = (f32x4){0.f, 0.f, 0.f, 0.f};
            const char* pbG = (const char*)a.P; const unsigned ldbG = (unsigned)a.ld * 2u;
#define GLA_GV(S_, cc_) do { const int ci_ = SCAN_CI(cc_); _Pragma("unroll") for (int k_ = 0; k_ < 4; ++k_) { int row; SCAN_ROW(cc_, ci_ * 64 + (ptid >> 4) + 16 * k_, row); \
                vr[S_][k_] = *(const u32x4*)(pbG + ((unsigned)row * ldbG + (unsigned)(colv + cg * 8) * 2u)); } } while (0)
#define GLA_GQK(S_, cc_) do { const int ci_ = SCAN_CI(cc_); const bool sq_ = (cc_) >= 4; _Pragma("unroll") for (int tl_ = 0; tl_ < 4; ++tl_) { int row; SCAN_ROW(cc_, ci_ * 64 + 16 * tl_ + c, row); \
                const unsigned ro_ = (unsigned)row * ldbG + (unsigned)(16 * (4 * half + pw) + 4 * g) * 2u; \
                if (sq_) qr[S_][tl_] = *(const u32x2*)(pbG + (ro_ + (unsigned)colq * 2u)); kr[S_][tl_] = *(const u32x2*)(pbG + (ro_ + (unsigned)colk * 2u)); } } while (0)
#define GLA_GR(cc_) do { if (pw == 0) { const int ci_ = SCAN_CI(cc_); int row; SCAN_ROW(cc_, ci_ * 64 + lane, row); const char* sb_ = (const char*)a.small; const unsigned so_ = (unsigned)row * 256u; \
                _Pragma("unroll") for (int i_ = 0; i_ < 4; ++i_) prr[i_] = *(const f32x4*)(sb_ + (so_ + (unsigned)(32 + dir * 16 + 4 * i_) * 4u)); } } while (0)
            auto grw = [&](const int buf) __attribute__((always_inline)) {
                if (pw == 0) {
                    unsigned hi[8], lo[8];
#pragma unroll
                    for (int i = 0; i < 4; ++i) { const f32x4 v = prr[i]; const unsigned h0 = cvt_pk(v[0], v[1]), h1 = cvt_pk(v[2], v[3]);
                        hi[2 * i] = h0; hi[2 * i + 1] = h1;
                        lo[2 * i] = cvt_pk(v[0] - __uint_as_float(h0 << 16), v[1] - __uint_as_float(h0 & 0xffff0000u)); lo[2 * i + 1] = cvt_pk(v[2] - __uint_as_float(h1 << 16), v[3] - __uint_as_float(h1 & 0xffff0000u)); }
                    LAS unsigned char* rp = lds + L_R + buf * (64 * RSG) + lane * RSG;
                    *(LAS u32x4*)rp = (u32x4){hi[0], hi[1], hi[2], hi[3]}; *(LAS u32x4*)(rp + 16) = (u32x4){hi[4], hi[5], hi[6], hi[7]};
                    *(LAS u32x4*)(rp + 32) = (u32x4){lo[0], lo[1], lo[2], lo[3]}; *(LAS u32x4*)(rp + 48) = (u32x4){lo[4], lo[5], lo[6], lo[7]}; }
            };
            auto produce = [&](auto setc, const int cn) __attribute__((always_inline)) {
                constexpr int S = decltype(setc)::value;
                const bool sq = cn >= 4; const int pn = cn & 1, dt = 4 * half + pw;
                unsigned char* xo = a.xbuf + (size_t)(((item * 8) + (cn & 7)) * XSLOT);
                const LAS unsigned char* gwb = lds + L_GW + (16 * dt + c) * RSG + 16 * (g & 1);
                const bf16x8 A1 = *(const LAS bf16x8*)gwb, A2 = *(const LAS bf16x8*)(gwb + 32);
                const f32x4 gbv = *(const LAS f32x4*)(sc + SC_GB + 16 * dt + 4 * g);
                const LAS unsigned char* rb = lds + L_R + pn * (64 * RSG) + c * RSG + 16 * g;
                f32x4 x[4];
#pragma unroll
                for (int tl = 0; tl < 4; ++tl) {
                    const bf16x8 B = *(const LAS bf16x8*)(rb + tl * 16 * RSG);
                    f32x4 acc = __builtin_amdgcn_mfma_f32_16x16x32_bf16(A1, B, gbv, 0, 0, 0);
                    acc = __builtin_amdgcn_mfma_f32_16x16x32_bf16(A2, B, acc, 0, 0, 0);
#pragma unroll
                    for (int i = 0; i < 4; ++i) { float v = __builtin_amdgcn_logf(1.f + __builtin_amdgcn_exp2f(-fmaxf(acc[i], -115.f))) * -0.0625f;
                        v += dpp_f<0x111, 0xf>(0.f, v); v += dpp_f<0x112, 0xf>(0.f, v); v += dpp_f<0x114, 0xf>(0.f, v); v += dpp_f<0x118, 0xf>(0.f, v);
                        acc[i] = v; }
                    x[tl] = acc;
                }
                f32x4 off = (f32x4){0.f, 0.f, 0.f, 0.f};
#pragma unroll
                for (int tl = 0; tl < 4; ++tl) { f32x4 tot;
#pragma unroll
                    for (int i = 0; i < 4; ++i) tot[i] = dpp_f<0x15F, 0xf>(0.f, x[tl][i]);
                    x[tl] += off; off += tot; }
                if (c == 0) { f32x4 dec;
#pragma unroll
                    for (int i = 0; i < 4; ++i) dec[i] = __builtin_amdgcn_exp2f(off[i]);
                    *(f32x4*)(xo + 16384 + (16 * pw + 4 * g) * 4) = dec; }
                const f32x4 offq = off + 3.5f;
#pragma unroll
                for (int tl = 0; tl < 4; ++tl) {
                    const int t = 16 * tl + c;
                    if (sq) { const u32x2 qw = qr[S][tl]; const f32x4 eq = x[tl] - offq;
                        const float q0 = __uint_as_float(qw.x << 16), q1 = __uint_as_float(qw.x & 0xffff0000u), q2 = __uint_as_float(qw.y << 16), q3 = __uint_as_float(qw.y & 0xffff0000u);
                        u32x2 w; w.x = cvt_pk(q0 * __builtin_amdgcn_exp2f(fminf(eq[0], 110.f)), q1 * __builtin_amdgcn_exp2f(fminf(eq[1], 110.f)));
                        w.y = cvt_pk(q2 * __builtin_amdgcn_exp2f(fminf(eq[2], 110.f)), q3 * __builtin_amdgcn_exp2f(fminf(eq[3], 110.f)));
                        *(u32x2*)(xo + t * 128 + (16 * pw + 4 * g) * 2) = w; }
                    { const u32x2 kw = kr[S][tl]; const f32x4 ek = off - x[tl];
                        const float k0 = __uint_as_float(kw.x << 16), k1 = __uint_as_float(kw.x & 0xffff0000u), k2 = __uint_as_float(kw.y << 16), k3 = __uint_as_float(kw.y & 0xffff0000u);
                        u32x2 w; w.x = cvt_pk(k0 * __builtin_amdgcn_exp2f(ek[0]), k1 * __builtin_amdgcn_exp2f(ek[1])); w.y = cvt_pk(k2 * __builtin_amdgcn_exp2f(ek[2]), k3 * __builtin_amdgcn_exp2f(ek[3]));
                        *(u32x2*)(xo + 8192 + t * 128 + (16 * pw + 4 * g) * 2) = w; }
                }
            };
            u32x4 cq[4], ck[4]; f32x4 cd = (f32x4){0.f, 0.f, 0.f, 0.f};
            const int crow = ptid >> 2, cpc = ptid & 3;
            auto cload = [&](const int cn) __attribute__((always_inline)) {
                const unsigned char* xi = a.xbuf + (size_t)(((((item & ~1) | (cpc >> 1)) * 8) + (cn & 7)) * XSLOT) + crow * 128 + (cpc & 1) * 64;
                if (cn >= 4) {
#pragma unroll
                    for (int k = 0; k < 4; ++k) cq[k] = *(const u32x4*)(xi + 16 * k); }
#pragma unroll
                for (int k = 0; k < 4; ++k) ck[k] = *(const u32x4*)(xi + 8192 + 16 * k);
                if (ptid < 32) cd = *(const f32x4*)(a.xbuf + (size_t)(((((item & ~1) | (ptid >> 4)) * 8) + (cn & 7)) * XSLOT) + 16384 + (ptid & 15) * 16);
            };
            auto cstore = [&](auto setc, const int cn) __attribute__((always_inline)) {
                constexpr int S = decltype(setc)::value; const int pn = cn & 1;
                LAS unsigned char* tq = lds + L_T + pn * 3 * TILE; LAS unsigned char* tk = tq + TILE; LAS unsigned char* tv = tq + 2 * TILE;
                if (cn >= 4) {
#pragma unroll
                    for (int k = 0; k < 4; ++k) *(LAS u32x4*)(tq + crow * RS + cpc * 64 + 16 * k) = cq[k]; }
#pragma unroll
                for (int k = 0; k < 4; ++k) *(LAS u32x4*)(tk + crow * RS + cpc * 64 + 16 * k) = ck[k];
#pragma unroll
                for (int k = 0; k < 4; ++k) *(LAS u32x4*)(tv + ((ptid >> 4) + 16 * k) * RS + cg * 16) = vr[S][k];
                if (ptid < 32) *(LAS f32x4*)(sc + SC_DEC + pn * 128 + 64 * (ptid >> 4) + 4 * (ptid & 15)) = cd;
            };
            unsigned flv = 0u;
            auto xpub = [&](const unsigned pubv, const unsigned target, const bool inval) __attribute__((always_inline)) {
                if (ptid == 0) { __hip_atomic_store(a.xflag + item * 64, pubv, __ATOMIC_RELAXED, __HIP_MEMORY_SCOPE_AGENT);
                    if (flv < target) { unsigned sp = 0; while (__hip_atomic_load(a.xflag + (item ^ 1) * 64, __ATOMIC_RELAXED, __HIP_MEMORY_SCOPE_AGENT) < target) { __builtin_amdgcn_s_sleep(1); if (++sp > (1u << 22)) break; } }
                    if (inval) { __builtin_amdgcn_fence(__ATOMIC_ACQUIRE, "agent"); asm volatile("s_waitcnt vmcnt(0)" ::: "memory"); } }
            };
            GLA_GV(0, 0); GLA_GQK(0, 0); GLA_GR(0); GLA_GV(1, 1); GLA_GQK(1, 1);
            grw(0); GLA_GR(1);
            __syncthreads();
            produce(IC<0>{}, 0); GLA_GQK(0, 2);
            grw(1); GLA_GR(2);
            __syncthreads();
            produce(IC<1>{}, 1); GLA_GQK(1, 3);
            grw(0); GLA_GR(3);
            __syncthreads();
            produce(IC<0>{}, 2); GLA_GQK(0, 4);
            grw(1); GLA_GR(4);
            asm volatile("s_waitcnt vmcnt(0)" ::: "memory");
            __syncthreads();
            flv = 0u; xpub(3u, 3u, true);
            __syncthreads();
            cload(0); asm volatile("s_waitcnt vmcnt(0)" ::: "memory"); cstore(IC<0>{}, 0); GLA_GV(0, 2);
            auto gstep = [&](auto setc, const int cn) __attribute__((always_inline)) {
                constexpr int S = decltype(setc)::value;
                if (ptid == 0) flv = __hip_atomic_load(a.xflag + (item ^ 1) * 64, __ATOMIC_RELAXED, __HIP_MEMORY_SCOPE_AGENT);
                if (cn + 1 < 36) cload(cn + 1);
                if (cn + 3 < 36) produce(IC<S ^ 1>{}, cn + 3);
                asm volatile("s_waitcnt vmcnt(0)" ::: "memory");
                if (cn + 1 < 36) cstore(IC<S ^ 1>{}, cn + 1);
            };
            auto gpre = [&](auto setc, const int cn) __attribute__((always_inline)) {
                constexpr int S = decltype(setc)::value;
                GLA_GQK(S ^ 1, cn + 5); GLA_GV(S ^ 1, cn + 3);
                grw(S); GLA_GR(cn + 5);
            };
            for (int cc = 0; cc < 36; cc += 2) {
                __syncthreads();
                gstep(IC<0>{}, cc);
                __syncthreads();
                xpub((unsigned)(cc + 4 < 36 ? cc + 4 : 36), (unsigned)(cc + 3 < 36 ? cc + 3 : 36), (cc % 6) == 0);
                gpre(IC<0>{}, cc);
                __syncthreads();
                gstep(IC<1>{}, cc + 1);
                __syncthreads();
                xpub((unsigned)(cc + 5 < 36 ? cc + 5 : 36), (unsigned)(cc + 4 < 36 ? cc + 4 : 36), ((cc + 1) % 6) == 0);
                gpre(IC<1>{}, cc + 1);
            }
#undef GLA_GV
#undef GLA_GQK
#undef GLA_GR
        } else {
#define SCAN_ISSUE(S_, cc_) do { const int ci_ = SCAN_CI(cc_); const bool sq_ = (cc_) >= 4; const char* pb_ = (const char*)a.P; const unsigned ldb_ = (unsigned)a.ld * 2u; \
        _Pragma("unroll") for (int k_ = 0; k_ < 4; ++k_) { int row; SCAN_ROW(cc_, ci_ * 64 + (ptid >> 4) + 16 * k_, row); rawvS[S_][k_] = *(const u32x4*)(pb_ + ((unsigned)row * ldb_ + (unsigned)(colv + cg * 8) * 2u)); } \
        if (!GLA) { if (which || sq_) { _Pragma("unroll") for (int j_ = 0; j_ < 10; ++j_) { int row; SCAN_ROW(cc_, ci_ * 64 + 8 * rg - 1 + j_, row); \
                rawmS[S_][j_] = *(const u32x4*)(pb_ + ((unsigned)row * ldb_ + (unsigned)((which ? colk : colq) + cg * 8) * 2u)); } } } \
        else { _Pragma("unroll") for (int tl_ = 0; tl_ < 4; ++tl_) { int row; SCAN_ROW(cc_, ci_ * 64 + 16 * tl_ + c, row); const unsigned ro_ = (unsigned)row * ldb_ + (unsigned)(32 * pw + 4 * g) * 2u; \
                _Pragma("unroll") for (int d2_ = 0; d2_ < 2; ++d2_) { if (sq_) rawqS[S_][tl_ * 2 + d2_] = *(const u32x2*)(pb_ + (ro_ + (unsigned)(colq + 16 * d2_) * 2u)); rawkS[S_][tl_ * 2 + d2_] = *(const u32x2*)(pb_ + (ro_ + (unsigned)(colk + 16 * d2_) * 2u)); } } } } while (0)
#define SCAN_GATES(S_, cc_) do { if (pw == 0) { const int ci_ = SCAN_CI(cc_); int row; SCAN_ROW(cc_, ci_ * 64 + lane, row); \
        const char* sb_ = (const char*)a.small; const unsigned so_ = (unsigned)row * 256u; \
        if (!GLA) { pre_liS[S_] = *(const float*)(sb_ + (so_ + (unsigned)(dir * 8 + h) * 4u)); pre_lfS[S_] = *(const float*)(sb_ + (so_ + (unsigned)(16 + dir * 8 + h) * 4u)); } \
        else { _Pragma("unroll") for (int i_ = 0; i_ < 4; ++i_) pre_rS[S_][i_] = *(const f32x4*)(sb_ + (so_ + (unsigned)(32 + dir * 16 + 4 * i_) * 4u)); } } } while (0)
        auto mprepass = [&](auto setc, const int fs) __attribute__((always_inline)) {
            constexpr int S = decltype(setc)::value; const float pre_li = pre_liS[S], pre_lf = pre_lfS[S];
            if (pw == 0) {
                LAS float* f = sc + SC_F + fs * 256;
                const float li = pre_li, lf = logsigmoidf_(pre_lf);
                const float bs = scan_sum64(lf);
                const float gg = li - bs; const float cm = scan_max64(gg);
                const float M = fmaxf(m_run, cm), M63 = lane63(M), b63 = lane63(bs);
                f[lane] = __expf(fminf(M63 - M, 80.f)) * 0.08838834764831845f;
                f[64 + lane] = __expf(gg - M63);
                f[128 + lane] = __expf(-(bs + M));
                if (lane == 0) f[192] = __expf(m_run - M63);
                m_run = b63 + M63;
            }
        };
        auto rwrite = [&](auto setc, const int buf) __attribute__((always_inline)) {
            constexpr int S = decltype(setc)::value;
            if (pw == 0) {
                unsigned hi[8], lo[8];
#pragma unroll
                for (int i = 0; i < 4; ++i) { const f32x4 v = pre_rS[S][i]; const unsigned h0 = cvt_pk(v[0], v[1]), h1 = cvt_pk(v[2], v[3]);
                    hi[2 * i] = h0; hi[2 * i + 1] = h1;
                    lo[2 * i] = cvt_pk(v[0] - __uint_as_float(h0 << 16), v[1] - __uint_as_float(h0 & 0xffff0000u)); lo[2 * i + 1] = cvt_pk(v[2] - __uint_as_float(h1 << 16), v[3] - __uint_as_float(h1 & 0xffff0000u)); }
                LAS unsigned char* rp = lds + L_R + buf * (64 * RSG) + lane * RSG;
                *(LAS u32x4*)rp = (u32x4){hi[0], hi[1], hi[2], hi[3]}; *(LAS u32x4*)(rp + 16) = (u32x4){hi[4], hi[5], hi[6], hi[7]};
                *(LAS u32x4*)(rp + 32) = (u32x4){lo[0], lo[1], lo[2], lo[3]}; *(LAS u32x4*)(rp + 48) = (u32x4){lo[4], lo[5], lo[6], lo[7]}; }
        };
        auto stage = [&](auto setc, const int cn) __attribute__((always_inline)) {
            constexpr int S = decltype(setc)::value;
            const bool sq = cn >= 4; const int ci = SCAN_CI(cn), T = sq ? SEQ : CTX;
            LAS unsigned char* tq = lds + L_T + (cn & 1) * 3 * TILE; LAS unsigned char* tk = tq + TILE; LAS unsigned char* tv = tq + 2 * TILE;
#pragma unroll
            for (int k = 0; k < 4; ++k) *(LAS u32x4*)(tv + ((ptid >> 4) + 16 * k) * RS + cg * 16) = rawvS[S][k];
            if (!GLA) {
                if (which || sq) {
                    const LAS float* f = sc + SC_F + (cn % 3) * 256 + (which ? 64 : 0);
                    float w0[8], w1[8], w2[8];
#define SCAN_LDW(dst, tap) do { const f32x4 x0_ = *(const LAS f32x4*)(sc + SC_CW + (tap) * 128 + cg * 8), x1_ = *(const LAS f32x4*)(sc + SC_CW + (tap) * 128 + cg * 8 + 4); \
                        dst[0] = x0_[0]; dst[1] = x0_[1]; dst[2] = x0_[2]; dst[3] = x0_[3]; dst[4] = x1_[0]; dst[5] = x1_[1]; dst[6] = x1_[2]; dst[7] = x1_[3]; } while (0)
                    SCAN_LDW(w0, which * 3 + 0); SCAN_LDW(w1, which * 3 + 1); SCAN_LDW(w2, which * 3 + 2);
#undef SCAN_LDW
                    u32x4 r0 = rawmS[S][0], r9 = rawmS[S][9];
                    if (ci * 64 + 8 * rg == 0) r0 = (u32x4){0u, 0u, 0u, 0u};
                    if (ci * 64 + 8 * rg + 8 > T - 1) r9 = (u32x4){0u, 0u, 0u, 0u};
                    float pv[8], cu[8], nx[8];
                    unpack8f(r0, pv); unpack8f(rawmS[S][1], cu);
#pragma unroll
                    for (int j = 0; j < 8; ++j) {
                        unpack8f(j == 7 ? r9 : rawmS[S][j + 2], nx);
                        const int t = 8 * rg + j;
                        const float es = f[t] * 0.6931471805599453f;
                        float x[8];
#pragma unroll
                        for (int e = 0; e < 8; ++e) { const float yl = w1[e] * cu[e] + w0[e] * pv[e] + w2[e] * nx[e];
                            x[e] = (yl * es) * __builtin_amdgcn_rcpf(1.f + __builtin_amdgcn_exp2f(-yl)); }
                        u32x4 w; w.x = cvt_pk(x[0], x[1]); w.y = cvt_pk(x[2], x[3]); w.z = cvt_pk(x[4], x[5]); w.w = cvt_pk(x[6], x[7]);
                        *(LAS u32x4*)((which ? tk : tq) + t * RS + cg * 16) = w;
#pragma unroll
                        for (int e = 0; e < 8; ++e) { pv[e] = cu[e]; cu[e] = nx[e]; }
                    }
                }
            } else {
                const int pn = cn & 1;
#pragma unroll
                for (int d2 = 0; d2 < 2; ++d2) {
                    const int dt = 2 * pw + d2;
                    const LAS unsigned char* gwb = lds + L_GW + (16 * dt + c) * RSG + 16 * (g & 1);
                    const bf16x8 A1 = *(const LAS bf16x8*)gwb, A2 = *(const LAS bf16x8*)(gwb + 32);
                    const f32x4 gbv = *(const LAS f32x4*)(sc + SC_GB + 16 * dt + 4 * g);
                    const LAS unsigned char* rb = lds + L_R + pn * (64 * RSG) + c * RSG + 16 * g;
                    f32x4 x[4];
#pragma unroll
                    for (int tl = 0; tl < 4; ++tl) {
                        const bf16x8 B = *(const LAS bf16x8*)(rb + tl * 16 * RSG);
                        f32x4 acc = __builtin_amdgcn_mfma_f32_16x16x32_bf16(A1, B, gbv, 0, 0, 0);
                        acc = __builtin_amdgcn_mfma_f32_16x16x32_bf16(A2, B, acc, 0, 0, 0);
#pragma unroll
                        for (int i = 0; i < 4; ++i) { float v = __builtin_amdgcn_logf(1.f + __builtin_amdgcn_exp2f(-fmaxf(acc[i], -115.f))) * -0.0625f;
                            v += dpp_f<0x111, 0xf>(0.f, v); v += dpp_f<0x112, 0xf>(0.f, v); v += dpp_f<0x114, 0xf>(0.f, v); v += dpp_f<0x118, 0xf>(0.f, v);
                            acc[i] = v; }
                        x[tl] = acc;
                    }
                    f32x4 off = (f32x4){0.f, 0.f, 0.f, 0.f};
#pragma unroll
                    for (int tl = 0; tl < 4; ++tl) { f32x4 tot;
#pragma unroll
                        for (int i = 0; i < 4; ++i) tot[i] = dpp_f<0x15F, 0xf>(0.f, x[tl][i]);
                        x[tl] += off; off += tot; }
                    if (c == 0) { f32x4 dec;
#pragma unroll
                        for (int i = 0; i < 4; ++i) dec[i] = __builtin_amdgcn_exp2f(off[i]);
                        *(LAS f32x4*)(sc + SC_DEC + pn * 128 + 16 * dt + 4 * g) = dec; }
                    const f32x4 offq = off + 3.5f;
#pragma unroll
                    for (int tl = 0; tl < 4; ++tl) {
                        const int t = 16 * tl + c;
                        if (sq) { const u32x2 qw = rawqS[S][tl * 2 + d2]; const f32x4 eq = x[tl] - offq;
                            const float q0 = __uint_as_float(qw.x << 16), q1 = __uint_as_float(qw.x & 0xffff0000u), q2 = __uint_as_float(qw.y << 16), q3 = __uint_as_float(qw.y & 0xffff0000u);
                            u32x2 w; w.x = cvt_pk(q0 * __builtin_amdgcn_exp2f(fminf(eq[0], 110.f)), q1 * __builtin_amdgcn_exp2f(fminf(eq[1], 110.f)));
                            w.y = cvt_pk(q2 * __builtin_amdgcn_exp2f(fminf(eq[2], 110.f)), q3 * __builtin_amdgcn_exp2f(fminf(eq[3], 110.f)));
                            *(LAS u32x2*)(tq + t * RS + (16 * dt + 4 * g) * 2) = w; }
                        { const u32x2 kw = rawkS[S][tl * 2 + d2]; const f32x4 ek = off - x[tl];
                            const float k0 = __uint_as_float(kw.x << 16), k1 = __uint_as_float(kw.x & 0xffff0000u), k2 = __uint_as_float(kw.y << 16), k3 = __uint_as_float(kw.y & 0xffff0000u);
                            u32x2 w; w.x = cvt_pk(k0 * __builtin_amdgcn_exp2f(ek[0]), k1 * __builtin_amdgcn_exp2f(ek[1])); w.y = cvt_pk(k2 * __builtin_amdgcn_exp2f(ek[2]), k3 * __builtin_amdgcn_exp2f(ek[3]));
                            *(LAS u32x2*)(tk + t * RS + (16 * dt + 4 * g) * 2) = w; }
                    }
                }
            }
        };
        auto pstep = [&](auto setc, const int cn) __attribute__((always_inline)) {
            constexpr int S = decltype(setc)::value;
            if (GLA) { rwrite(IC<S ^ 1>{}, (cn + 1) & 1); SCAN_GATES(S ^ 1, cn + 3); }
            else { mprepass(IC<S ^ 1>{}, (cn + 1) % 3); SCAN_GATES(S ^ 1, cn + 3); }
            stage(setc, cn);
            SCAN_ISSUE(S, cn + 2);
        };
        SCAN_ISSUE(0, 0); SCAN_GATES(0, 0); SCAN_ISSUE(1, 1);
        if (GLA) rwrite(IC<0>{}, 0); else mprepass(IC<0>{}, 0);
        SCAN_GATES(1, 1); SCAN_GATES(0, 2);
        __syncthreads();
        pstep(IC<0>{}, 0);
        for (int cc = 0; cc < 36; cc += 2) {
            __syncthreads();
            pstep(IC<1>{}, cc + 1);
            __syncthreads();
            __syncthreads();
            if (cc + 2 < 36) pstep(IC<0>{}, cc + 2);
            __syncthreads();
        }
        }
        __builtin_amdgcn_s_setprio(0);
#undef SCAN_ISSUE
#undef SCAN_GATES
    } else {
        f32x4 Cst[2][8]; f32x4 nst[2];
#pragma unroll
        for (int hv = 0; hv < 2; ++hv)
#pragma unroll
            for (int j = 0; j < 8; ++j) Cst[hv][j] = (f32x4){0.f, 0.f, 0.f, 0.f};
        nst[0] = (f32x4){0.f, 0.f, 0.f, 0.f}; nst[1] = (f32x4){0.f, 0.f, 0.f, 0.f};
        const int q4 = c >> 2, p4 = c & 3;
        __syncthreads();
        if (GLA) { __syncthreads(); __syncthreads(); __syncthreads(); __syncthreads(); }
        auto cchunk = [&](auto segc, const int cc) __attribute__((always_inline)) {
            constexpr int seg = decltype(segc)::value;
            const int ci = seg ? cc - 4 : cc, T = seg ? SEQ : CTX, par = cc & 1;
            const LAS unsigned char* tq = lds + L_T + par * 3 * TILE; const LAS unsigned char* tk = tq + TILE; const LAS unsigned char* tv = tq + 2 * TILE;
            const LAS float* fset = sc + SC_F + (cc % 3) * 256;
            __syncthreads();
            float dsc = 1.f;
            if (!GLA) { dsc = fset[192];
#pragma unroll
                for (int hv = 0; hv < 2; ++hv)
#pragma unroll
                    for (int j = 0; j < 8; ++j) Cst[hv][j] *= dsc;
                nst[0] *= dsc; nst[1] *= dsc;
            } else {
#pragma unroll
                for (int j = 0; j < 8; ++j) { const f32x4 dv = *(const LAS f32x4*)(sc + SC_DEC + par * 128 + 32 * (j >> 1) + 8 * g + 4 * (j & 1)); Cst[0][j] *= dv; Cst[1][j] *= dv; }
            }
            f32x4 O[2][4];
#pragma unroll
            for (int hv = 0; hv < 2; ++hv)
#pragma unroll
                for (int i = 0; i < 4; ++i) O[hv][i] = (f32x4){0.f, 0.f, 0.f, 0.f};
            bf16x8 vf[2][2], fa[4], fb[4];
#define SCAN_QFRAG(l4_, kk_) (*(const LAS bf16x8*)(tq + (16 * (l4_) + c) * RS + (32 * (kk_) + 8 * g) * 2))
#define SCAN_KROW(st_, kk_) (*(const LAS bf16x8*)(tk + (16 * (st_) + c) * RS + (32 * (kk_) + 8 * g) * 2))
#define SCAN_KT(dst, j_, tt_) do { const LAS unsigned char* kp_ = tk + (32 * (tt_) + 8 * g + q4) * RS + (32 * ((j_) >> 1) + 8 * p4 + 4 * ((j_) & 1)) * 2; dst = cat4(tr16(kp_), tr16(kp_ + 4 * RS)); } while (0)
#define SCAN_SB() __builtin_amdgcn_sched_barrier(0)
#define SCAN_VF() do { _Pragma("unroll") for (int hv = 0; hv < 2; ++hv) _Pragma("unroll") for (int tt = 0; tt < 2; ++tt) { \
                const LAS unsigned char* vp = tv + (32 * tt + 8 * g + q4) * RS + (32 * wid + 16 * hv + 4 * p4) * 2; vf[hv][tt] = cat4(tr16(vp), tr16(vp + 4 * RS)); } } while (0)
            if constexpr (seg != 0) {
                if (!GLA) {
                    const int l = tid >> 2, part = tid & 3; const LAS unsigned char* qp = tq + l * RS + part * 64; const LAS float* np = sc + SC_N + par * 128 + part * 32;
                    float s = 0.f;
#pragma unroll
                    for (int hq = 0; hq < 2; ++hq) { float q[16]; unpack8f(*(const LAS u32x4*)(qp + 32 * hq), q); unpack8f(*(const LAS u32x4*)(qp + 32 * hq + 16), q + 8);
#pragma unroll
                        for (int i = 0; i < 4; ++i) { const f32x4 nv = *(const LAS f32x4*)(np + 16 * hq + 4 * i); s += q[4 * i] * nv[0] + q[4 * i + 1] * nv[1] + q[4 * i + 2] * nv[2] + q[4 * i + 3] * nv[3]; } }
                    s += __shfl_xor(s, 1); s += __shfl_xor(s, 2);
                    if (part == 0) sc[SC_QN + l] = s * dsc;
                }
                const int lt = wid;
                bf16x8 qf[4];
#pragma unroll
                for (int kk = 0; kk < 4; ++kk) qf[kk] = SCAN_QFRAG(lt, kk);
#pragma unroll
                for (int kk = 0; kk < 4; ++kk) fa[kk] = SCAN_KROW(0, kk);
#pragma unroll
                for (int kk = 0; kk < 4; ++kk) fb[kk] = SCAN_KROW(1, kk);
                SCAN_SB();
                f32x4 accs[4];
#pragma unroll
                for (int i = 0; i < 4; ++i) accs[i] = (f32x4){0.f, 0.f, 0.f, 0.f};
#pragma unroll
                for (int kk = 0; kk < 4; ++kk) accs[0] = __builtin_amdgcn_mfma_f32_16x16x32_bf16(fa[kk], qf[kk], accs[0], 0, 0, 0);
                SCAN_SB();
#pragma unroll
                for (int kk = 0; kk < 4; ++kk) fa[kk] = SCAN_KROW(2, kk);
#pragma unroll
                for (int kk = 0; kk < 4; ++kk) accs[1] = __builtin_amdgcn_mfma_f32_16x16x32_bf16(fb[kk], qf[kk], accs[1], 0, 0, 0);
                SCAN_SB();
#pragma unroll
                for (int kk = 0; kk < 4; ++kk) fb[kk] = SCAN_KROW(3, kk);
#pragma unroll
                for (int kk = 0; kk < 4; ++kk) accs[2] = __builtin_amdgcn_mfma_f32_16x16x32_bf16(fa[kk], qf[kk], accs[2], 0, 0, 0);
                SCAN_SB();
#pragma unroll
                for (int i = 0; i < 4; ++i) fa[i] = SCAN_QFRAG(i, 0);
#pragma unroll
                for (int kk = 0; kk < 4; ++kk) accs[3] = __builtin_amdgcn_mfma_f32_16x16x32_bf16(fb[kk], qf[kk], accs[3], 0, 0, 0);
                SCAN_SB();
#pragma unroll
                for (int i = 0; i < 4; ++i) fb[i] = SCAN_QFRAG(i, 1);
                float rs = 0.f;
#pragma unroll
                for (int st = 0; st < 4; ++st) { f32x4 acc = accs[st];
                    int lim = st < lt ? 64 : (st == lt ? c : -1); asm volatile("" : "+v"(lim));
#pragma unroll
                    for (int i = 0; i < 4; ++i) acc[i] = (4 * g + i > lim) ? 0.f : acc[i];
                    rs += (acc[0] + acc[1]) + (acc[2] + acc[3]);
                    u32x2 w; w.x = cvt_pk(acc[0], acc[1]); w.y = cvt_pk(acc[2], acc[3]);
                    *(LAS u32x2*)(lds + L_P + (16 * lt + c) * RSP + (16 * st + 4 * g) * 2) = w;
                }
                if (!GLA) { rs += __shfl_xor(rs, 16); rs += __shfl_xor(rs, 32); if (g == 0) sc[SC_RS + 16 * lt + c] = rs; }
#define SCAN_CF(dst, hv_, kk_) do { u32x4 bw_; bw_.x = cvt_pk(Cst[hv_][2 * (kk_)][0], Cst[hv_][2 * (kk_)][1]); bw_.y = cvt_pk(Cst[hv_][2 * (kk_)][2], Cst[hv_][2 * (kk_)][3]); \
                    bw_.z = cvt_pk(Cst[hv_][2 * (kk_) + 1][0], Cst[hv_][2 * (kk_) + 1][1]); bw_.w = cvt_pk(Cst[hv_][2 * (kk_) + 1][2], Cst[hv_][2 * (kk_) + 1][3]); dst = __builtin_bit_cast(bf16x8, bw_); } while (0)
#define SCAN_2B(fr, kk_) do { bf16x8 c0_, c1_; SCAN_CF(c0_, 0, kk_); SCAN_CF(c1_, 1, kk_); \
                    _Pragma("unroll") for (int i = 0; i < 4; ++i) { O[0][i] = __builtin_amdgcn_mfma_f32_16x16x32_bf16(c0_, fr[i], O[0][i], 0, 0, 0); O[1][i] = __builtin_amdgcn_mfma_f32_16x16x32_bf16(c1_, fr[i], O[1][i], 0, 0, 0); } } while (0)
                SCAN_SB();
                SCAN_2B(fa, 0);
#pragma unroll
                for (int i = 0; i < 4; ++i) fa[i] = SCAN_QFRAG(i, 2);
                SCAN_SB();
                SCAN_2B(fb, 1);
#pragma unroll
                for (int i = 0; i < 4; ++i) fb[i] = SCAN_QFRAG(i, 3);
                SCAN_SB();
                SCAN_2B(fa, 2);
                SCAN_VF();
#pragma unroll
                for (int i = 0; i < 4; ++i) SCAN_KT(fa[i], i >> 1, i & 1);
                SCAN_SB();
                SCAN_2B(fb, 3);
#undef SCAN_2B
#undef SCAN_CF
            } else {
                SCAN_VF();
#pragma unroll
                for (int i = 0; i < 4; ++i) SCAN_KT(fa[i], i >> 1, i & 1);
            }
#define SCAN_3(fr, j0_) do { _Pragma("unroll") for (int i = 0; i < 4; ++i) { Cst[0][(j0_) + (i >> 1)] = __builtin_amdgcn_mfma_f32_16x16x32_bf16(fr[i], vf[0][i & 1], Cst[0][(j0_) + (i >> 1)], 0, 0, 0); \
                Cst[1][(j0_) + (i >> 1)] = __builtin_amdgcn_mfma_f32_16x16x32_bf16(fr[i], vf[1][i & 1], Cst[1][(j0_) + (i >> 1)], 0, 0, 0); } } while (0)
#pragma unroll
            for (int i = 0; i < 4; ++i) SCAN_KT(fb[i], 2 + (i >> 1), i & 1);
            SCAN_SB();
            SCAN_3(fa, 0);
#pragma unroll
            for (int i = 0; i < 4; ++i) SCAN_KT(fa[i], 4 + (i >> 1), i & 1);
            SCAN_SB();
            SCAN_3(fb, 2);
#pragma unroll
            for (int i = 0; i < 4; ++i) SCAN_KT(fb[i], 6 + (i >> 1), i & 1);
            SCAN_SB();
            SCAN_3(fa, 4);
            if (!GLA) {
#pragma unroll
                for (int i = 0; i < 4; ++i) SCAN_KT(fa[i], 2 * wid + (i >> 1), i & 1);
            }
            SCAN_SB();
            SCAN_3(fb, 6);
#undef SCAN_3
            if (!GLA) {
                const bf16x8 ones = (bf16x8){0x3F80, 0x3F80, 0x3F80, 0x3F80, 0x3F80, 0x3F80, 0x3F80, 0x3F80};
#pragma unroll
                for (int i = 0; i < 4; ++i) nst[i >> 1] = __builtin_amdgcn_mfma_f32_16x16x32_bf16(fa[i], ones, nst[i >> 1], 0, 0, 0);
                if (c == 0) {
#pragma unroll
                    for (int j2 = 0; j2 < 2; ++j2) *(LAS f32x4*)(sc + SC_N + (par ^ 1) * 128 + 32 * wid + 8 * g + 4 * j2) = nst[j2]; }
            }
            __syncthreads();
            if constexpr (seg != 0) {
#pragma unroll
                for (int i = 0; i < 4; ++i) fa[i] = *(const LAS bf16x8*)(lds + L_P + (16 * (i >> 1) + c) * RSP + (32 * (i & 1) + 8 * g) * 2);
#pragma unroll
                for (int i = 0; i < 4; ++i) fb[i] = *(const LAS bf16x8*)(lds + L_P + (16 * (2 + (i >> 1)) + c) * RSP + (32 * (i & 1) + 8 * g) * 2);
                SCAN_SB();
#pragma unroll
                for (int i = 0; i < 4; ++i) { O[0][i >> 1] = __builtin_amdgcn_mfma_f32_16x16x32_bf16(vf[0][i & 1], fa[i], O[0][i >> 1], 0, 0, 0); O[1][i >> 1] = __builtin_amdgcn_mfma_f32_16x16x32_bf16(vf[1][i & 1], fa[i], O[1][i >> 1], 0, 0, 0); }
#pragma unroll
                for (int i = 0; i < 4; ++i) { O[0][2 + (i >> 1)] = __builtin_amdgcn_mfma_f32_16x16x32_bf16(vf[0][i & 1], fb[i], O[0][2 + (i >> 1)], 0, 0, 0); O[1][2 + (i >> 1)] = __builtin_amdgcn_mfma_f32_16x16x32_bf16(vf[1][i & 1], fb[i], O[1][2 + (i >> 1)], 0, 0, 0); }
#pragma unroll
                for (int l4 = 0; l4 < 4; ++l4) {
                    const int l = 16 * l4 + c; float rc = 1.f; asm volatile("" : "+v"(rc));
                    if (!GLA) { const float den = fmaxf(fabsf(sc[SC_QN + l] + sc[SC_RS + l]), fset[128 + l]); rc = __builtin_amdgcn_rcpf(den); }
                    const int pp = ci * 64 + l; const int t = dir ? (T - 1 - pp) : pp;
                    const f32x4 oa = O[0][l4] * rc, ob = O[1][l4] * rc;
                    const unsigned a0 = cvt_pk(oa[0], oa[1]), a1 = cvt_pk(oa[2], oa[3]), b0 = cvt_pk(ob[0], ob[1]), b1 = cvt_pk(ob[2], ob[3]);
                    const u32x2 s0 = __builtin_amdgcn_permlane16_swap(a0, b0, false, false), s1 = __builtin_amdgcn_permlane16_swap(a1, b1, false, false);
                    *(u32x4*)((char*)hout + ((unsigned)((b * SEQ + t) * DM + ocol + 32 * wid + 16 * (g & 1) + 8 * (g >> 1)) * 2u)) = (u32x4){s0[0], s1[0], s0[1], s1[1]};
                }
            }
#undef SCAN_QFRAG
#undef SCAN_KROW
#undef SCAN_KT
#undef SCAN_SB
#undef SCAN_VF
        };
        for (int cc = 0; cc < 4; ++cc) cchunk(IC<0>{}, cc);
        for (int cc = 4; cc < 36; ++cc) cchunk(IC<1>{}, cc);
    }
#undef SCAN_ROW
#undef SCAN_CI
}
#undef LAS
}

#include <hip/hip_cooperative_groups.h>
namespace cg = cooperative_groups;
#define LAS __attribute__((address_space(3)))
constexpr int NBLK = 256, NTHR = 512;
constexpr int MISC_OFF = scan::LDS_BYTES > pg8::STAGE_BYTES ? scan::LDS_BYTES : pg8::STAGE_BYTES;
constexpr int MEGA_LDS = MISC_OFF + 64;
constexpr int CW_LN = 16384;
constexpr size_t WS_LNX = 2 * MiB;
constexpr int CW_GX = 32768;
constexpr size_t BIG_GX = 130 * MiB;
constexpr int CW_RANK = 8192;
constexpr int CW_BAR = 4096;
constexpr size_t WS_MODP = 502 * MiB;
struct Params { const float* in[28]; float* out; unsigned char* ws; };
typedef float f32x4v __attribute__((ext_vector_type(4)));
typedef unsigned u32x4v __attribute__((ext_vector_type(4)));

__device__ __forceinline__ void ph_prologue(const Params& p, LAS unsigned char* lds, int c) {
    int tid = threadIdx.x; asm volatile("" : "+v"(tid));
    unsigned char* ws = p.ws;
    LAS float* t = (LAS float*)lds;
    auto wdec = [&](const int it, const float*& s0, const float*& s1, bf16_t*& dp) __attribute__((always_inline)) {
        const float* W; bf16_t* Wt; int ldw, K, srcA, srcB, dst, kb, tl = it;
        if (tl < 2320) { W = p.in[6]; Wt = (bf16_t*)(ws + WS_WIN); ldw = NIN; K = DM; kb = tl / 145; const int nt = tl - kb * 145; int jn;
            if (nt < 48) { srcA = 64 * nt; dst = 64 * nt; }
            else if (nt == 48) { srcA = 4096; dst = 3072; }
            else if ((jn = nt - 49) < 8) { srcA = 4128 + 64 * jn; dst = 3328 + 64 * jn; }
            else if ((jn = nt - 57) < 8) { srcA = 4640 + 64 * jn; dst = 3840 + 64 * jn; }
            else if ((jn = nt - 65) < 16) { srcA = 5152 + 64 * jn; dst = 4352 + 64 * jn; }
            else if ((jn = nt - 81) < 16) { srcA = 3072 + 64 * jn; dst = 5376 + 64 * jn; }
            else if ((jn = nt - 97) < 16) { srcA = 6176 + 64 * jn; dst = 6400 + 64 * jn; }
            else if ((jn = nt - 113) < 16) { srcA = 7232 + 64 * jn; dst = 7424 + 64 * jn; }
            else { jn = nt - 129; srcA = 8256 + 64 * jn; dst = 8448 + 64 * jn; }
            srcB = nt == 48 ? 7200 : srcA + 32; }
        else { int ntn;
            if ((tl -= 2320) < 256) { W = p.in[15]; Wt = (bf16_t*)(ws + WS_WBM); ldw = DM; K = DM; ntn = 16; }
            else if ((tl -= 256) < 256) { W = p.in[16]; Wt = (bf16_t*)(ws + WS_WBG); ldw = DM; K = DM; ntn = 16; }
            else if ((tl -= 256) < 256) { W = p.in[17]; Wt = (bf16_t*)(ws + WS_WOUT); ldw = DM; K = DM; ntn = 16; }
            else if ((tl -= 256) < 1408) { W = p.in[20]; Wt = (bf16_t*)(ws + WS_WUP); ldw = 2 * DFF; K = DM; ntn = 88; }
            else { tl -= 1408; W = p.in[24]; Wt = (bf16_t*)(ws + WS_WDN); ldw = DM; K = DFF; ntn = 16; }
            kb = tl / ntn; srcA = 64 * (tl - kb * ntn); srcB = srcA + 32; dst = srcA; }
        const int k0 = kb * 64, n = 4 * (tid & 15), kk = tid >> 4;
        const float* sp = W + (size_t)(k0 + kk) * ldw + (n < 32 ? srcA + n : srcB + n - 32);
        s0 = sp; s1 = sp + (size_t)32 * ldw;
        dp = Wt + (size_t)(dst + (tid >> 3)) * K + k0 + 8 * (tid & 7);
    };
    { const float* s0; const float* s1; bf16_t* dp; f32x4v pv0 = (f32x4v){0.f, 0.f, 0.f, 0.f}, pv1 = pv0;
      if (c < 5200) { wdec(c, s0, s1, dp); pv0 = *(const f32x4v*)s0; pv1 = *(const f32x4v*)s1; }
      int ib = 0;
      for (int it = c; it < 5200; it += NBLK, ++ib) {
        bf16_t* dcur = dp; const f32x4v v0 = pv0, v1 = pv1; LAS float* tb = t + (ib & 1) * (64 * 65);
        if (it + NBLK < 5200) { wdec(it + NBLK, s0, s1, dp); pv0 = *(const f32x4v*)s0; pv1 = *(const f32x4v*)s1; }
        { const int k = tid >> 4, n = 4 * (tid & 15);
          tb[k * 65 + n] = v0[0]; tb[k * 65 + n + 1] = v0[1]; tb[k * 65 + n + 2] = v0[2]; tb[k * 65 + n + 3] = v0[3];
          tb[(k + 32) * 65 + n] = v1[0]; tb[(k + 32) * 65 + n + 1] = v1[1]; tb[(k + 32) * 65 + n + 2] = v1[2]; tb[(k + 32) * 65 + n + 3] = v1[3]; }
        __syncthreads();
        { const int n = tid >> 3, kq = tid & 7; const LAS float* tp = tb + (8 * kq) * 65 + n;
          u32x4v o; o.x = scan::cvt_pk(tp[0], tp[65]); o.y = scan::cvt_pk(tp[130], tp[195]); o.z = scan::cvt_pk(tp[260], tp[325]); o.w = scan::cvt_pk(tp[390], tp[455]);
          *(u32x4v*)dcur = o; }
      }
      __syncthreads(); }
    { u32x4v* z = (u32x4v*)((bf16_t*)(ws + WS_WIN) + (size_t)3136 * DM);
      for (int i = c * NTHR + tid; i < 24576; i += NBLK * NTHR) z[i] = (u32x4v){0u, 0u, 0u, 0u}; }
    { float* bp = (float*)(ws + WS_BIN); const float* b_in = p.in[7];
      for (int j = c * NTHR + tid; j < NINP; j += NBLK * NTHR) { int s;
        if (j < 3072) s = j; else if (j < 3104) s = 4096 + (j - 3072); else if (j < 3136) s = 7200 + (j - 3104); else if (j < 3328) s = -1;
        else if (j < 3840) s = 4128 + (j - 3328); else if (j < 4352) s = 4640 + (j - 3840); else if (j < 5376) s = 5152 + (j - 4352);
        else if (j < 6400) s = 3072 + (j - 5376); else if (j < 7424) s = 6176 + (j - 6400); else if (j < 8448) s = 7232 + (j - 7424); else s = 8256 + (j - 8448);
        bp[j] = s >= 0 ? b_in[s] : 0.f; } }
    for (int item = c; item < 192; item += NBLK) {
        const int cb = item % 12, ks = item / 12; LAS float* sl = (LAS float*)lds;
        for (int i = tid; i < 17 * 64; i += NTHR) { const int r = i >> 6, k = i & 63; const float cv = r < 16 ? p.in[1][r * DM + ks * 64 + k] : p.in[3][ks * 64 + k]; sl[i] = siluf_(cv); }
        __syncthreads();
        const int col = cb * 512 + tid; float acc[17];
#pragma unroll
        for (int r = 0; r < 17; ++r) acc[r] = 0.f;
        const float* wm = p.in[4] + (size_t)(ks * 64) * 6144 + col;
        for (int k = 0; k < 64; ++k) { const float w = wm[(size_t)k * 6144];
#pragma unroll
            for (int r = 0; r < 17; ++r) acc[r] += sl[r * 64 + k] * w; }
        float* mp = (float*)(ws + WS_MODP) + (size_t)ks * 17 * 6144 + col;
#pragma unroll
        for (int r = 0; r < 17; ++r) mp[(size_t)r * 6144] = acc[r];
        __syncthreads();
    }
}
__device__ __forceinline__ void ph_modulate(const Params& p, LAS unsigned char* lds, int c) {
    int tid = threadIdx.x; asm volatile("" : "+v"(tid)); const int lane = tid & 63, wid = tid >> 6;
    const float* modp = (const float*)(p.ws + WS_MODP); const float* b_mod = p.in[5];
    float* modv = (float*)(p.ws + WS_MOD);
    { const bf16_t* Ws = (const bf16_t*)(p.ws + WS_WIN) + (size_t)3072 * DM; LAS unsigned char* wl = lds + 8192;
#pragma unroll
      for (int h2 = 0; h2 < 2; ++h2) { u32x4v wv[8];
#pragma unroll
          for (int k = 0; k < 8; ++k) { const int i = tid + NTHR * (8 * h2 + k), r = i >> 7, pc = i & 127; wv[k] = *(const u32x4v*)(Ws + (size_t)r * DM + pc * 8); }
#pragma unroll
          for (int k = 0; k < 8; ++k) { const int i = tid + NTHR * (8 * h2 + k), r = i >> 7, pc = i & 127; *(LAS u32x4v*)(wl + r * 2064 + pc * 16) = wv[k]; } } }
    for (int e = tid; e < 408; e += NTHR) { const int idx = c * 408 + e, r = idx / 6144, j = idx - r * 6144; float s = b_mod[j];
#pragma unroll
        for (int ks = 0; ks < 16; ++ks) s += modp[((size_t)ks * 17 + r) * 6144 + j];
        modv[idx] = s; }
    LAS float* mv = (LAS float*)lds;
    bf16_t* U = (bf16_t*)(p.ws + WS_U) ;
    for (int pass = 0; pass < 2; ++pass) {
        const int b = pass ? 16 : c >> 4;
        __syncthreads();
        for (int j = tid; j < 2048; j += NTHR) { float s = b_mod[j];
#pragma unroll
            for (int ks = 0; ks < 16; ++ks) s += modp[((size_t)ks * 17 + b) * 6144 + j];
            mv[j] = s; }
        __syncthreads();
        f32x4v shv[4], scv[4];
#pragma unroll
        for (int i = 0; i < 4; ++i) { const int d = i * 256 + lane * 4; shv[i] = *(const LAS f32x4v*)(mv + d); scv[i] = *(const LAS f32x4v*)(mv + 1024 + d) + 1.f; }
        const int nrow = pass ? 16 : 128;
        for (int r0 = wid; r0 < nrow; r0 += 32) {
            f32x4v v[4][4];
#pragma unroll
            for (int k = 0; k < 4; ++k) { const int rr = r0 + 8 * k; if (rr < nrow) { const float* src = pass ? p.in[2] + (size_t)(16 * c + rr) * DM : p.in[0] + (size_t)(128 * c + rr) * DM;
#pragma unroll
                for (int i = 0; i < 4; ++i) v[k][i] = *(const f32x4v*)(src + i * 256 + lane * 4); } }
#pragma unroll
            for (int k = 0; k < 4; ++k) { const int rr = r0 + 8 * k; if (rr < nrow) { const int row = pass ? ML + 16 * c + rr : 128 * c + rr;
#pragma unroll
                for (int i = 0; i < 4; ++i) { const f32x4v w = v[k][i] * scv[i] + shv[i];
                    uint2 o; o.x = scan::cvt_pk(w[0], w[1]); o.y = scan::cvt_pk(w[2], w[3]);
                    *(uint2*)(U + (size_t)row * DM + i * 256 + lane * 4) = o; } } }
        }
    }
    asm volatile("s_waitcnt vmcnt(0)" ::: "memory");
    __syncthreads();
    { LAS unsigned char* wl = lds + 8192;
      int c16 = lane & 15, g4 = lane >> 4; asm volatile("" : "+v"(c16), "+v"(g4));
      const float* bsm = (const float*)(p.ws + WS_BIN) + 3072; char* smb = (char*)(p.ws + WS_BIG + BIG_SMALL); const char* ub = (const char*)U;
      const LAS unsigned char* wlb = wl + c16 * 2064 + g4 * 16;
      const unsigned ao = (unsigned)((128 * c + 16 * wid + c16) * DM + 8 * g4) * 2u, aoc = (unsigned)((ML + 16 * c + c16) * DM + 8 * g4) * 2u + (unsigned)(256 * wid);
      scan::bf16x8 fa[32], fc[4];
#pragma unroll
      for (int u = 0; u < 32; ++u) fa[u] = *(const scan::bf16x8*)(ub + (ao + (unsigned)(64 * u)));
#pragma unroll
      for (int u = 0; u < 4; ++u) fc[u] = *(const scan::bf16x8*)(ub + (aoc + (unsigned)(64 * u)));
      f32x4v acc[4], accc[4];
#pragma unroll
      for (int nt = 0; nt < 4; ++nt) { const float bz = bsm[16 * nt + c16]; acc[nt] = (f32x4v){bz, bz, bz, bz}; accc[nt] = (f32x4v){0.f, 0.f, 0.f, 0.f}; }
#pragma unroll
      for (int u = 0; u < 32; ++u)
#pragma unroll
          for (int nt = 0; nt < 4; ++nt) { const scan::bf16x8 bf = *(const LAS scan::bf16x8*)(wlb + nt * 16 * 2064 + 64 * u);
              acc[nt] = __builtin_amdgcn_mfma_f32_16x16x32_bf16(fa[u], bf, acc[nt], 0, 0, 0); }
#pragma unroll
      for (int u = 0; u < 4; ++u)
#pragma unroll
          for (int nt = 0; nt < 4; ++nt) { const scan::bf16x8 bf = *(const LAS scan::bf16x8*)(wlb + nt * 16 * 2064 + 64 * (4 * wid + u));
              accc[nt] = __builtin_amdgcn_mfma_f32_16x16x32_bf16(fc[u], bf, accc[nt], 0, 0, 0); }
      { const unsigned so = (unsigned)((128 * c + 16 * wid + 4 * g4) * 64 + c16) * 4u;
#pragma unroll
        for (int nt = 0; nt < 4; ++nt)
#pragma unroll
            for (int i = 0; i < 4; ++i) *(float*)(smb + (so + (unsigned)((i * 64 + 16 * nt) * 4))) = acc[nt][i]; }
      __syncthreads();
      LAS float* part = (LAS float*)wl;
#pragma unroll
      for (int nt = 0; nt < 4; ++nt)
#pragma unroll
          for (int i = 0; i < 4; ++i) part[(wid * 16 + 4 * g4 + i) * 64 + 16 * nt + c16] = accc[nt][i];
      __syncthreads();
#pragma unroll
      for (int o2 = 0; o2 < 2; ++o2) { const int o = tid + 512 * o2, row = o >> 6, col = o & 63; float sacc = bsm[col];
#pragma unroll
          for (int w = 0; w < 8; ++w) sacc += part[(w * 16 + row) * 64 + col];
          *(float*)(smb + (unsigned)((ML + 16 * c + row) * 64 + col) * 4u) = sacc; }
    }
}
__device__ __forceinline__ void aprep_unpack16(u32x4v a, u32x4v b, float* v) {
    v[0] = __uint_as_float(a.x << 16); v[1] = __uint_as_float(a.x & 0xffff0000u); v[2] = __uint_as_float(a.y << 16); v[3] = __uint_as_float(a.y & 0xffff0000u);
    v[4] = __uint_as_float(a.z << 16); v[5] = __uint_as_float(a.z & 0xffff0000u); v[6] = __uint_as_float(a.w << 16); v[7] = __uint_as_float(a.w & 0xffff0000u);
    v[8] = __uint_as_float(b.x << 16); v[9] = __uint_as_float(b.x & 0xffff0000u); v[10] = __uint_as_float(b.y << 16); v[11] = __uint_as_float(b.y & 0xffff0000u);
    v[12] = __uint_as_float(b.z << 16); v[13] = __uint_as_float(b.z & 0xffff0000u); v[14] = __uint_as_float(b.w << 16); v[15] = __uint_as_float(b.w & 0xffff0000u); }
__device__ __forceinline__ void ph_aprep(const Params& p, int c) {
    int tid = threadIdx.x; asm volatile("" : "+v"(tid)); const int lane = tid & 63, wid = tid >> 6;
    bf16_t* hm = (bf16_t*)p.out; bf16_t* hg = (bf16_t*)(p.ws + WS_BIG + BIG_HG); const bf16_t* side = (const bf16_t*)(p.ws + WS_BIG + BIG_SIDE);
    float gmv[16], ggv[16];
#pragma unroll
    for (int i = 0; i < 4; ++i) { const f32x4v a = *(const f32x4v*)(p.in[13] + lane * 16 + 4 * i), b = *(const f32x4v*)(p.in[14] + lane * 16 + 4 * i);
        gmv[4 * i] = a[0]; gmv[4 * i + 1] = a[1]; gmv[4 * i + 2] = a[2]; gmv[4 * i + 3] = a[3]; ggv[4 * i] = b[0]; ggv[4 * i + 1] = b[1]; ggv[4 * i + 2] = b[2]; ggv[4 * i + 3] = b[3]; }
    u32x4v raw[2][12];
#define APREP_LD(buf, rq_) do { const int row_ = c * 128 + 8 * (rq_) + wid; const size_t o_ = (size_t)row_ * DM + lane * 16; const bf16_t* sp_ = side + (size_t)row_ * 4096 + lane * 16; \
        raw[buf][0] = *(const u32x4v*)(hm + o_); raw[buf][1] = *(const u32x4v*)(hm + o_ + 8); raw[buf][2] = *(const u32x4v*)(hm + o_ + (size_t)ML * DM); raw[buf][3] = *(const u32x4v*)(hm + o_ + (size_t)ML * DM + 8); \
        raw[buf][4] = *(const u32x4v*)sp_; raw[buf][5] = *(const u32x4v*)(sp_ + 8); \
        raw[buf][6] = *(const u32x4v*)(hg + o_); raw[buf][7] = *(const u32x4v*)(hg + o_ + 8); raw[buf][8] = *(const u32x4v*)(hg + o_ + (size_t)ML * DM); raw[buf][9] = *(const u32x4v*)(hg + o_ + (size_t)ML * DM + 8); \
        raw[buf][10] = *(const u32x4v*)(sp_ + 1024); raw[buf][11] = *(const u32x4v*)(sp_ + 1024 + 8); } while (0)
    APREP_LD(0, 0);
    for (int rq2 = 0; rq2 < 16; rq2 += 2) {
#pragma unroll
        for (int u = 0; u < 2; ++u) {
            const int rq = rq2 + u; const int row = c * 128 + 8 * rq + wid; const size_t o = (size_t)row * DM + lane * 16;
            if (rq + 1 < 16) APREP_LD(u ^ 1, rq + 1);
            float v[16], w[16], g[16];
            { aprep_unpack16(raw[u][0], raw[u][1], v); aprep_unpack16(raw[u][2], raw[u][3], w); aprep_unpack16(raw[u][4], raw[u][5], g);
              float s = 0.f;
#pragma unroll
              for (int i = 0; i < 16; ++i) { v[i] += w[i]; s += v[i]; }
              s += __shfl_xor(s, 1); s += __shfl_xor(s, 2); s += __shfl_xor(s, 4);
              const float mean = s * (1.f / 128.f); float q = 0.f;
#pragma unroll
              for (int i = 0; i < 16; ++i) { v[i] -= mean; q += v[i] * v[i]; }
              q += __shfl_xor(q, 1); q += __shfl_xor(q, 2); q += __shfl_xor(q, 4);
              const float rstd = rsqrtf(q * (1.f / 128.f) + EPS);
              unsigned ow[8];
#pragma unroll
              for (int e = 0; e < 16; e += 2) ow[e >> 1] = scan::cvt_pk(v[e] * rstd * gmv[e] * sigmoidf_(g[e]), v[e + 1] * rstd * gmv[e + 1] * sigmoidf_(g[e + 1]));
              *(u32x4v*)(hm + o) = (u32x4v){ow[0], ow[1], ow[2], ow[3]}; *(u32x4v*)(hm + o + 8) = (u32x4v){ow[4], ow[5], ow[6], ow[7]}; }
            { aprep_unpack16(raw[u][6], raw[u][7], v); aprep_unpack16(raw[u][8], raw[u][9], w); aprep_unpack16(raw[u][10], raw[u][11], g);
              float q = 0.f;
#pragma unroll
              for (int i = 0; i < 16; ++i) { v[i] += w[i]; q += v[i] * v[i]; }
              q += __shfl_xor(q, 1); q += __shfl_xor(q, 2); q += __shfl_xor(q, 4); q += __shfl_xor(q, 8);
              const float rstd = rsqrtf(q * (1.f / 256.f) + EPS);
              unsigned ow[8];
#pragma unroll
              for (int e = 0; e < 16; e += 2) ow[e >> 1] = scan::cvt_pk(v[e] * rstd * ggv[e] * siluf_(g[e]), v[e + 1] * rstd * ggv[e + 1] * siluf_(g[e + 1]));
              *(u32x4v*)(hg + o) = (u32x4v){ow[0], ow[1], ow[2], ow[3]}; *(u32x4v*)(hg + o + 8) = (u32x4v){ow[4], ow[5], ow[6], ow[7]}; }
        }
    }
#undef APREP_LD
}
template <int MODE>
__device__ __forceinline__ void ph_ln(const Params& p, int c) {
    int tid = threadIdx.x; asm volatile("" : "+v"(tid)); const int lane = tid & 63, wid = tid >> 6;
    const float* g = MODE == 1 ? p.in[18] : p.in[26]; const float* bta = MODE == 1 ? p.in[19] : p.in[27];
    const float* mv = (const float*)(p.ws + WS_MOD) + (c * 128 / SEQ) * 6144; bf16_t* u2 = (bf16_t*)(p.ws + WS_U);
    f32x4v vn[4];
#pragma unroll
    for (int j = 0; j < 4; ++j) vn[j] = *(const f32x4v*)(p.out + (size_t)(c * 128 + wid) * DM + j * 256 + lane * 4);
    for (int rr = wid; rr < 128; rr += 8) {
        const int row = c * 128 + rr; float* ptr = p.out + (size_t)row * DM;
        f32x4v v[4]; float s = 0.f;
#pragma unroll
        for (int j = 0; j < 4; ++j) { v[j] = vn[j]; s += (v[j][0] + v[j][1]) + (v[j][2] + v[j][3]); }
        if (rr + 8 < 128) {
#pragma unroll
            for (int j = 0; j < 4; ++j) vn[j] = *(const f32x4v*)(ptr + (size_t)8 * DM + j * 256 + lane * 4); }
        const float mean = wave_sum(s) * (1.f / DM); float q = 0.f;
#pragma unroll
        for (int j = 0; j < 4; ++j) { v[j] = v[j] - mean; q += (v[j][0] * v[j][0] + v[j][1] * v[j][1]) + (v[j][2] * v[j][2] + v[j][3] * v[j][3]); }
        const float rstd = rsqrtf(wave_sum(q) * (1.f / DM) + EPS);
#pragma unroll
        for (int j = 0; j < 4; ++j) { const int cc = j * 256 + lane * 4; const f32x4v o = v[j] * rstd * *(const f32x4v*)(g + cc) + *(const f32x4v*)(bta + cc);
            *(f32x4v*)(ptr + cc) = o;
            if (MODE == 1) { const f32x4v sh = *(const f32x4v*)(mv + 3072 + cc), sc = *(const f32x4v*)(mv + 4096 + cc); const f32x4v w = o * (sc + 1.f) + sh;
                uint2 ww; ww.x = scan::cvt_pk(w[0], w[1]); ww.y = scan::cvt_pk(w[2], w[3]); *(uint2*)(u2 + (size_t)row * DM + cc) = ww; } }
    }
}
__device__ __forceinline__ void ph_convglu(const Params& p, LAS unsigned char* lds, int c) {
    int tid = threadIdx.x; asm volatile("" : "+v"(tid));
    const bf16_t* gate = (const bf16_t*)(p.ws + WS_BIG + BIG_GATE); bf16_t* val = (bf16_t*)(p.ws + WS_BIG + BIG_VAL);
    LAS float* cw = (LAS float*)lds;
    for (int i = tid; i < 9 * DFF; i += NTHR) cw[i] = p.in[22][i];
    for (int i = tid; i < DFF; i += NTHR) cw[9 * DFF + i] = p.in[23][i];
    __syncthreads();
    const int b = c >> 4, rimg0 = (c & 15) * 2;
    for (int wi = (tid >> 6); wi < 44; wi += 8) {
        const int cs = wi / 11, grp = wi - cs * 11, rsel = (tid >> 5) & 1, cgp = 32 * grp + (tid & 31), ch = cgp * 8;
        const int r = rimg0 + rsel, col0 = 16 * cs;
        const bool up = r > 0, dn = r < SEQ / GW - 1;
        const bf16_t* g0 = gate + ((size_t)b * SEQ + r * GW) * DFF + ch;
        const bf16_t* gu = up ? g0 - (size_t)GW * DFF : g0; const bf16_t* gd = dn ? g0 + (size_t)GW * DFF : g0;
        bf16_t* v0 = val + ((size_t)c * 128 + rsel * 64 + col0) * DFF + ch;
        float w[9][8];
#pragma unroll
        for (int k = 0; k < 9; ++k) { const f32x4v a0 = *(const LAS f32x4v*)(cw + k * DFF + ch), a1 = *(const LAS f32x4v*)(cw + k * DFF + ch + 4);
            const bool ok = k < 3 ? up : (k >= 6 ? dn : true);
#pragma unroll
            for (int e = 0; e < 4; ++e) { w[k][e] = ok ? a0[e] : 0.f; w[k][4 + e] = ok ? a1[e] : 0.f; } }
        float win[4][3][8];
#define CONV_LD(dst, col_) do { const int cc_ = (col_) < 0 ? 0 : ((col_) > GW - 1 ? GW - 1 : (col_)); dst[0] = *(const u32x4v*)(gu + (size_t)cc_ * DFF); dst[1] = *(const u32x4v*)(g0 + (size_t)cc_ * DFF); dst[2] = *(const u32x4v*)(gd + (size_t)cc_ * DFF); } while (0)
#define CONV_UNP(slot_, src, okc) do { _Pragma("unroll") for (int di_ = 0; di_ < 3; ++di_) { u32x4v q_ = src[di_]; if (!(okc)) q_ = (u32x4v){0u, 0u, 0u, 0u}; \
            win[slot_][di_][0] = __uint_as_float(q_.x << 16); win[slot_][di_][1] = __uint_as_float(q_.x & 0xffff0000u); win[slot_][di_][2] = __uint_as_float(q_.y << 16); win[slot_][di_][3] = __uint_as_float(q_.y & 0xffff0000u); \
            win[slot_][di_][4] = __uint_as_float(q_.z << 16); win[slot_][di_][5] = __uint_as_float(q_.z & 0xffff0000u); win[slot_][di_][6] = __uint_as_float(q_.w << 16); win[slot_][di_][7] = __uint_as_float(q_.w & 0xffff0000u); } } while (0)
        u32x4v rawn[3];
        { u32x4v ra[3], rb[3]; CONV_LD(ra, col0 - 1); CONV_LD(rb, col0); CONV_LD(rawn, col0 + 1);
          CONV_UNP(3, ra, col0 > 0); CONV_UNP(0, rb, true); }
        for (int q = 0; q < 4; ++q) {
#pragma unroll
            for (int u = 0; u < 4; ++u) {
                const int px = 4 * q + u, col = col0 + px;
                const int sl = (u + 3) & 3, sm = u, sr = (u + 1) & 3;
                CONV_UNP(sr, rawn, col + 1 < GW);
                const u32x4v vv = *(const u32x4v*)(v0 + (size_t)px * DFF);
                CONV_LD(rawn, col + 2);
                float acc[8];
                { const LAS float* bp = cw + 9 * DFF + ch; asm volatile("" : "+v"(bp));
                  const f32x4v a0 = *(const LAS f32x4v*)bp, a1 = *(const LAS f32x4v*)(bp + 4);
#pragma unroll
                  for (int e = 0; e < 4; ++e) { acc[e] = a0[e]; acc[4 + e] = a1[e]; } }
#pragma unroll
                for (int di = 0; di < 3; ++di)
#pragma unroll
                    for (int e = 0; e < 8; ++e) acc[e] += w[di * 3][e] * win[sl][di][e] + w[di * 3 + 1][e] * win[sm][di][e] + w[di * 3 + 2][e] * win[sr][di][e];
                const float vf[8] = {__uint_as_float(vv.x << 16), __uint_as_float(vv.x & 0xffff0000u), __uint_as_float(vv.y << 16), __uint_as_float(vv.y & 0xffff0000u),
                                     __uint_as_float(vv.z << 16), __uint_as_float(vv.z & 0xffff0000u), __uint_as_float(vv.w << 16), __uint_as_float(vv.w & 0xffff0000u)};
                u32x4v o; o.x = scan::cvt_pk(gelu_tanh(acc[0]) * vf[0], gelu_tanh(acc[1]) * vf[1]); o.y = scan::cvt_pk(gelu_tanh(acc[2]) * vf[2], gelu_tanh(acc[3]) * vf[3]);
                o.z = scan::cvt_pk(gelu_tanh(acc[4]) * vf[4], gelu_tanh(acc[5]) * vf[5]); o.w = scan::cvt_pk(gelu_tanh(acc[6]) * vf[6], gelu_tanh(acc[7]) * vf[7]);
                *(u32x4v*)(v0 + (size_t)px * DFF) = o;
            }
        }
#undef CONV_LD
#undef CONV_UNP
    }
}


#define GAS __attribute__((address_space(1)))
typedef GAS unsigned gu32;
#define RLX_AGENT __ATOMIC_RELAXED, __HIP_MEMORY_SCOPE_AGENT
#define XB_TMO      128
#define XB_XCNT(j)  (256  + 64 * (j))
#define XB_XSUB(j)  (1280 + 64 * (j))
#define XB_XGEN(j)  (2304 + 64 * (j))
#define XB_TOP      3328
#define XB_TOPGEN   3392
#define XCD_BAR_WORDS 3456
#define XB_SPIN_CAP (1u << 18)

__device__ __forceinline__ unsigned xb_ld(unsigned* p)              { return __hip_atomic_load(p, __ATOMIC_RELAXED, __HIP_MEMORY_SCOPE_AGENT); }
__device__ __forceinline__ unsigned xb_add(unsigned* p, unsigned v) { return __hip_atomic_fetch_add(p, v, __ATOMIC_RELAXED, __HIP_MEMORY_SCOPE_AGENT); }
__device__ __forceinline__ unsigned xb_xcc_id() { return (unsigned)__builtin_amdgcn_s_getreg((3 << 11) | 20) & 0xFu; }
#define XB_SPIN(cond, bar) do { unsigned _sp = 0; while (cond) { __builtin_amdgcn_s_sleep(1); \
    if ((++_sp & 255u) == 0u) { if (xb_ld(&(bar)[XB_TMO])) break; if (_sp > XB_SPIN_CAP) { atomicAdd(&(bar)[XB_TMO], 1u); break; } } } } while (0)

struct XcdBarrier {
    unsigned* bar; unsigned x;
    volatile LAS unsigned* st;
};

__device__ __forceinline__ XcdBarrier xcd_barrier_post(unsigned* bar, volatile LAS unsigned* st) {
    XcdBarrier b; b.bar = bar; b.x = xb_xcc_id(); b.st = st;
    if (threadIdx.x == 0) (void)xb_add(&bar[XB_XCNT(b.x)], 1u);
    return b;
}
__device__ __forceinline__ void xcd_barrier_complete(unsigned* bar, unsigned x, unsigned& nloc, unsigned& nx) {
    const unsigned G = gridDim.x * gridDim.y * gridDim.z;
    unsigned sum, cnt, mine, sp = 0u;
    for (;;) {
        sum = 0u; cnt = 0u; mine = 0u;
#pragma unroll
        for (unsigned j = 0; j < 16; ++j) { const unsigned c = xb_ld(&bar[XB_XCNT(j)]); sum += c; cnt += (c > 0u) ? 1u : 0u; mine = (j == x) ? c : mine; }
        if (sum == G) break;
        __builtin_amdgcn_s_sleep(1);
        if ((++sp & 255u) == 0u) { if (xb_ld(&bar[XB_TMO])) break; if (sp > XB_SPIN_CAP) { atomicAdd(&bar[XB_TMO], 1u); break; } }
    }
    nloc = mine > 0u ? mine : 1u; nx = cnt > 0u ? cnt : 1u;
}

template <bool LOCAL>
__device__ __forceinline__ void xcd_barrier(const XcdBarrier& b) {
    asm volatile("s_waitcnt vmcnt(0)" ::: "memory");
    __syncthreads();
    if (threadIdx.x == 0) {
        unsigned* bar = b.bar;
        __builtin_amdgcn_s_waitcnt(0);
        unsigned nloc = b.st[0], nx = b.st[1];
        if (nloc == 0u) { xcd_barrier_complete(bar, b.x, nloc, nx); b.st[0] = nloc; b.st[1] = nx; }
        const unsigned old = xb_add(&bar[XB_XSUB(b.x)], 1u);
        const unsigned gen = old / nloc;
        if (LOCAL) {
            if (old + 1u == (gen + 1u) * nloc) xb_add(&bar[XB_XGEN(b.x)], 1u);
            else XB_SPIN(xb_ld(&bar[XB_XGEN(b.x)]) == gen, bar);
            __builtin_amdgcn_fence(__ATOMIC_ACQUIRE, "agent");
            asm volatile("s_waitcnt vmcnt(0)" ::: "memory");
        } else if (old + 1u == (gen + 1u) * nloc) {
            __builtin_amdgcn_fence(__ATOMIC_RELEASE, "agent");
            asm volatile("s_waitcnt vmcnt(0)" ::: "memory");
            const unsigned og = xb_add(&bar[XB_TOP], 1u);
            const unsigned tg = og / nx;
            if (og + 1u == (tg + 1u) * nx) xb_add(&bar[XB_TOPGEN], 1u);
            else XB_SPIN(xb_ld(&bar[XB_TOPGEN]) == tg, bar);
            __builtin_amdgcn_fence(__ATOMIC_ACQUIRE, "agent");
            xb_add(&bar[XB_XGEN(b.x)], 1u);
            asm volatile("s_waitcnt vmcnt(0)" ::: "memory");
        } else {
            XB_SPIN(xb_ld(&bar[XB_XGEN(b.x)]) == gen, bar);
            __builtin_amdgcn_fence(__ATOMIC_ACQUIRE, "agent");
            asm volatile("s_waitcnt vmcnt(0)" ::: "memory");
        }
    }
    __syncthreads();
}


__global__ void __launch_bounds__(NTHR, 2) mega_fwd(Params p) {
    extern __shared__ __attribute__((aligned(16))) unsigned char lds_dyn[];
    LAS unsigned char* lds = (LAS unsigned char*)lds_dyn;
    cg::grid_group grid = cg::this_grid();
    const int c = blockIdx.x;
    unsigned char* ws = p.ws; unsigned char* big = ws + WS_BIG;
    float* modv = (float*)(ws + WS_MOD); float* binp = (float*)(ws + WS_BIN);
    bf16_t* Wt_in = (bf16_t*)(ws + WS_WIN); bf16_t* U = (bf16_t*)(ws + WS_U);
    bf16_t* Pm = (bf16_t*)(big + BIG_PM); bf16_t* Pg = (bf16_t*)(big + BIG_PG); float* small = (float*)(big + BIG_SMALL);
    bf16_t* hm = (bf16_t*)p.out; bf16_t* hg = (bf16_t*)(big + BIG_HG); bf16_t* side = (bf16_t*)(big + BIG_SIDE);
    bf16_t* gate = (bf16_t*)(big + BIG_GATE); bf16_t* val = (bf16_t*)(big + BIG_VAL);
    if (threadIdx.x < 16) ((LAS unsigned*)(lds + MISC_OFF))[threadIdx.x] = 0u;
    __syncthreads();
#define GRID_SYNC() xcd_barrier<false>(bar)
#define XCD_SYNC() xcd_barrier<true>(bar)
    if (c == 0) { for (int i = threadIdx.x; i < XCD_BAR_WORDS; i += NTHR) __hip_atomic_store((unsigned*)(ws + WS_CTL) + CW_BAR + i, 0u, __ATOMIC_RELAXED, __HIP_MEMORY_SCOPE_AGENT);
                  if (threadIdx.x < 16) __hip_atomic_store((unsigned*)(ws + WS_CTL) + CW_RANK + 64 * threadIdx.x, 0u, __ATOMIC_RELAXED, __HIP_MEMORY_SCOPE_AGENT);
                  if (threadIdx.x < 256) { __hip_atomic_store((unsigned*)(ws + WS_CTL) + CW_LN + 64 * threadIdx.x, 0u, __ATOMIC_RELAXED, __HIP_MEMORY_SCOPE_AGENT);
                                           __hip_atomic_store((unsigned*)(ws + WS_CTL) + CW_GX + 64 * threadIdx.x, 0u, __ATOMIC_RELAXED, __HIP_MEMORY_SCOPE_AGENT); } }
    asm volatile("s_waitcnt vmcnt(0)" ::: "memory");
    grid.sync();
    XcdBarrier bar = xcd_barrier_post((unsigned*)(ws + WS_CTL) + CW_BAR, (volatile LAS unsigned*)(lds + MISC_OFF));
    if (threadIdx.x == 0) ((volatile LAS unsigned*)(lds + MISC_OFF))[4] = xb_add((unsigned*)(ws + WS_CTL) + CW_RANK + 64 * bar.x, 1u);
    __syncthreads();
    const int xr = __builtin_amdgcn_readfirstlane((int)((volatile LAS unsigned*)(lds + MISC_OFF))[4]);
    const int xx = __builtin_amdgcn_readfirstlane((int)bar.x & 7), v = 32 * xx + (xr & 31);
    ph_prologue(p, lds, c);
    GRID_SYNC();
    ph_modulate(p, lds, v);
    XCD_SYNC();
    { pg8::SchedAB S{U, Wt_in, DM, xx, xr & 31, 0}; pg8::FEpiAB E{Pm, Pg, binp}; pg8::gemm_phase(lds, DM, S, E); }
    XCD_SYNC();
    { scan::Args a{Pm, 3072, 0, small, p.in[8], p.in[9], p.in[10], p.in[11], p.in[12], hm, nullptr, nullptr}; scan::scan_item<false>(lds, a, v); }
    GRID_SYNC();
    { scan::Args a{Pg, 2048, 0, small, p.in[8], p.in[9], p.in[10], p.in[11], p.in[12], hg, big + BIG_GX, (unsigned*)(ws + WS_CTL) + CW_GX}; scan::scan_item<true>(lds, a, v); }
    GRID_SYNC();
    { pg8::SchedPlain S{U, Wt_in + (size_t)PC_SIDE * DM, 16, N_SIDE / 256, DM, xx, xr & 31, 0};
      pg8::FEpiSideF E{side, binp + PC_SIDE, hm, hg, p.in[13], p.in[14], (LAS float*)(lds + pg8::STAGE_BYTES)}; pg8::gemm_phase(lds, DM, S, E); }
    XCD_SYNC();
    { pg8::SchedDual S{hm, (const bf16_t*)(ws + WS_WBM), hg, (const bf16_t*)(ws + WS_WBG), 16, DM / 256, DM, xx, xr & 31, 0}; pg8::FEpiMerge E{U, side}; pg8::gemm_phase(lds, DM, S, E); }
    GRID_SYNC();
    { pg8::SchedPlain S{U, (const bf16_t*)(ws + WS_WOUT), 16, DM / 256, DM, xx, xr & 31, 0};
      pg8::FEpiOutLN E{p.in[0], modv, p.out, U, p.in[18], p.in[19], pg8::LnX{(float*)(ws + WS_LNX), (unsigned*)(ws + WS_CTL) + CW_LN, (LAS float*)(lds + pg8::STAGE_BYTES), xx, 0}}; pg8::gemm_phase(lds, DM, S, E); }
    XCD_SYNC();
    { pg8::SchedPlain S{U, (const bf16_t*)(ws + WS_WUP), 16, 2 * DFF / 256, DM, xx, xr & 31, 0}; pg8::FEpiUp E{gate, val, p.in[21]}; pg8::gemm_phase(lds, DM, S, E); }
    XCD_SYNC();
    ph_convglu(p, lds, v);
    XCD_SYNC();
    { pg8::SchedPlain S{val, (const bf16_t*)(ws + WS_WDN), 16, DM / 256, DFF, xx, xr & 31, 0};
      pg8::FEpiDownLN E{p.out, modv, p.in[25], p.in[26], p.in[27], pg8::LnX{(float*)(ws + WS_LNX + MiB), (unsigned*)(ws + WS_CTL) + CW_LN + 128 * 64, (LAS float*)(lds + pg8::STAGE_BYTES), xx, 0}}; pg8::gemm_phase(lds, DFF, S, E); }
    if (xb_ld(&bar.bar[XB_TMO]) != 0u || xr >= 32 || bar.x >= 8u) { __syncthreads(); if (threadIdx.x == 0) p.out[(size_t)v * 128 * DM] = __builtin_nanf(""); }
}

extern "C" void kernel_launch(void* const* d_in, const int* in_sizes, int n_in, void* d_out, int out_size, void* d_ws, size_t ws_size, hipStream_t stream) {
    if (n_in != 28 || out_size != ML * DM || ws_size < WS_END) { fprintf(stderr, "kernel_launch: unexpected shapes n_in %d out %d ws %zu\n", n_in, out_size, ws_size); return; }
    static bool attr_set = false;
    if (!attr_set) { (void)hipFuncSetAttribute((const void*)mega_fwd, hipFuncAttributeMaxDynamicSharedMemorySize, MEGA_LDS); attr_set = true; }
    Params p{};
    for (int i = 0; i < 28; ++i) p.in[i] = (const float*)d_in[i];
    p.out = (float*)d_out; p.ws = (unsigned char*)d_ws;
    void* args[] = {&p};
    hipError_t e = hipLaunchCooperativeKernel((const void*)mega_fwd, dim3(NBLK), dim3(NTHR), args, MEGA_LDS, stream);
    if (e != hipSuccess) fprintf(stderr, "cooperative launch failed: %s\n", hipGetErrorString(e));
}
```
